# Optimizing an MI355X kernel written in HIP

```python
import math
import jax, jax.numpy as jnp
from jax import lax
import numpy as np

D_MODEL = 1024
BATCH = 8
SEQ = 4096
DEPTH = 4

MIX_WIDTH = D_MODEL
A_HEADS = 8
A_KV_HEADS = 2
A_GROUP = A_HEADS // A_KV_HEADS
B_HEADS = 8
HEAD_DIM = MIX_WIDTH // (A_HEADS + B_HEADS)
A_WIDTH = A_HEADS * HEAD_DIM
A_KV_WIDTH = A_KV_HEADS * HEAD_DIM
B_WIDTH = B_HEADS * HEAD_DIM
PROJ_WIDTH = A_WIDTH + 2 * A_KV_WIDTH + 3 * B_WIDTH
WINDOW = 128
BLOCK = 128
GRID_W = 64
NA_ROWS_MAX = 8
NA_COLS = 16
T5_BUCKETS = 32
T5_MAX_DIST = 128
PEER_HEADS = 8
PEER_N_KEYS = 128
PEER_N_EXPERTS = PEER_N_KEYS * PEER_N_KEYS
PEER_TOPK = 16
PEER_QDIM = 256
PEER_CHUNK = 128
ALPHA = (2 * DEPTH) ** 0.25
BETA = (8 * DEPTH) ** -0.25
LN_EPS = 1e-5
NEG = -1e30

kernel_name = 'hymba_window_natten_peer_deepnorm'


def layer_norm(x, g, b):
    xf = x.astype(jnp.float32)
    mu = xf.mean(-1, keepdims=True)
    var = jnp.square(xf - mu).mean(-1, keepdims=True)
    return ((xf - mu) * lax.rsqrt(var + LN_EPS) * g + b).astype(x.dtype)


def rms_norm(x, g):
    xf = x.astype(jnp.float32)
    return (xf * lax.rsqrt(jnp.square(xf).mean(-1, keepdims=True) + LN_EPS) * g).astype(x.dtype)


def t5_bucket(rel):
    nb = T5_BUCKETS // 2
    max_exact = nb // 2
    ret = (rel > 0).astype(jnp.int32) * nb
    n = jnp.abs(rel).astype(jnp.int32)
    nf = jnp.maximum(n, 1).astype(jnp.float32)
    large = max_exact + (jnp.log(nf / max_exact) / math.log(T5_MAX_DIST / max_exact)
                         * (nb - max_exact)).astype(jnp.int32)
    large = jnp.minimum(large, nb - 1)
    return ret + jnp.where(n < max_exact, n, large)


def window_attention(q, k, v, sink, t5_table):
    b, t = q.shape[0], q.shape[1]
    nb = t // BLOCK
    pad = ((0, 0), (BLOCK, BLOCK), (0, 0), (0, 0))
    kp = jnp.pad(k, pad).reshape(b, nb + 2, BLOCK, A_KV_HEADS, HEAD_DIM)
    vp = jnp.pad(v, pad).reshape(b, nb + 2, BLOCK, A_KV_HEADS, HEAD_DIM)
    kw = jnp.concatenate([kp[:, :-2], kp[:, 1:-1], kp[:, 2:]], axis=2)
    vw = jnp.concatenate([vp[:, :-2], vp[:, 1:-1], vp[:, 2:]], axis=2)
    qb = q.reshape(b, nb, BLOCK, A_KV_HEADS, A_GROUP, HEAD_DIM)
    s = jnp.einsum('bnqkgd,bnskd->bnkgqs', qb, kw).astype(jnp.float32) * (HEAD_DIM ** -0.5)
    rel = (jnp.arange(3 * BLOCK)[None, :] - BLOCK) - jnp.arange(BLOCK)[:, None]
    bias = t5_table[t5_bucket(rel)].astype(jnp.float32)
    bias = bias.transpose(2, 0, 1).reshape(A_KV_HEADS, A_GROUP, BLOCK, 3 * BLOCK)
    key_pos = jnp.arange(nb)[:, None] * BLOCK + jnp.arange(3 * BLOCK)[None, :] - BLOCK
    in_range = (key_pos >= 0) & (key_pos < t)
    valid = (jnp.abs(rel) <= WINDOW)[None] & in_range[:, None, :]
    s = jnp.where(valid[None, :, None, None], s + bias, NEG)
    sk = sink.astype(jnp.float32).reshape(A_KV_HEADS, A_GROUP)[None, None, :, :, None, None]
    m = jnp.maximum(s.max(-1, keepdims=True), sk)
    e = jnp.exp(s - m)
    p = e / (e.sum(-1, keepdims=True) + jnp.exp(sk - m))
    o = jnp.einsum('bnkgqs,bnskd->bnqkgd', p.astype(v.dtype), vw)
    return o.reshape(b, t, A_WIDTH)


def neighbourhood_attention(q, k, v, rpb):
    b, t = q.shape[0], q.shape[1]
    rows = t // GRID_W
    kh = min(NA_ROWS_MAX, rows)
    qg = q.reshape(b, rows, GRID_W, B_HEADS, HEAD_DIM)
    kg = k.reshape(b, rows, GRID_W, B_HEADS, HEAD_DIM)
    vg = v.reshape(b, rows, GRID_W, B_HEADS, HEAD_DIM)
    r = jnp.arange(rows)
    row_start = jnp.clip(r - kh // 2, 0, rows - kh)
    key_rows = row_start[:, None] + jnp.arange(kh)[None, :]
    kr = kg[:, key_rows]
    vr = vg[:, key_rows]
    s = jnp.einsum('brqhd,brikhd->brhqik', qg, kr).astype(jnp.float32) * (HEAD_DIM ** -0.5)
    c = jnp.arange(GRID_W)
    col_start = jnp.clip(c - NA_COLS // 2, 0, GRID_W - NA_COLS)
    col_mask = (c[None, :] >= col_start[:, None]) & (c[None, :] < col_start[:, None] + NA_COLS)
    dr = key_rows - r[:, None] + (NA_ROWS_MAX - 1)
    dc = jnp.clip(c[None, :] - c[:, None], -(NA_COLS - 1), NA_COLS - 1) + (NA_COLS - 1)
    bias = rpb[:, dr[:, None, :, None], dc[None, :, None, :]].astype(jnp.float32)
    bias = bias.transpose(1, 0, 2, 3, 4)
    s = jnp.where(col_mask[:, None, :], s + bias[None], NEG)
    p = jax.nn.softmax(s.reshape(b, rows, B_HEADS, GRID_W, kh * GRID_W), axis=-1)
    p = p.reshape(b, rows, B_HEADS, GRID_W, kh, GRID_W).astype(v.dtype)
    o = jnp.einsum('brhqik,brikhd->brqhd', p, vr)
    return o.reshape(b, t, B_WIDTH)


def peer(x, w_q, sub_keys, u, v):
    b, t, d = x.shape
    n = b * t
    xf = x.reshape(n, d)
    q = (xf @ w_q).reshape(n, PEER_HEADS, 2, PEER_QDIM // 2)
    sc = jnp.einsum('nhpc,hpkc->nhpk', q, sub_keys).astype(jnp.float32)
    s_top, i_top = lax.top_k(sc, PEER_TOPK)
    cand = (s_top[:, :, 0, :, None] + s_top[:, :, 1, None, :]).reshape(n, PEER_HEADS, PEER_TOPK * PEER_TOPK)
    cand_idx = (i_top[:, :, 0, :, None] * PEER_N_KEYS + i_top[:, :, 1, None, :]).reshape(
        n, PEER_HEADS, PEER_TOPK * PEER_TOPK)
    fs, fpos = lax.top_k(cand, PEER_TOPK)
    eidx = jnp.take_along_axis(cand_idx, fpos, axis=-1)
    g = jax.nn.softmax(fs, axis=-1)
    nc = n // PEER_CHUNK

    def chunk_fn(args):
        xc, ec, gc = args
        h = jnp.einsum('cd,chkd->chk', xc, u[ec])
        a = (jax.nn.gelu(h.astype(jnp.float32), approximate=False) * gc).astype(xc.dtype)
        return jnp.einsum('chk,chkd->cd', a, v[ec])

    out = lax.map(chunk_fn, (xf.reshape(nc, PEER_CHUNK, d),
                             eidx.reshape(nc, PEER_CHUNK, PEER_HEADS, PEER_TOPK),
                             g.reshape(nc, PEER_CHUNK, PEER_HEADS, PEER_TOPK)))
    return out.reshape(b, t, d)


def setup_inputs(seed: int = 0) -> dict:
    key = jax.random.key(seed)
    ks = jax.random.split(key, 16)
    f32 = jnp.float32
    x = jax.random.normal(ks[0], (BATCH, SEQ, D_MODEL), f32)
    va0 = A_WIDTH + A_KV_WIDTH
    vb0 = A_WIDTH + 2 * A_KV_WIDTH + 2 * B_WIDTH
    col_scale = jnp.ones((PROJ_WIDTH,), f32).at[va0:va0 + A_KV_WIDTH].set(BETA).at[vb0:].set(BETA)
    w_in = jax.random.normal(ks[1], (DEPTH, D_MODEL, PROJ_WIDTH), f32) * (D_MODEL ** -0.5) * col_scale
    w_o = jax.random.normal(ks[2], (DEPTH, MIX_WIDTH, D_MODEL), f32) * (MIX_WIDTH ** -0.5) * BETA
    attn_sink = jax.random.normal(ks[3], (DEPTH, A_HEADS), f32) * 0.5
    na_rpb = jax.random.normal(ks[4], (DEPTH, B_HEADS, 2 * NA_ROWS_MAX - 1, 2 * NA_COLS - 1), f32) * 0.1
    t5_table = jax.random.normal(ks[5], (T5_BUCKETS, A_HEADS), f32) * 0.1
    gnorm_a = 1.0 + 0.02 * jax.random.normal(ks[6], (DEPTH, A_WIDTH), f32)
    gnorm_b = 1.0 + 0.02 * jax.random.normal(ks[7], (DEPTH, B_WIDTH), f32)
    ln1_g = 1.0 + 0.02 * jax.random.normal(ks[8], (DEPTH, D_MODEL), f32)
    ln1_b = 0.02 * jax.random.normal(ks[9], (DEPTH, D_MODEL), f32)
    ln2_g = 1.0 + 0.02 * jax.random.normal(ks[10], (DEPTH, D_MODEL), f32)
    ln2_b = 0.02 * jax.random.normal(ks[11], (DEPTH, D_MODEL), f32)
    peer_wq = jax.random.normal(ks[12], (DEPTH, D_MODEL, PEER_HEADS * PEER_QDIM), f32) * (D_MODEL ** -0.5)
    peer_keys = jax.random.normal(ks[13], (DEPTH, PEER_HEADS, 2, PEER_N_KEYS, PEER_QDIM // 2), f32) * (
        (PEER_QDIM // 2) ** -0.5)
    peer_u = jax.random.normal(ks[14], (DEPTH, PEER_N_EXPERTS, D_MODEL), f32) * (D_MODEL ** -0.5)
    peer_v = jax.random.normal(ks[15], (DEPTH, PEER_N_EXPERTS, D_MODEL), f32) * BETA * (PEER_HEADS ** -0.5)
    return {'x': x, 'w_in': w_in, 'w_o': w_o, 'attn_sink': attn_sink, 'na_rpb': na_rpb,
            't5_table': t5_table, 'gnorm_a': gnorm_a, 'gnorm_b': gnorm_b,
            'ln1_g': ln1_g, 'ln1_b': ln1_b, 'ln2_g': ln2_g, 'ln2_b': ln2_b,
            'peer_wq': peer_wq, 'peer_keys': peer_keys, 'peer_u': peer_u, 'peer_v': peer_v}


def reference(x, w_in, w_o, attn_sink, na_rpb, t5_table, gnorm_a, gnorm_b,
              ln1_g, ln1_b, ln2_g, ln2_b, peer_wq, peer_keys, peer_u, peer_v):
    b, t, _ = x.shape
    o1 = A_WIDTH
    o2 = o1 + A_KV_WIDTH
    o3 = o2 + A_KV_WIDTH
    o4 = o3 + B_WIDTH
    o5 = o4 + B_WIDTH
    for l in range(DEPTH):
        h = x @ w_in[l]
        qa = h[..., :o1].reshape(b, t, A_HEADS, HEAD_DIM)
        ka = h[..., o1:o2].reshape(b, t, A_KV_HEADS, HEAD_DIM)
        va = h[..., o2:o3].reshape(b, t, A_KV_HEADS, HEAD_DIM)
        qb = h[..., o3:o4].reshape(b, t, B_HEADS, HEAD_DIM)
        kb = h[..., o4:o5].reshape(b, t, B_HEADS, HEAD_DIM)
        vb = h[..., o5:].reshape(b, t, B_HEADS, HEAD_DIM)
        ya = window_attention(qa, ka, va, attn_sink[l], t5_table)
        yb = neighbourhood_attention(qb, kb, vb, na_rpb[l])
        mixed = jnp.concatenate([rms_norm(ya, gnorm_a[l]), rms_norm(yb, gnorm_b[l])], axis=-1) @ w_o[l]
        x = layer_norm(ALPHA * x + mixed, ln1_g[l], ln1_b[l])
        x = layer_norm(ALPHA * x + peer(x, peer_wq[l], peer_keys[l], peer_u[l], peer_v[l]), ln2_g[l], ln2_b[l])
    return x
```

```cpp
#include <hip/hip_runtime.h>
#include <stdint.h>

typedef unsigned short bf16_t;
typedef short bf16x8 __attribute__((ext_vector_type(8)));
typedef float f32x4 __attribute__((ext_vector_type(4)));

constexpr int D = 1024, BATCH = 8, SEQ = 4096, DEPTH = 4, NTOK = BATCH * SEQ;
constexpr int HD = 64, PROJ = 2304;
constexpr int O1 = 512, O2 = 640, O3 = 768, O4 = 1280, O5 = 1792;
constexpr int PQ = 2048, NKEYS = 128, NEXP = 16384, TOPK = 16;
constexpr float LN_EPS = 1e-5f;
constexpr float NEGF = -1e30f;
constexpr float ALPHA = 1.6817928305074290f;

__device__ __forceinline__ bf16_t f2bf(float f) { unsigned u = __float_as_uint(f); return (bf16_t)((u + 0x7fffu + ((u >> 16) & 1u)) >> 16); }
__device__ __forceinline__ float bf2f(bf16_t h) { return __uint_as_float(((unsigned)h) << 16); }
__device__ __forceinline__ float wave_sum(float v) {
#pragma unroll
    for (int o = 1; o < 64; o <<= 1) v += __shfl_xor(v, o);
    return v;
}
__device__ __forceinline__ float wave_max(float v) {
#pragma unroll
    for (int o = 1; o < 64; o <<= 1) v = fmaxf(v, __shfl_xor(v, o));
    return v;
}

__global__ __launch_bounds__(256) void cvt_transpose(const float* __restrict__ W, bf16_t* __restrict__ WT, int K, int N) {
    __shared__ float t[32][33];
    const int n0 = blockIdx.x * 32, k0 = blockIdx.y * 32;
    const size_t zoff = (size_t)blockIdx.z * K * N;
    const int tx = threadIdx.x & 31, ty = threadIdx.x >> 5;
    for (int i = ty; i < 32; i += 8) t[i][tx] = W[zoff + (size_t)(k0 + i) * N + n0 + tx];
    __syncthreads();
    for (int i = ty; i < 32; i += 8) WT[zoff + (size_t)(n0 + i) * K + k0 + tx] = f2bf(t[tx][i]);
}
__global__ __launch_bounds__(256) void cvt_bf16(const float* __restrict__ src, bf16_t* __restrict__ dst, size_t n4) {
    size_t i = (size_t)blockIdx.x * 256 + threadIdx.x;
    if (i < n4) {
        f32x4 v = ((const f32x4*)src)[i];
        uint2 o; o.x = f2bf(v[0]) | ((unsigned)f2bf(v[1]) << 16); o.y = f2bf(v[2]) | ((unsigned)f2bf(v[3]) << 16);
        ((uint2*)dst)[i] = o;
    }
}

struct EpiH { bf16_t* H; __device__ void operator()(int r, int c, float v) const { H[(size_t)r * PROJ + c] = f2bf(v); } };
struct EpiZ { const float* x; float* Z; __device__ void operator()(int r, int c, float v) const { size_t i = (size_t)r * D + c; Z[i] = ALPHA * x[i] + v; } };
struct EpiQ { float* Q; __device__ void operator()(int r, int c, float v) const { Q[(size_t)r * PQ + c] = v; } };

template <class Epi, int K>
__global__ __launch_bounds__(256) void gemm_bf16(const bf16_t* __restrict__ A, const bf16_t* __restrict__ Bt, Epi epi) {
    __shared__ __attribute__((aligned(16))) bf16_t sA[128 * 40];
    __shared__ __attribute__((aligned(16))) bf16_t sB[128 * 40];
    const int tid = threadIdx.x, lane = tid & 63, wid = tid >> 6, wm = wid >> 1, wn = wid & 1;
    const int bm = blockIdx.y * 128, bn = blockIdx.x * 128;
    f32x4 acc[4][4];
#pragma unroll
    for (int i = 0; i < 4; ++i)
#pragma unroll
        for (int j = 0; j < 4; ++j) acc[i][j] = (f32x4){0.f, 0.f, 0.f, 0.f};
    for (int k0 = 0; k0 < K; k0 += 32) {
#pragma unroll
        for (int i = 0; i < 2; ++i) {
            const int ch = tid + i * 256, r = ch >> 2, c = (ch & 3) * 8;
            *(uint4*)&sA[r * 40 + c] = *(const uint4*)&A[(size_t)(bm + r) * K + k0 + c];
            *(uint4*)&sB[r * 40 + c] = *(const uint4*)&Bt[(size_t)(bn + r) * K + k0 + c];
        }
        __syncthreads();
        bf16x8 a[4], b[4];
#pragma unroll
        for (int i = 0; i < 4; ++i) {
            a[i] = *(const bf16x8*)&sA[(wm * 64 + i * 16 + (lane & 15)) * 40 + (lane >> 4) * 8];
            b[i] = *(const bf16x8*)&sB[(wn * 64 + i * 16 + (lane & 15)) * 40 + (lane >> 4) * 8];
        }
#pragma unroll
        for (int i = 0; i < 4; ++i)
#pragma unroll
            for (int j = 0; j < 4; ++j) acc[i][j] = __builtin_amdgcn_mfma_f32_16x16x32_bf16(a[i], b[j], acc[i][j], 0, 0, 0);
        __syncthreads();
    }
#pragma unroll
    for (int i = 0; i < 4; ++i)
#pragma unroll
        for (int j = 0; j < 4; ++j)
#pragma unroll
            for (int r = 0; r < 4; ++r) epi(bm + wm * 64 + i * 16 + (lane >> 4) * 4 + r, bn + wn * 64 + j * 16 + (lane & 15), acc[i][j][r]);
}

__device__ __forceinline__ int t5_bucket(int rel) {
    const int n = rel < 0 ? -rel : rel;
    int v;
    if (n < 8) v = n;
    else { int k = 0; k += (n >= 12); k += (n >= 16); k += (n >= 23); k += (n >= 32); k += (n >= 46); k += (n >= 64); k += (n >= 91); v = 8 + k; }
    return (rel > 0 ? 16 : 0) + v;
}
__device__ __forceinline__ float dot64_bf16(const float* qs, const bf16_t* krow) {
    float s = 0.f;
#pragma unroll
    for (int c = 0; c < 8; ++c) {
        const uint4 w = ((const uint4*)krow)[c];
        const unsigned ww[4] = {w.x, w.y, w.z, w.w};
#pragma unroll
        for (int e = 0; e < 4; ++e) { s += qs[c * 8 + 2 * e] * __uint_as_float(ww[e] << 16); s += qs[c * 8 + 2 * e + 1] * __uint_as_float(ww[e] & 0xffff0000u); }
    }
    return s;
}

__global__ __launch_bounds__(256) void attn_window_naive(const bf16_t* __restrict__ H, const float* __restrict__ sink, const float* __restrict__ t5, float* __restrict__ Yraw) {
    __shared__ float qsh[4][64];
    const int lane = threadIdx.x & 63, w = threadIdx.x >> 6;
    const int item = blockIdx.x * 4 + w;
    const int tok = item >> 3, hq = item & 7, kvh = hq >> 2;
    const int b = tok / SEQ, tt = tok % SEQ;
    qsh[w][lane] = bf2f(H[(size_t)tok * PROJ + hq * HD + lane]);
    __syncthreads();
    float s[5];
#pragma unroll
    for (int i = 0; i < 5; ++i) {
        const int j = lane + 64 * i, rel = j - 128, kp = tt + rel;
        const bool valid = (rel <= 128) && kp >= 0 && kp < SEQ;
        float v = NEGF;
        if (valid) {
            const bf16_t* krow = H + (size_t)(b * SEQ + kp) * PROJ + O1 + kvh * HD;
            v = dot64_bf16(qsh[w], krow) * 0.125f + t5[t5_bucket(rel) * 8 + hq];
        }
        s[i] = v;
    }
    const float sk = sink[hq];
    float m = fmaxf(fmaxf(fmaxf(s[0], s[1]), fmaxf(s[2], s[3])), s[4]);
    m = fmaxf(wave_max(m), sk);
    float p[5], sum = 0.f;
#pragma unroll
    for (int i = 0; i < 5; ++i) { p[i] = expf(s[i] - m); sum += p[i]; }
    sum = wave_sum(sum) + expf(sk - m);
    const float inv = 1.f / sum;
    float acc = 0.f;
#pragma unroll
    for (int i = 0; i < 5; ++i) {
        for (int jj = 0; jj < 64; ++jj) {
            const float pj = __shfl(p[i], jj);
            const int rel = jj + 64 * i - 128; const int kp = tt + rel;
            if (rel > 128 || kp < 0 || kp >= SEQ) continue;
            acc += pj * bf2f(H[(size_t)(b * SEQ + kp) * PROJ + O2 + kvh * HD + lane]);
        }
    }
    Yraw[(size_t)tok * D + hq * HD + lane] = acc * inv;
}

__global__ __launch_bounds__(256) void attn_na_naive(const bf16_t* __restrict__ H, const float* __restrict__ rpb, float* __restrict__ Yraw) {
    __shared__ float qsh[4][64];
    const int lane = threadIdx.x & 63, w = threadIdx.x >> 6;
    const int item = blockIdx.x * 4 + w;
    const int tok = item >> 3, hb = item & 7;
    const int b = tok / SEQ, tt = tok % SEQ, r = tt >> 6, c = tt & 63;
    int rs = r - 4; rs = rs < 0 ? 0 : (rs > 56 ? 56 : rs);
    int cs = c - 8; cs = cs < 0 ? 0 : (cs > 48 ? 48 : cs);
    qsh[w][lane] = bf2f(H[(size_t)tok * PROJ + O3 + hb * HD + lane]);
    __syncthreads();
    float s[2];
#pragma unroll
    for (int i = 0; i < 2; ++i) {
        const int j = lane + 64 * i, kr = rs + (j >> 4), kc = cs + (j & 15);
        const bf16_t* krow = H + (size_t)(b * SEQ + kr * 64 + kc) * PROJ + O4 + hb * HD;
        const int dr = kr - r + 7; int dc = kc - c; dc = dc < -15 ? -15 : (dc > 15 ? 15 : dc); dc += 15;
        s[i] = dot64_bf16(qsh[w], krow) * 0.125f + rpb[(hb * 15 + dr) * 31 + dc];
    }
    float m = wave_max(fmaxf(s[0], s[1]));
    float p[2]; p[0] = expf(s[0] - m); p[1] = expf(s[1] - m);
    const float inv = 1.f / wave_sum(p[0] + p[1]);
    float acc = 0.f;
#pragma unroll
    for (int i = 0; i < 2; ++i)
        for (int jj = 0; jj < 64; ++jj) {
            const float pj = __shfl(p[i], jj);
            const int j = jj + 64 * i, kr = rs + (j >> 4), kc = cs + (j & 15);
            acc += pj * bf2f(H[(size_t)(b * SEQ + kr * 64 + kc) * PROJ + O5 + hb * HD + lane]);
        }
    Yraw[(size_t)tok * D + 512 + hb * HD + lane] = acc * inv;
}

__global__ __launch_bounds__(256) void rmsnorm_pair(const float* __restrict__ Yraw, const float* __restrict__ ga, const float* __restrict__ gb, bf16_t* __restrict__ Y) {
    const int lane = threadIdx.x & 63, w = threadIdx.x >> 6, tok = blockIdx.x * 4 + w;
    const float* row = Yraw + (size_t)tok * D;
    float a[8], bb[8], sa = 0.f, sb = 0.f;
#pragma unroll
    for (int i = 0; i < 8; ++i) { a[i] = row[lane + 64 * i]; bb[i] = row[512 + lane + 64 * i]; sa += a[i] * a[i]; sb += bb[i] * bb[i]; }
    const float ra = rsqrtf(wave_sum(sa) * (1.f / 512.f) + LN_EPS), rb = rsqrtf(wave_sum(sb) * (1.f / 512.f) + LN_EPS);
#pragma unroll
    for (int i = 0; i < 8; ++i) {
        Y[(size_t)tok * D + lane + 64 * i] = f2bf(a[i] * ra * ga[lane + 64 * i]);
        Y[(size_t)tok * D + 512 + lane + 64 * i] = f2bf(bb[i] * rb * gb[lane + 64 * i]);
    }
}

__global__ __launch_bounds__(256) void ln_rows(const float* __restrict__ Z, const float* __restrict__ g, const float* __restrict__ bta, float* __restrict__ out, bf16_t* __restrict__ outb) {
    const int lane = threadIdx.x & 63, w = threadIdx.x >> 6, tok = blockIdx.x * 4 + w;
    const f32x4* zr = (const f32x4*)(Z + (size_t)tok * D);
    f32x4 v[4]; float s = 0.f;
#pragma unroll
    for (int j = 0; j < 4; ++j) { v[j] = zr[lane + 64 * j]; s += (v[j][0] + v[j][1]) + (v[j][2] + v[j][3]); }
    const float mean = wave_sum(s) * (1.f / D); float s2 = 0.f;
#pragma unroll
    for (int j = 0; j < 4; ++j) { v[j] = v[j] - mean; s2 += (v[j][0] * v[j][0] + v[j][1] * v[j][1]) + (v[j][2] * v[j][2] + v[j][3] * v[j][3]); }
    const float rstd = rsqrtf(wave_sum(s2) * (1.f / D) + LN_EPS);
#pragma unroll
    for (int j = 0; j < 4; ++j) {
        const f32x4 gg = ((const f32x4*)g)[lane + 64 * j], be = ((const f32x4*)bta)[lane + 64 * j];
        const f32x4 o = v[j] * rstd * gg + be;
        ((f32x4*)(out + (size_t)tok * D))[lane + 64 * j] = o;
        uint2 ob; ob.x = f2bf(o[0]) | ((unsigned)f2bf(o[1]) << 16); ob.y = f2bf(o[2]) | ((unsigned)f2bf(o[3]) << 16);
        ((uint2*)(outb + (size_t)tok * D))[lane + 64 * j] = ob;
    }
}

__device__ __forceinline__ void wave_argmax(float& v, int& i) {
#pragma unroll
    for (int o = 32; o >= 1; o >>= 1) {
        const float ov = __shfl_xor(v, o); const int oi = __shfl_xor(i, o);
        if (ov > v || (ov == v && oi < i)) { v = ov; i = oi; }
    }
}
__global__ __launch_bounds__(256) void peer_topk_naive(const float* __restrict__ Qp, const float* __restrict__ keys, int* __restrict__ eidx, float* __restrict__ gate) {
    __shared__ float qsh[4][128];
    __shared__ float tv[4][2][16];
    __shared__ int ti[4][2][16];
    const int lane = threadIdx.x & 63, w = threadIdx.x >> 6;
    const int item = blockIdx.x * 4 + w, tok = item >> 3, h = item & 7;
    for (int p = 0; p < 2; ++p) {
        const float* q = Qp + (size_t)tok * PQ + h * 256 + p * 128;
        qsh[w][lane] = q[lane]; qsh[w][lane + 64] = q[lane + 64];
        __syncthreads();
        float s[2];
#pragma unroll
        for (int i = 0; i < 2; ++i) {
            const f32x4* kr = (const f32x4*)(keys + ((size_t)(h * 2 + p) * NKEYS + lane + 64 * i) * 128);
            float a = 0.f;
            for (int c = 0; c < 32; ++c) { const f32x4 kk = kr[c]; a += qsh[w][4 * c] * kk[0]; a += qsh[w][4 * c + 1] * kk[1]; a += qsh[w][4 * c + 2] * kk[2]; a += qsh[w][4 * c + 3] * kk[3]; }
            s[i] = a;
        }
        for (int r = 0; r < 16; ++r) {
            float bv; int bi;
            if (s[0] >= s[1]) { bv = s[0]; bi = lane; } else { bv = s[1]; bi = lane + 64; }
            wave_argmax(bv, bi);
            if (bi == lane) s[0] = -INFINITY;
            if (bi == lane + 64) s[1] = -INFINITY;
            if (lane == 0) { tv[w][p][r] = bv; ti[w][p][r] = bi; }
        }
        __syncthreads();
    }
    float cv[4];
#pragma unroll
    for (int j = 0; j < 4; ++j) { const int f = lane * 4 + j; cv[j] = tv[w][0][f >> 4] + tv[w][1][f & 15]; }
    float fs = 0.f; int fp = 0;
    for (int r = 0; r < 16; ++r) {
        float bv = cv[0]; int bi = lane * 4;
#pragma unroll
        for (int j = 1; j < 4; ++j) if (cv[j] > bv) { bv = cv[j]; bi = lane * 4 + j; }
        wave_argmax(bv, bi);
#pragma unroll
        for (int j = 0; j < 4; ++j) if (bi == lane * 4 + j) cv[j] = -INFINITY;
        if (lane == r) { fs = bv; fp = bi; }
    }
    float mv = lane < 16 ? fs : -INFINITY;
    const float m = wave_max(mv);
    const float e = lane < 16 ? expf(fs - m) : 0.f;
    const float sum = wave_sum(e);
    if (lane < 16) {
        const int id = ti[w][0][fp >> 4] * NKEYS + ti[w][1][fp & 15];
        eidx[(size_t)item * 16 + lane] = id;
        gate[(size_t)item * 16 + lane] = e / sum;
    }
}

__global__ __launch_bounds__(256) void peer_gather_naive(const float* __restrict__ x1, const int* __restrict__ eidx, const float* __restrict__ gate,
                                                          const float* __restrict__ U, const float* __restrict__ V, const float* __restrict__ g, const float* __restrict__ bta,
                                                          float* __restrict__ out, bf16_t* __restrict__ outb) {
    const int lane = threadIdx.x & 63, w = threadIdx.x >> 6, tok = blockIdx.x * 4 + w;
    const f32x4* xr = (const f32x4*)(x1 + (size_t)tok * D);
    f32x4 xv[4], acc[4];
#pragma unroll
    for (int j = 0; j < 4; ++j) { xv[j] = xr[lane + 64 * j]; acc[j] = (f32x4){0.f, 0.f, 0.f, 0.f}; }
    for (int k = 0; k < 128; ++k) {
        const int e = eidx[(size_t)tok * 128 + k];
        const float gk = gate[(size_t)tok * 128 + k];
        const f32x4* ur = (const f32x4*)(U + (size_t)e * D);
        const f32x4* vr = (const f32x4*)(V + (size_t)e * D);
        float d = 0.f;
#pragma unroll
        for (int j = 0; j < 4; ++j) { const f32x4 uu = ur[lane + 64 * j]; d += (xv[j][0] * uu[0] + xv[j][1] * uu[1]) + (xv[j][2] * uu[2] + xv[j][3] * uu[3]); }
        d = wave_sum(d);
        const float a = 0.5f * d * (1.f + erff(d * 0.70710678118654752f)) * gk;
#pragma unroll
        for (int j = 0; j < 4; ++j) acc[j] += a * vr[lane + 64 * j];
    }
    float s = 0.f;
#pragma unroll
    for (int j = 0; j < 4; ++j) { acc[j] = ALPHA * xv[j] + acc[j]; s += (acc[j][0] + acc[j][1]) + (acc[j][2] + acc[j][3]); }
    const float mean = wave_sum(s) * (1.f / D); float s2 = 0.f;
#pragma unroll
    for (int j = 0; j < 4; ++j) { acc[j] = acc[j] - mean; s2 += (acc[j][0] * acc[j][0] + acc[j][1] * acc[j][1]) + (acc[j][2] * acc[j][2] + acc[j][3] * acc[j][3]); }
    const float rstd = rsqrtf(wave_sum(s2) * (1.f / D) + LN_EPS);
#pragma unroll
    for (int j = 0; j < 4; ++j) {
        const f32x4 gg = ((const f32x4*)g)[lane + 64 * j], be = ((const f32x4*)bta)[lane + 64 * j];
        const f32x4 o = acc[j] * rstd * gg + be;
        ((f32x4*)(out + (size_t)tok * D))[lane + 64 * j] = o;
        uint2 ob; ob.x = f2bf(o[0]) | ((unsigned)f2bf(o[1]) << 16); ob.y = f2bf(o[2]) | ((unsigned)f2bf(o[3]) << 16);
        ((uint2*)(outb + (size_t)tok * D))[lane + 64 * j] = ob;
    }
}

constexpr size_t MiB = 1u << 20;
constexpr size_t WS_WIN = 0;
constexpr size_t WS_WO = 20 * MiB;
constexpr size_t WS_WQ = 28 * MiB;
constexpr size_t WS_XB = 48 * MiB;
constexpr size_t WS_XA = 112 * MiB;
constexpr size_t WS_X1 = 240 * MiB;
constexpr size_t WS_H = 368 * MiB;
constexpr size_t WS_Y = 512 * MiB;
constexpr size_t WS_Z = 576 * MiB;
constexpr size_t WS_QP = 368 * MiB;
constexpr size_t WS_EI = 704 * MiB;
constexpr size_t WS_GT = 720 * MiB;
constexpr size_t WS_END = 736 * MiB;

extern "C" void kernel_launch(void* const* d_in, const int* in_sizes, int n_in, void* d_out, int out_size, void* d_ws, size_t ws_size, hipStream_t stream) {
    if (n_in != 16 || ws_size < WS_END || out_size != NTOK * D) return;
    const float* x = (const float*)d_in[0];
    const float* w_in = (const float*)d_in[1];
    const float* w_o = (const float*)d_in[2];
    const float* sink = (const float*)d_in[3];
    const float* rpb = (const float*)d_in[4];
    const float* t5 = (const float*)d_in[5];
    const float* ga = (const float*)d_in[6];
    const float* gb = (const float*)d_in[7];
    const float* l1g = (const float*)d_in[8];
    const float* l1b = (const float*)d_in[9];
    const float* l2g = (const float*)d_in[10];
    const float* l2b = (const float*)d_in[11];
    const float* wq = (const float*)d_in[12];
    const float* keys = (const float*)d_in[13];
    const float* pu = (const float*)d_in[14];
    const float* pv = (const float*)d_in[15];
    char* ws = (char*)d_ws;
    bf16_t* WinT = (bf16_t*)(ws + WS_WIN); bf16_t* WoT = (bf16_t*)(ws + WS_WO); bf16_t* WqT = (bf16_t*)(ws + WS_WQ);
    bf16_t* Xb = (bf16_t*)(ws + WS_XB); float* XA = (float*)(ws + WS_XA); float* X1 = (float*)(ws + WS_X1);
    bf16_t* H = (bf16_t*)(ws + WS_H); bf16_t* Y = (bf16_t*)(ws + WS_Y); float* Z = (float*)(ws + WS_Z); float* Qp = (float*)(ws + WS_QP);
    int* EI = (int*)(ws + WS_EI); float* GT = (float*)(ws + WS_GT);

    cvt_transpose<<<dim3(PROJ / 32, D / 32, DEPTH), 256, 0, stream>>>(w_in, WinT, D, PROJ);
    cvt_transpose<<<dim3(D / 32, D / 32, DEPTH), 256, 0, stream>>>(w_o, WoT, D, D);
    cvt_transpose<<<dim3(PQ / 32, D / 32, DEPTH), 256, 0, stream>>>(wq, WqT, D, PQ);
    cvt_bf16<<<(NTOK * D / 4 + 255) / 256, 256, 0, stream>>>(x, Xb, (size_t)NTOK * D / 4);

    for (int l = 0; l < DEPTH; ++l) {
        const float* xin = (l == 0) ? x : XA;
        float* xout = (l == DEPTH - 1) ? (float*)d_out : XA;
        gemm_bf16<EpiH, D><<<dim3(PROJ / 128, NTOK / 128), 256, 0, stream>>>(Xb, WinT + (size_t)l * PROJ * D, EpiH{H});
        attn_window_naive<<<NTOK * 8 / 4, 256, 0, stream>>>(H, sink + l * 8, t5, Z);
        attn_na_naive<<<NTOK * 8 / 4, 256, 0, stream>>>(H, rpb + (size_t)l * 8 * 15 * 31, Z);
        rmsnorm_pair<<<NTOK / 4, 256, 0, stream>>>(Z, ga + l * 512, gb + l * 512, Y);
        gemm_bf16<EpiZ, D><<<dim3(D / 128, NTOK / 128), 256, 0, stream>>>(Y, WoT + (size_t)l * D * D, EpiZ{xin, Z});
        ln_rows<<<NTOK / 4, 256, 0, stream>>>(Z, l1g + l * D, l1b + l * D, X1, Xb);
        gemm_bf16<EpiQ, D><<<dim3(PQ / 128, NTOK / 128), 256, 0, stream>>>(Xb, WqT + (size_t)l * PQ * D, EpiQ{Qp});
        peer_topk_naive<<<NTOK * 8 / 4, 256, 0, stream>>>(Qp, keys + (size_t)l * 8 * 2 * NKEYS * 128, EI, GT);
        peer_gather_naive<<<NTOK / 4, 256, 0, stream>>>(X1, EI, GT, pu + (size_t)l * NEXP * D, pv + (size_t)l * NEXP * D, l2g + l * D, l2b + l * D, xout, Xb);
    }
}
```

```cpp
#include <hip/hip_runtime.h>
#include <hip/hip_cooperative_groups.h>
#include <stdint.h>
#include <cstdio>
namespace cg = cooperative_groups;

typedef unsigned short bf16_t;
typedef short bf16x8 __attribute__((ext_vector_type(8)));
typedef float f32x4 __attribute__((ext_vector_type(4)));

constexpr int D = 1024, BATCH = 8, SEQ = 4096, DEPTH = 4, NTOK = BATCH * SEQ;
constexpr int HD = 64, PROJ = 2304;
constexpr int O1 = 512, O2 = 640, O3 = 768, O4 = 1280, O5 = 1792;
constexpr int PQ = 2048, NKEYS = 128, NEXP = 16384, TOPK = 16;
constexpr float LN_EPS = 1e-5f;
constexpr float NEGF = -1e30f;
constexpr float ALPHA = 1.6817928305074290f;

__device__ __forceinline__ bf16_t f2bf(float f) { unsigned u = __float_as_uint(f); return (bf16_t)((u + 0x7fffu + ((u >> 16) & 1u)) >> 16); }
__device__ __forceinline__ float bf2f(bf16_t h) { return __uint_as_float(((unsigned)h) << 16); }
__device__ __forceinline__ float wave_sum(float v) {
#pragma unroll
    for (int o = 1; o < 64; o <<= 1) v += __shfl_xor(v, o);
    return v;
}
__device__ __forceinline__ float wave_max(float v) {
#pragma unroll
    for (int o = 1; o < 64; o <<= 1) v = fmaxf(v, __shfl_xor(v, o));
    return v;
}


#define LAS __attribute__((address_space(3)))
constexpr int NTHREADS = 512, NWAVES = 8;
constexpr int LDS_BYTES = 147456;

struct Ctx { int tid, lane, wid, bid, G; unsigned char* lds; };
__device__ __forceinline__ Ctx make_ctx(unsigned char* lds) {
    Ctx c; int t = threadIdx.x; asm volatile("" : "+v"(t));
    c.tid = t; c.lane = t & 63; c.wid = __builtin_amdgcn_readfirstlane(t >> 6); c.bid = blockIdx.x; c.G = gridDim.x; c.lds = lds; return c;
}

__device__ __forceinline__ void transpose_item(const float* __restrict__ W, int K, int N, bf16_t* __restrict__ WT, float* scr, int item, int lane) {
    const int nblk = N / 32, kb = item / nblk, nb = item % nblk, k0 = 64 * kb, n0 = 32 * nb;
#pragma unroll 8
    for (int i = 0; i < 32; ++i) { const int kk = 2 * i + (lane >> 5); scr[kk * 33 + (lane & 31)] = W[(size_t)(k0 + kk) * N + n0 + (lane & 31)]; }
    __builtin_amdgcn_fence(__ATOMIC_RELEASE, "wavefront"); __builtin_amdgcn_wave_barrier(); __builtin_amdgcn_fence(__ATOMIC_ACQUIRE, "wavefront");
    const int c = lane & 7;
#pragma unroll
    for (int j = 0; j < 4; ++j) {
        const int n = (lane >> 3) + 8 * j; const float* sp = scr + (8 * c) * 33 + n;
        uint4 o;
        o.x = f2bf(sp[0 * 33]) | ((unsigned)f2bf(sp[1 * 33]) << 16); o.y = f2bf(sp[2 * 33]) | ((unsigned)f2bf(sp[3 * 33]) << 16);
        o.z = f2bf(sp[4 * 33]) | ((unsigned)f2bf(sp[5 * 33]) << 16); o.w = f2bf(sp[6 * 33]) | ((unsigned)f2bf(sp[7 * 33]) << 16);
        *(uint4*)(WT + (size_t)(n0 + n) * K + k0 + 8 * c) = o;
    }
    __builtin_amdgcn_fence(__ATOMIC_RELEASE, "wavefront"); __builtin_amdgcn_wave_barrier(); __builtin_amdgcn_fence(__ATOMIC_ACQUIRE, "wavefront");
}
__device__ __forceinline__ void phase_convert(const Ctx& c, const float* w_in, const float* w_o, const float* wq, const float* x,
                                              bf16_t* WinT, bf16_t* WoT, bf16_t* WqT, bf16_t* Xb) {
    float* scr = (float*)(c.lds + c.wid * 16384);
    const int gw = c.bid * NWAVES + c.wid, NGW = c.G * NWAVES;
    constexpr int I_IN = (D / 64) * (PROJ / 32), I_O = (D / 64) * (D / 32), I_Q = (D / 64) * (PQ / 32);
    constexpr int NIT = DEPTH * (I_IN + I_O + I_Q);
    for (int it = gw; it < NIT; it += NGW) {
        const int l = it / (I_IN + I_O + I_Q); int r = it % (I_IN + I_O + I_Q);
        if (r < I_IN) { transpose_item(w_in + (size_t)l * D * PROJ, D, PROJ, WinT + (size_t)l * PROJ * D, scr, r, c.lane); continue; } r -= I_IN;
        if (r < I_O) { transpose_item(w_o + (size_t)l * D * D, D, D, WoT + (size_t)l * D * D, scr, r, c.lane); continue; } r -= I_O;
        transpose_item(wq + (size_t)l * D * PQ, D, PQ, WqT + (size_t)l * PQ * D, scr, r, c.lane);
    }
    const size_t n4 = (size_t)NTOK * D / 4;
    for (size_t i = (size_t)c.bid * NTHREADS + c.tid; i < n4; i += (size_t)c.G * NTHREADS) {
        const f32x4 v = ((const f32x4*)x)[i];
        uint2 o; o.x = f2bf(v[0]) | ((unsigned)f2bf(v[1]) << 16); o.y = f2bf(v[2]) | ((unsigned)f2bf(v[3]) << 16);
        ((uint2*)Xb)[i] = o;
    }
}

struct EpiH { bf16_t* H; __device__ void operator()(int r, int c, float v) const { H[(size_t)r * PROJ + c] = f2bf(v); } };
struct EpiZ { const float* x; float* Z; __device__ void operator()(int r, int c, float v) const { size_t i = (size_t)r * D + c; Z[i] = ALPHA * x[i] + v; } };
struct EpiQ { float* Q; __device__ void operator()(int r, int c, float v) const { Q[(size_t)r * PQ + c] = v; } };

template <class Epi, int N, int K>
__device__ __forceinline__ void phase_gemm_simple(const Ctx& c, const bf16_t* __restrict__ A, const bf16_t* __restrict__ Bt, Epi epi) {
    const int half = c.tid >> 8, tid = c.tid & 255, lane = c.lane, wid = tid >> 6, wm = wid >> 1, wn = wid & 1;
    bf16_t* sA = (bf16_t*)(c.lds + half * 20480);
    bf16_t* sB = sA + 128 * 40;
    constexpr int nN = N / 128, NT = (NTOK / 128) * nN;
    for (int t0 = c.bid * 2; t0 < NT; t0 += c.G * 2) {
        const int t = t0 + half; const bool live = t < NT;
        const int bm = (t / nN) * 128, bn = (t % nN) * 128;
        f32x4 acc[4][4];
#pragma unroll
        for (int i = 0; i < 4; ++i)
#pragma unroll
            for (int j = 0; j < 4; ++j) acc[i][j] = (f32x4){0.f, 0.f, 0.f, 0.f};
        for (int k0 = 0; k0 < K; k0 += 32) {
            if (live) {
#pragma unroll
                for (int i = 0; i < 2; ++i) {
                    const int ch = tid + i * 256, r = ch >> 2, cc = (ch & 3) * 8;
                    *(uint4*)&sA[r * 40 + cc] = *(const uint4*)&A[(size_t)(bm + r) * K + k0 + cc];
                    *(uint4*)&sB[r * 40 + cc] = *(const uint4*)&Bt[(size_t)(bn + r) * K + k0 + cc];
                }
            }
            __syncthreads();
            bf16x8 a[4], b[4];
#pragma unroll
            for (int i = 0; i < 4; ++i) {
                a[i] = *(const bf16x8*)&sA[(wm * 64 + i * 16 + (lane & 15)) * 40 + (lane >> 4) * 8];
                b[i] = *(const bf16x8*)&sB[(wn * 64 + i * 16 + (lane & 15)) * 40 + (lane >> 4) * 8];
            }
#pragma unroll
            for (int i = 0; i < 4; ++i)
#pragma unroll
                for (int j = 0; j < 4; ++j) acc[i][j] = __builtin_amdgcn_mfma_f32_16x16x32_bf16(a[i], b[j], acc[i][j], 0, 0, 0);
            __syncthreads();
        }
        if (live) {
#pragma unroll
            for (int i = 0; i < 4; ++i)
#pragma unroll
                for (int j = 0; j < 4; ++j)
#pragma unroll
                    for (int r = 0; r < 4; ++r) epi(bm + wm * 64 + i * 16 + (lane >> 4) * 4 + r, bn + wn * 64 + j * 16 + (lane & 15), acc[i][j][r]);
        }
    }
}

__device__ __forceinline__ int t5_bucket(int rel) {
    const int n = rel < 0 ? -rel : rel;
    int v;
    if (n < 8) v = n;
    else { int k = 0; k += (n >= 12); k += (n >= 16); k += (n >= 23); k += (n >= 32); k += (n >= 46); k += (n >= 64); k += (n >= 91); v = 8 + k; }
    return (rel > 0 ? 16 : 0) + v;
}
__device__ __forceinline__ float dot64_bf16(const float* qs, const bf16_t* krow) {
    float s = 0.f;
#pragma unroll
    for (int c = 0; c < 8; ++c) {
        const uint4 w = ((const uint4*)krow)[c];
        const unsigned ww[4] = {w.x, w.y, w.z, w.w};
#pragma unroll
        for (int e = 0; e < 4; ++e) { s += qs[c * 8 + 2 * e] * __uint_as_float(ww[e] << 16); s += qs[c * 8 + 2 * e + 1] * __uint_as_float(ww[e] & 0xffff0000u); }
    }
    return s;
}
#define WAVE_LDS_SYNC() do { __builtin_amdgcn_fence(__ATOMIC_RELEASE, "wavefront"); __builtin_amdgcn_wave_barrier(); __builtin_amdgcn_fence(__ATOMIC_ACQUIRE, "wavefront"); } while (0)

__device__ __forceinline__ void phase_attn_naive(const Ctx& c, const bf16_t* __restrict__ H, const float* __restrict__ sink, const float* __restrict__ t5, const float* __restrict__ rpb, float* __restrict__ Yraw) {
    float* qsh = (float*)(c.lds + c.wid * 256);
    const int lane = c.lane;
    const int gw = c.bid * NWAVES + c.wid, NGW = c.G * NWAVES;
    for (int item = gw; item < NTOK * 16; item += NGW) {
        const int tok = item >> 4, hh = item & 15;
        const int b = tok / SEQ, tt = tok % SEQ;
        if (hh < 8) {
            const int hq = hh, kvh = hq >> 2;
            qsh[lane] = bf2f(H[(size_t)tok * PROJ + hq * HD + lane]);
            WAVE_LDS_SYNC();
            float s[5];
#pragma unroll
            for (int i = 0; i < 5; ++i) {
                const int j = lane + 64 * i, rel = j - 128, kp = tt + rel;
                const bool valid = (rel <= 128) && kp >= 0 && kp < SEQ;
                float v = NEGF;
                if (valid) {
                    const bf16_t* krow = H + (size_t)(b * SEQ + kp) * PROJ + O1 + kvh * HD;
                    v = dot64_bf16(qsh, krow) * 0.125f + t5[t5_bucket(rel) * 8 + hq];
                }
                s[i] = v;
            }
            const float sk = sink[hq];
            float m = fmaxf(fmaxf(fmaxf(s[0], s[1]), fmaxf(s[2], s[3])), s[4]);
            m = fmaxf(wave_max(m), sk);
            float p[5], sum = 0.f;
#pragma unroll
            for (int i = 0; i < 5; ++i) { p[i] = expf(s[i] - m); sum += p[i]; }
            sum = wave_sum(sum) + expf(sk - m);
            const float inv = 1.f / sum;
            float acc = 0.f;
#pragma unroll
            for (int i = 0; i < 5; ++i) {
                for (int jj = 0; jj < 64; ++jj) {
                    const float pj = __shfl(p[i], jj);
                    const int rel = jj + 64 * i - 128; const int kp = tt + rel;
                    if (rel > 128 || kp < 0 || kp >= SEQ) continue;
                    acc += pj * bf2f(H[(size_t)(b * SEQ + kp) * PROJ + O2 + kvh * HD + lane]);
                }
            }
            Yraw[(size_t)tok * D + hq * HD + lane] = acc * inv;
        } else {
            const int hb = hh - 8, r = tt >> 6, cc = tt & 63;
            int rs = r - 4; rs = rs < 0 ? 0 : (rs > 56 ? 56 : rs);
            int cs = cc - 8; cs = cs < 0 ? 0 : (cs > 48 ? 48 : cs);
            qsh[lane] = bf2f(H[(size_t)tok * PROJ + O3 + hb * HD + lane]);
            WAVE_LDS_SYNC();
            float s[2];
#pragma unroll
            for (int i = 0; i < 2; ++i) {
                const int j = lane + 64 * i, kr = rs + (j >> 4), kc = cs + (j & 15);
                const bf16_t* krow = H + (size_t)(b * SEQ + kr * 64 + kc) * PROJ + O4 + hb * HD;
                const int dr = kr - r + 7; int dc = kc - cc; dc = dc < -15 ? -15 : (dc > 15 ? 15 : dc); dc += 15;
                s[i] = dot64_bf16(qsh, krow) * 0.125f + rpb[(hb * 15 + dr) * 31 + dc];
            }
            const float m = wave_max(fmaxf(s[0], s[1]));
            float p[2]; p[0] = expf(s[0] - m); p[1] = expf(s[1] - m);
            const float inv = 1.f / wave_sum(p[0] + p[1]);
            float acc = 0.f;
#pragma unroll
            for (int i = 0; i < 2; ++i)
                for (int jj = 0; jj < 64; ++jj) {
                    const float pj = __shfl(p[i], jj);
                    const int j = jj + 64 * i, kr = rs + (j >> 4), kc = cs + (j & 15);
                    acc += pj * bf2f(H[(size_t)(b * SEQ + kr * 64 + kc) * PROJ + O5 + hb * HD + lane]);
                }
            Yraw[(size_t)tok * D + 512 + hb * HD + lane] = acc * inv;
        }
        WAVE_LDS_SYNC();
    }
}

__device__ __forceinline__ void phase_rmsnorm(const Ctx& c, const float* __restrict__ Yraw, const float* __restrict__ ga, const float* __restrict__ gb, bf16_t* __restrict__ Y) {
    const int lane = c.lane, gw = c.bid * NWAVES + c.wid, NGW = c.G * NWAVES;
    for (int tok = gw; tok < NTOK; tok += NGW) {
        const float* row = Yraw + (size_t)tok * D;
        float a[8], bb[8], sa = 0.f, sb = 0.f;
#pragma unroll
        for (int i = 0; i < 8; ++i) { a[i] = row[lane + 64 * i]; bb[i] = row[512 + lane + 64 * i]; sa += a[i] * a[i]; sb += bb[i] * bb[i]; }
        const float ra = rsqrtf(wave_sum(sa) * (1.f / 512.f) + LN_EPS), rb = rsqrtf(wave_sum(sb) * (1.f / 512.f) + LN_EPS);
#pragma unroll
        for (int i = 0; i < 8; ++i) {
            Y[(size_t)tok * D + lane + 64 * i] = f2bf(a[i] * ra * ga[lane + 64 * i]);
            Y[(size_t)tok * D + 512 + lane + 64 * i] = f2bf(bb[i] * rb * gb[lane + 64 * i]);
        }
    }
}

__device__ __forceinline__ void ln_store_row(f32x4 (&v)[4], int lane, const float* __restrict__ g, const float* __restrict__ bta, float* __restrict__ orow, bf16_t* __restrict__ obrow) {
    float s = 0.f;
#pragma unroll
    for (int j = 0; j < 4; ++j) s += (v[j][0] + v[j][1]) + (v[j][2] + v[j][3]);
    const float mean = wave_sum(s) * (1.f / D); float s2 = 0.f;
#pragma unroll
    for (int j = 0; j < 4; ++j) { v[j] = v[j] - mean; s2 += (v[j][0] * v[j][0] + v[j][1] * v[j][1]) + (v[j][2] * v[j][2] + v[j][3] * v[j][3]); }
    const float rstd = rsqrtf(wave_sum(s2) * (1.f / D) + LN_EPS);
#pragma unroll
    for (int j = 0; j < 4; ++j) {
        const f32x4 gg = ((const f32x4*)g)[lane + 64 * j], be = ((const f32x4*)bta)[lane + 64 * j];
        const f32x4 o = v[j] * rstd * gg + be;
        ((f32x4*)orow)[lane + 64 * j] = o;
        uint2 ob; ob.x = f2bf(o[0]) | ((unsigned)f2bf(o[1]) << 16); ob.y = f2bf(o[2]) | ((unsigned)f2bf(o[3]) << 16);
        ((uint2*)obrow)[lane + 64 * j] = ob;
    }
}
__device__ __forceinline__ void phase_ln(const Ctx& c, const float* __restrict__ Z, const float* __restrict__ g, const float* __restrict__ bta, float* __restrict__ out, bf16_t* __restrict__ outb) {
    const int lane = c.lane, gw = c.bid * NWAVES + c.wid, NGW = c.G * NWAVES;
    for (int tok = gw; tok < NTOK; tok += NGW) {
        const f32x4* zr = (const f32x4*)(Z + (size_t)tok * D);
        f32x4 v[4];
#pragma unroll
        for (int j = 0; j < 4; ++j) v[j] = zr[lane + 64 * j];
        ln_store_row(v, lane, g, bta, out + (size_t)tok * D, outb + (size_t)tok * D);
    }
}

__device__ __forceinline__ void wave_argmax(float& v, int& i) {
#pragma unroll
    for (int o = 32; o >= 1; o >>= 1) {
        const float ov = __shfl_xor(v, o); const int oi = __shfl_xor(i, o);
        if (ov > v || (ov == v && oi < i)) { v = ov; i = oi; }
    }
}
__device__ __forceinline__ void phase_topk_naive(const Ctx& c, const float* __restrict__ Qp, const float* __restrict__ keys, int* __restrict__ eidx, float* __restrict__ gate) {
    float* qsh = (float*)(c.lds + c.wid * 1024);
    float* tv = qsh + 128;
    int* ti = (int*)(tv + 32);
    const int lane = c.lane, gw = c.bid * NWAVES + c.wid, NGW = c.G * NWAVES;
    for (int item = gw; item < NTOK * 8; item += NGW) {
        const int tok = item >> 3, h = item & 7;
        for (int p = 0; p < 2; ++p) {
            const float* q = Qp + (size_t)tok * PQ + h * 256 + p * 128;
            qsh[lane] = q[lane]; qsh[lane + 64] = q[lane + 64];
            WAVE_LDS_SYNC();
            float s[2];
#pragma unroll
            for (int i = 0; i < 2; ++i) {
                const f32x4* kr = (const f32x4*)(keys + ((size_t)(h * 2 + p) * NKEYS + lane + 64 * i) * 128);
                float a = 0.f;
                for (int cc = 0; cc < 32; ++cc) { const f32x4 kk = kr[cc]; a += qsh[4 * cc] * kk[0]; a += qsh[4 * cc + 1] * kk[1]; a += qsh[4 * cc + 2] * kk[2]; a += qsh[4 * cc + 3] * kk[3]; }
                s[i] = a;
            }
            for (int r = 0; r < 16; ++r) {
                float bv; int bi;
                if (s[0] >= s[1]) { bv = s[0]; bi = lane; } else { bv = s[1]; bi = lane + 64; }
                wave_argmax(bv, bi);
                if (bi == lane) s[0] = -INFINITY;
                if (bi == lane + 64) s[1] = -INFINITY;
                if (lane == 0) { tv[p * 16 + r] = bv; ti[p * 16 + r] = bi; }
            }
            WAVE_LDS_SYNC();
        }
        float cv[4];
#pragma unroll
        for (int j = 0; j < 4; ++j) { const int f = lane * 4 + j; cv[j] = tv[f >> 4] + tv[16 + (f & 15)]; }
        float fs = 0.f; int fp = 0;
        for (int r = 0; r < 16; ++r) {
            float bv = cv[0]; int bi = lane * 4;
#pragma unroll
            for (int j = 1; j < 4; ++j) if (cv[j] > bv) { bv = cv[j]; bi = lane * 4 + j; }
            wave_argmax(bv, bi);
#pragma unroll
            for (int j = 0; j < 4; ++j) if (bi == lane * 4 + j) cv[j] = -INFINITY;
            if (lane == r) { fs = bv; fp = bi; }
        }
        const float m = wave_max(lane < 16 ? fs : -INFINITY);
        const float e = lane < 16 ? expf(fs - m) : 0.f;
        const float sum = wave_sum(e);
        if (lane < 16) {
            const int id = ti[fp >> 4] * NKEYS + ti[16 + (fp & 15)];
            eidx[(size_t)item * 16 + lane] = id;
            gate[(size_t)item * 16 + lane] = e / sum;
        }
        WAVE_LDS_SYNC();
    }
}

__device__ __forceinline__ void phase_gather_naive(const Ctx& c, const float* __restrict__ x1, const int* __restrict__ eidx, const float* __restrict__ gate,
                                                   const float* __restrict__ U, const float* __restrict__ V, const float* __restrict__ g, const float* __restrict__ bta,
                                                   float* __restrict__ out, bf16_t* __restrict__ outb) {
    const int lane = c.lane, gw = c.bid * NWAVES + c.wid, NGW = c.G * NWAVES;
    for (int tok = gw; tok < NTOK; tok += NGW) {
        const f32x4* xr = (const f32x4*)(x1 + (size_t)tok * D);
        f32x4 xv[4], acc[4];
#pragma unroll
        for (int j = 0; j < 4; ++j) { xv[j] = xr[lane + 64 * j]; acc[j] = (f32x4){0.f, 0.f, 0.f, 0.f}; }
        for (int k = 0; k < 128; ++k) {
            const int e = eidx[(size_t)tok * 128 + k];
            const float gk = gate[(size_t)tok * 128 + k];
            const f32x4* ur = (const f32x4*)(U + (size_t)e * D);
            const f32x4* vr = (const f32x4*)(V + (size_t)e * D);
            float d = 0.f;
#pragma unroll
            for (int j = 0; j < 4; ++j) { const f32x4 uu = ur[lane + 64 * j]; d += (xv[j][0] * uu[0] + xv[j][1] * uu[1]) + (xv[j][2] * uu[2] + xv[j][3] * uu[3]); }
            d = wave_sum(d);
            const float a = 0.5f * d * (1.f + erff(d * 0.70710678118654752f)) * gk;
#pragma unroll
            for (int j = 0; j < 4; ++j) acc[j] += a * vr[lane + 64 * j];
        }
#pragma unroll
        for (int j = 0; j < 4; ++j) acc[j] = ALPHA * xv[j] + acc[j];
        ln_store_row(acc, lane, g, bta, out + (size_t)tok * D, outb + (size_t)tok * D);
    }
}

constexpr size_t MiB = 1u << 20;
constexpr size_t WS_WIN = 0;
constexpr size_t WS_WO = 20 * MiB;
constexpr size_t WS_WQ = 28 * MiB;
constexpr size_t WS_XB = 48 * MiB;
constexpr size_t WS_XA = 112 * MiB;
constexpr size_t WS_X1 = 240 * MiB;
constexpr size_t WS_H = 368 * MiB;
constexpr size_t WS_Y = 512 * MiB;
constexpr size_t WS_Z = 576 * MiB;
constexpr size_t WS_QP = 368 * MiB;
constexpr size_t WS_EI = 704 * MiB;
constexpr size_t WS_GT = 720 * MiB;
constexpr size_t WS_END = 736 * MiB;

struct Params { const float* in[16]; float* out; unsigned char* ws; };

__global__ void __launch_bounds__(NTHREADS, 2) mega_fwd(Params P) {
    extern __shared__ __attribute__((aligned(16))) unsigned char lds[];
    cg::grid_group grid = cg::this_grid();
    const float* x = P.in[0]; const float* w_in = P.in[1]; const float* w_o = P.in[2]; const float* sink = P.in[3]; const float* rpb = P.in[4]; const float* t5 = P.in[5];
    const float* ga = P.in[6]; const float* gb = P.in[7]; const float* l1g = P.in[8]; const float* l1b = P.in[9]; const float* l2g = P.in[10]; const float* l2b = P.in[11];
    const float* wq = P.in[12]; const float* keys = P.in[13]; const float* pu = P.in[14]; const float* pv = P.in[15];
    unsigned char* ws = P.ws;
    bf16_t* WinT = (bf16_t*)(ws + WS_WIN); bf16_t* WoT = (bf16_t*)(ws + WS_WO); bf16_t* WqT = (bf16_t*)(ws + WS_WQ);
    bf16_t* Xb = (bf16_t*)(ws + WS_XB); float* XA = (float*)(ws + WS_XA); float* X1 = (float*)(ws + WS_X1);
    bf16_t* H = (bf16_t*)(ws + WS_H); bf16_t* Y = (bf16_t*)(ws + WS_Y); float* Z = (float*)(ws + WS_Z); float* Qp = (float*)(ws + WS_QP);
    int* EI = (int*)(ws + WS_EI); float* GT = (float*)(ws + WS_GT);

    phase_convert(make_ctx(lds), w_in, w_o, wq, x, WinT, WoT, WqT, Xb);
    grid.sync();
#pragma unroll 1
    for (int l = 0; l < DEPTH; ++l) {
        const float* xin = (l == 0) ? x : XA;
        float* xout = (l == DEPTH - 1) ? P.out : XA;
        phase_gemm_simple<EpiH, PROJ, D>(make_ctx(lds), Xb, WinT + (size_t)l * PROJ * D, EpiH{H});
        grid.sync();
        phase_attn_naive(make_ctx(lds), H, sink + l * 8, t5, rpb + (size_t)l * 8 * 15 * 31, Z);
        grid.sync();
        phase_rmsnorm(make_ctx(lds), Z, ga + l * 512, gb + l * 512, Y);
        grid.sync();
        phase_gemm_simple<EpiZ, D, D>(make_ctx(lds), Y, WoT + (size_t)l * D * D, EpiZ{xin, Z});
        grid.sync();
        phase_ln(make_ctx(lds), Z, l1g + l * D, l1b + l * D, X1, Xb);
        grid.sync();
        phase_gemm_simple<EpiQ, PQ, D>(make_ctx(lds), Xb, WqT + (size_t)l * PQ * D, EpiQ{Qp});
        grid.sync();
        phase_topk_naive(make_ctx(lds), Qp, keys + (size_t)l * 8 * 2 * NKEYS * 128, EI, GT);
        grid.sync();
        phase_gather_naive(make_ctx(lds), X1, EI, GT, pu + (size_t)l * NEXP * D, pv + (size_t)l * NEXP * D, l2g + l * D, l2b + l * D, xout, Xb);
        grid.sync();
    }
}

extern "C" void kernel_launch(void* const* d_in, const int* in_sizes, int n_in, void* d_out, int out_size, void* d_ws, size_t ws_size, hipStream_t stream) {
    static int grid = 0;
    if (grid == 0) {
        if (n_in != 16 || ws_size < WS_END || out_size != NTOK * D) { fprintf(stderr, "kernel_launch: unexpected shapes\n"); grid = -1; return; }
        int dev = 0, cus = 0, per_cu = 0;
        hipGetDevice(&dev);
        hipDeviceGetAttribute(&cus, hipDeviceAttributeMultiprocessorCount, dev);
        hipFuncSetAttribute((const void*)mega_fwd, hipFuncAttributeMaxDynamicSharedMemorySize, LDS_BYTES);
        hipOccupancyMaxActiveBlocksPerMultiprocessor(&per_cu, (const void*)mega_fwd, NTHREADS, LDS_BYTES);
        if (per_cu < 1) { fprintf(stderr, "kernel_launch: occupancy query says %d blocks/CU\n", per_cu); grid = -1; return; }
        grid = cus;
    }
    if (grid < 0) return;
    Params P{};
    for (int i = 0; i < 16; ++i) P.in[i] = (const float*)d_in[i];
    P.out = (float*)d_out; P.ws = (unsigned char*)d_ws;
    void* args[] = {&P};
    hipError_t e = hipLaunchCooperativeKernel((const void*)mega_fwd, dim3(grid), dim3(NTHREADS), args, LDS_BYTES, stream);
    if (e != hipSuccess) fprintf(stderr, "cooperative launch failed: %s (grid %d)\n", hipGetErrorString(e), grid);
}
```

```cpp
#include <hip/hip_runtime.h>
#include <hip/hip_cooperative_groups.h>
#include <stdint.h>
#include <cstdio>
namespace cg = cooperative_groups;

typedef unsigned short bf16_t;
typedef short bf16x8 __attribute__((ext_vector_type(8)));
typedef float f32x4 __attribute__((ext_vector_type(4)));

constexpr int D = 1024, BATCH = 8, SEQ = 4096, DEPTH = 4, NTOK = BATCH * SEQ;
constexpr int HD = 64, PROJ = 2304;
constexpr int O1 = 512, O2 = 640, O3 = 768, O4 = 1280, O5 = 1792;
constexpr int PQ = 2048, NKEYS = 128, NEXP = 16384, TOPK = 16;
constexpr float LN_EPS = 1e-5f;
constexpr float NEGF = -1e30f;
constexpr float ALPHA = 1.6817928305074290f;

__device__ __forceinline__ bf16_t f2bf(float f) { unsigned u = __float_as_uint(f); return (bf16_t)((u + 0x7fffu + ((u >> 16) & 1u)) >> 16); }
__device__ __forceinline__ float bf2f(bf16_t h) { return __uint_as_float(((unsigned)h) << 16); }
__device__ __forceinline__ float wave_sum(float v) {
#pragma unroll
    for (int o = 1; o < 64; o <<= 1) v += __shfl_xor(v, o);
    return v;
}
__device__ __forceinline__ float wave_max(float v) {
#pragma unroll
    for (int o = 1; o < 64; o <<= 1) v = fmaxf(v, __shfl_xor(v, o));
    return v;
}


#define LAS __attribute__((address_space(3)))
typedef float f32x2 __attribute__((ext_vector_type(2)));
typedef unsigned u32x4 __attribute__((ext_vector_type(4)));
constexpr float XS = 8.f, US = 64.f, VS = 16.f;
__device__ __forceinline__ unsigned pack4_fp8(f32x4 v, float sc) {
    v = v * sc;
#pragma unroll
    for (int i = 0; i < 4; ++i) v[i] = fminf(fmaxf(v[i], -448.f), 448.f);
    unsigned p = 0;
    p = __builtin_amdgcn_cvt_pk_fp8_f32(v[0], v[1], p, false);
    p = __builtin_amdgcn_cvt_pk_fp8_f32(v[2], v[3], p, true);
    return p;
}
constexpr int NTHREADS = 512, NWAVES = 8;
constexpr int LDS_BYTES = 147456;

struct Ctx { int tid, lane, wid, bid, G; unsigned char* lds; };
__device__ __forceinline__ Ctx make_ctx(unsigned char* lds) {
    Ctx c; int t = threadIdx.x; asm volatile("" : "+v"(t));
    c.tid = t; c.lane = t & 63; c.wid = __builtin_amdgcn_readfirstlane(t >> 6); c.bid = blockIdx.x; c.G = gridDim.x; c.lds = lds; return c;
}

__device__ __forceinline__ void transpose_item(const float* __restrict__ W, int K, int N, bf16_t* __restrict__ WT, float* scr, int item, int lane) {
    const int nblk = N / 32, kb = item / nblk, nb = item % nblk, k0 = 64 * kb, n0 = 32 * nb;
#pragma unroll 8
    for (int i = 0; i < 32; ++i) { const int kk = 2 * i + (lane >> 5); scr[kk * 33 + (lane & 31)] = W[(size_t)(k0 + kk) * N + n0 + (lane & 31)]; }
    __builtin_amdgcn_fence(__ATOMIC_RELEASE, "wavefront"); __builtin_amdgcn_wave_barrier(); __builtin_amdgcn_fence(__ATOMIC_ACQUIRE, "wavefront");
    const int c = lane & 7;
#pragma unroll
    for (int j = 0; j < 4; ++j) {
        const int n = (lane >> 3) + 8 * j; const float* sp = scr + (8 * c) * 33 + n;
        uint4 o;
        o.x = f2bf(sp[0 * 33]) | ((unsigned)f2bf(sp[1 * 33]) << 16); o.y = f2bf(sp[2 * 33]) | ((unsigned)f2bf(sp[3 * 33]) << 16);
        o.z = f2bf(sp[4 * 33]) | ((unsigned)f2bf(sp[5 * 33]) << 16); o.w = f2bf(sp[6 * 33]) | ((unsigned)f2bf(sp[7 * 33]) << 16);
        *(uint4*)(WT + (size_t)(n0 + n) * K + k0 + 8 * c) = o;
    }
    __builtin_amdgcn_fence(__ATOMIC_RELEASE, "wavefront"); __builtin_amdgcn_wave_barrier(); __builtin_amdgcn_fence(__ATOMIC_ACQUIRE, "wavefront");
}
__device__ __forceinline__ void phase_convert(const Ctx& c, const float* w_in, const float* w_o, const float* wq, const float* x, const float* pu, const float* pv,
                                              bf16_t* WinT, bf16_t* WoT, bf16_t* WqT, bf16_t* Xb, unsigned char* U8, unsigned char* V8) {
    float* scr = (float*)(c.lds + c.wid * 16384);
    const int gw = c.bid * NWAVES + c.wid, NGW = c.G * NWAVES;
    constexpr int I_IN = (D / 64) * (PROJ / 32), I_O = (D / 64) * (D / 32), I_Q = (D / 64) * (PQ / 32);
    constexpr int NIT = DEPTH * (I_IN + I_O + I_Q);
    for (int it = gw; it < NIT; it += NGW) {
        const int l = it / (I_IN + I_O + I_Q); int r = it % (I_IN + I_O + I_Q);
        if (r < I_IN) { transpose_item(w_in + (size_t)l * D * PROJ, D, PROJ, WinT + (size_t)l * PROJ * D, scr, r, c.lane); continue; } r -= I_IN;
        if (r < I_O) { transpose_item(w_o + (size_t)l * D * D, D, D, WoT + (size_t)l * D * D, scr, r, c.lane); continue; } r -= I_O;
        transpose_item(wq + (size_t)l * D * PQ, D, PQ, WqT + (size_t)l * PQ * D, scr, r, c.lane);
    }
    const size_t n4 = (size_t)NTOK * D / 4;
    for (size_t i = (size_t)c.bid * NTHREADS + c.tid; i < n4; i += (size_t)c.G * NTHREADS) {
        const f32x4 v = ((const f32x4*)x)[i];
        uint2 o; o.x = f2bf(v[0]) | ((unsigned)f2bf(v[1]) << 16); o.y = f2bf(v[2]) | ((unsigned)f2bf(v[3]) << 16);
        ((uint2*)Xb)[i] = o;
    }
    const size_t n16 = (size_t)DEPTH * NEXP * D / 16;
    for (size_t i = (size_t)c.bid * NTHREADS + c.tid; i < n16; i += (size_t)c.G * NTHREADS) {
        const f32x4* pa = (const f32x4*)pu + 4 * i; const f32x4* pb = (const f32x4*)pv + 4 * i;
        uint4 oa, ob;
        oa.x = pack4_fp8(pa[0], US); oa.y = pack4_fp8(pa[1], US); oa.z = pack4_fp8(pa[2], US); oa.w = pack4_fp8(pa[3], US);
        ob.x = pack4_fp8(pb[0], VS); ob.y = pack4_fp8(pb[1], VS); ob.z = pack4_fp8(pb[2], VS); ob.w = pack4_fp8(pb[3], VS);
        ((uint4*)U8)[i] = oa; ((uint4*)V8)[i] = ob;
    }
}

struct EpiH { bf16_t* H; __device__ void operator()(int r, int c, float v) const { H[(size_t)r * PROJ + c] = f2bf(v); } };
struct EpiZ { const float* x; float* Z; __device__ void operator()(int r, int c, float v) const { size_t i = (size_t)r * D + c; Z[i] = ALPHA * x[i] + v; } };
struct EpiQ { float* Q; __device__ void operator()(int r, int c, float v) const { Q[(size_t)r * PQ + c] = v; } };

template <class Epi, int N, int K>
__device__ __forceinline__ void phase_gemm_simple(const Ctx& c, const bf16_t* __restrict__ A, const bf16_t* __restrict__ Bt, Epi epi) {
    const int half = c.tid >> 8, tid = c.tid & 255, lane = c.lane, wid = tid >> 6, wm = wid >> 1, wn = wid & 1;
    bf16_t* sA = (bf16_t*)(c.lds + half * 20480);
    bf16_t* sB = sA + 128 * 40;
    constexpr int nN = N / 128, NT = (NTOK / 128) * nN;
    for (int t0 = c.bid * 2; t0 < NT; t0 += c.G * 2) {
        const int t = t0 + half; const bool live = t < NT;
        const int bm = (t / nN) * 128, bn = (t % nN) * 128;
        f32x4 acc[4][4];
#pragma unroll
        for (int i = 0; i < 4; ++i)
#pragma unroll
            for (int j = 0; j < 4; ++j) acc[i][j] = (f32x4){0.f, 0.f, 0.f, 0.f};
        for (int k0 = 0; k0 < K; k0 += 32) {
            if (live) {
#pragma unroll
                for (int i = 0; i < 2; ++i) {
                    const int ch = tid + i * 256, r = ch >> 2, cc = (ch & 3) * 8;
                    *(uint4*)&sA[r * 40 + cc] = *(const uint4*)&A[(size_t)(bm + r) * K + k0 + cc];
                    *(uint4*)&sB[r * 40 + cc] = *(const uint4*)&Bt[(size_t)(bn + r) * K + k0 + cc];
                }
            }
            __syncthreads();
            bf16x8 a[4], b[4];
#pragma unroll
            for (int i = 0; i < 4; ++i) {
                a[i] = *(const bf16x8*)&sA[(wm * 64 + i * 16 + (lane & 15)) * 40 + (lane >> 4) * 8];
                b[i] = *(const bf16x8*)&sB[(wn * 64 + i * 16 + (lane & 15)) * 40 + (lane >> 4) * 8];
            }
#pragma unroll
            for (int i = 0; i < 4; ++i)
#pragma unroll
                for (int j = 0; j < 4; ++j) acc[i][j] = __builtin_amdgcn_mfma_f32_16x16x32_bf16(a[i], b[j], acc[i][j], 0, 0, 0);
            __syncthreads();
        }
        if (live) {
#pragma unroll
            for (int i = 0; i < 4; ++i)
#pragma unroll
                for (int j = 0; j < 4; ++j)
#pragma unroll
                    for (int r = 0; r < 4; ++r) epi(bm + wm * 64 + i * 16 + (lane >> 4) * 4 + r, bn + wn * 64 + j * 16 + (lane & 15), acc[i][j][r]);
        }
    }
}

__device__ __forceinline__ int t5_bucket(int rel) {
    const int n = rel < 0 ? -rel : rel;
    int v;
    if (n < 8) v = n;
    else { int k = 0; k += (n >= 12); k += (n >= 16); k += (n >= 23); k += (n >= 32); k += (n >= 46); k += (n >= 64); k += (n >= 91); v = 8 + k; }
    return (rel > 0 ? 16 : 0) + v;
}
__device__ __forceinline__ float dot64_bf16(const float* qs, const bf16_t* krow) {
    float s = 0.f;
#pragma unroll
    for (int c = 0; c < 8; ++c) {
        const uint4 w = ((const uint4*)krow)[c];
        const unsigned ww[4] = {w.x, w.y, w.z, w.w};
#pragma unroll
        for (int e = 0; e < 4; ++e) { s += qs[c * 8 + 2 * e] * __uint_as_float(ww[e] << 16); s += qs[c * 8 + 2 * e + 1] * __uint_as_float(ww[e] & 0xffff0000u); }
    }
    return s;
}
#define WAVE_LDS_SYNC() do { __builtin_amdgcn_fence(__ATOMIC_RELEASE, "wavefront"); __builtin_amdgcn_wave_barrier(); __builtin_amdgcn_fence(__ATOMIC_ACQUIRE, "wavefront"); } while (0)

__device__ __forceinline__ void phase_attn_naive(const Ctx& c, const bf16_t* __restrict__ H, const float* __restrict__ sink, const float* __restrict__ t5, const float* __restrict__ rpb, float* __restrict__ Yraw) {
    float* qsh = (float*)(c.lds + c.wid * 256);
    const int lane = c.lane;
    const int gw = c.bid * NWAVES + c.wid, NGW = c.G * NWAVES;
    for (int item = gw; item < NTOK * 16; item += NGW) {
        const int tok = item >> 4, hh = item & 15;
        const int b = tok / SEQ, tt = tok % SEQ;
        if (hh < 8) {
            const int hq = hh, kvh = hq >> 2;
            qsh[lane] = bf2f(H[(size_t)tok * PROJ + hq * HD + lane]);
            WAVE_LDS_SYNC();
            float s[5];
#pragma unroll
            for (int i = 0; i < 5; ++i) {
                const int j = lane + 64 * i, rel = j - 128, kp = tt + rel;
                const bool valid = (rel <= 128) && kp >= 0 && kp < SEQ;
                float v = NEGF;
                if (valid) {
                    const bf16_t* krow = H + (size_t)(b * SEQ + kp) * PROJ + O1 + kvh * HD;
                    v = dot64_bf16(qsh, krow) * 0.125f + t5[t5_bucket(rel) * 8 + hq];
                }
                s[i] = v;
            }
            const float sk = sink[hq];
            float m = fmaxf(fmaxf(fmaxf(s[0], s[1]), fmaxf(s[2], s[3])), s[4]);
            m = fmaxf(wave_max(m), sk);
            float p[5], sum = 0.f;
#pragma unroll
            for (int i = 0; i < 5; ++i) { p[i] = expf(s[i] - m); sum += p[i]; }
            sum = wave_sum(sum) + expf(sk - m);
            const float inv = 1.f / sum;
            float acc = 0.f;
#pragma unroll
            for (int i = 0; i < 5; ++i) {
                for (int jj = 0; jj < 64; ++jj) {
                    const float pj = __shfl(p[i], jj);
                    const int rel = jj + 64 * i - 128; const int kp = tt + rel;
                    if (rel > 128 || kp < 0 || kp >= SEQ) continue;
                    acc += pj * bf2f(H[(size_t)(b * SEQ + kp) * PROJ + O2 + kvh * HD + lane]);
                }
            }
            Yraw[(size_t)tok * D + hq * HD + lane] = acc * inv;
        } else {
            const int hb = hh - 8, r = tt >> 6, cc = tt & 63;
            int rs = r - 4; rs = rs < 0 ? 0 : (rs > 56 ? 56 : rs);
            int cs = cc - 8; cs = cs < 0 ? 0 : (cs > 48 ? 48 : cs);
            qsh[lane] = bf2f(H[(size_t)tok * PROJ + O3 + hb * HD + lane]);
            WAVE_LDS_SYNC();
            float s[2];
#pragma unroll
            for (int i = 0; i < 2; ++i) {
                const int j = lane + 64 * i, kr = rs + (j >> 4), kc = cs + (j & 15);
                const bf16_t* krow = H + (size_t)(b * SEQ + kr * 64 + kc) * PROJ + O4 + hb * HD;
                const int dr = kr - r + 7; int dc = kc - cc; dc = dc < -15 ? -15 : (dc > 15 ? 15 : dc); dc += 15;
                s[i] = dot64_bf16(qsh, krow) * 0.125f + rpb[(hb * 15 + dr) * 31 + dc];
            }
            const float m = wave_max(fmaxf(s[0], s[1]));
            float p[2]; p[0] = expf(s[0] - m); p[1] = expf(s[1] - m);
            const float inv = 1.f / wave_sum(p[0] + p[1]);
            float acc = 0.f;
#pragma unroll
            for (int i = 0; i < 2; ++i)
                for (int jj = 0; jj < 64; ++jj) {
                    const float pj = __shfl(p[i], jj);
                    const int j = jj + 64 * i, kr = rs + (j >> 4), kc = cs + (j & 15);
                    acc += pj * bf2f(H[(size_t)(b * SEQ + kr * 64 + kc) * PROJ + O5 + hb * HD + lane]);
                }
            Yraw[(size_t)tok * D + 512 + hb * HD + lane] = acc * inv;
        }
        WAVE_LDS_SYNC();
    }
}

__device__ __forceinline__ void phase_rmsnorm(const Ctx& c, const float* __restrict__ Yraw, const float* __restrict__ ga, const float* __restrict__ gb, bf16_t* __restrict__ Y) {
    const int lane = c.lane, gw = c.bid * NWAVES + c.wid, NGW = c.G * NWAVES;
    for (int tok = gw; tok < NTOK; tok += NGW) {
        const float* row = Yraw + (size_t)tok * D;
        float a[8], bb[8], sa = 0.f, sb = 0.f;
#pragma unroll
        for (int i = 0; i < 8; ++i) { a[i] = row[lane + 64 * i]; bb[i] = row[512 + lane + 64 * i]; sa += a[i] * a[i]; sb += bb[i] * bb[i]; }
        const float ra = rsqrtf(wave_sum(sa) * (1.f / 512.f) + LN_EPS), rb = rsqrtf(wave_sum(sb) * (1.f / 512.f) + LN_EPS);
#pragma unroll
        for (int i = 0; i < 8; ++i) {
            Y[(size_t)tok * D + lane + 64 * i] = f2bf(a[i] * ra * ga[lane + 64 * i]);
            Y[(size_t)tok * D + 512 + lane + 64 * i] = f2bf(bb[i] * rb * gb[lane + 64 * i]);
        }
    }
}

__device__ __forceinline__ void ln_store_row(f32x4 (&v)[4], int lane, const float* __restrict__ g, const float* __restrict__ bta, float* __restrict__ orow, bf16_t* __restrict__ obrow, unsigned char* __restrict__ o8row) {
    float s = 0.f;
#pragma unroll
    for (int j = 0; j < 4; ++j) s += (v[j][0] + v[j][1]) + (v[j][2] + v[j][3]);
    const float mean = wave_sum(s) * (1.f / D); float s2 = 0.f;
#pragma unroll
    for (int j = 0; j < 4; ++j) { v[j] = v[j] - mean; s2 += (v[j][0] * v[j][0] + v[j][1] * v[j][1]) + (v[j][2] * v[j][2] + v[j][3] * v[j][3]); }
    const float rstd = rsqrtf(wave_sum(s2) * (1.f / D) + LN_EPS);
#pragma unroll
    for (int j = 0; j < 4; ++j) {
        const f32x4 gg = ((const f32x4*)g)[lane + 64 * j], be = ((const f32x4*)bta)[lane + 64 * j];
        const f32x4 o = v[j] * rstd * gg + be;
        ((f32x4*)orow)[lane + 64 * j] = o;
        uint2 ob; ob.x = f2bf(o[0]) | ((unsigned)f2bf(o[1]) << 16); ob.y = f2bf(o[2]) | ((unsigned)f2bf(o[3]) << 16);
        ((uint2*)obrow)[lane + 64 * j] = ob;
        if (o8row) ((unsigned*)o8row)[lane + 64 * j] = pack4_fp8(o, XS);
    }
}
__device__ __forceinline__ void phase_ln(const Ctx& c, const float* __restrict__ Z, const float* __restrict__ g, const float* __restrict__ bta, float* __restrict__ out, bf16_t* __restrict__ outb, unsigned char* __restrict__ out8) {
    const int lane = c.lane, gw = c.bid * NWAVES + c.wid, NGW = c.G * NWAVES;
    for (int tok = gw; tok < NTOK; tok += NGW) {
        const f32x4* zr = (const f32x4*)(Z + (size_t)tok * D);
        f32x4 v[4];
#pragma unroll
        for (int j = 0; j < 4; ++j) v[j] = zr[lane + 64 * j];
        ln_store_row(v, lane, g, bta, out + (size_t)tok * D, outb + (size_t)tok * D, out8 + (size_t)tok * D);
    }
}

__device__ __forceinline__ void wave_argmax(float& v, int& i) {
#pragma unroll
    for (int o = 32; o >= 1; o >>= 1) {
        const float ov = __shfl_xor(v, o); const int oi = __shfl_xor(i, o);
        if (ov > v || (ov == v && oi < i)) { v = ov; i = oi; }
    }
}
__device__ __forceinline__ void phase_topk_naive(const Ctx& c, const float* __restrict__ Qp, const float* __restrict__ keys, int* __restrict__ eidx, float* __restrict__ gate) {
    float* qsh = (float*)(c.lds + c.wid * 1024);
    float* tv = qsh + 128;
    int* ti = (int*)(tv + 32);
    const int lane = c.lane, gw = c.bid * NWAVES + c.wid, NGW = c.G * NWAVES;
    for (int item = gw; item < NTOK * 8; item += NGW) {
        const int tok = item >> 3, h = item & 7;
        for (int p = 0; p < 2; ++p) {
            const float* q = Qp + (size_t)tok * PQ + h * 256 + p * 128;
            qsh[lane] = q[lane]; qsh[lane + 64] = q[lane + 64];
            WAVE_LDS_SYNC();
            float s[2];
#pragma unroll
            for (int i = 0; i < 2; ++i) {
                const f32x4* kr = (const f32x4*)(keys + ((size_t)(h * 2 + p) * NKEYS + lane + 64 * i) * 128);
                float a = 0.f;
                for (int cc = 0; cc < 32; ++cc) { const f32x4 kk = kr[cc]; a += qsh[4 * cc] * kk[0]; a += qsh[4 * cc + 1] * kk[1]; a += qsh[4 * cc + 2] * kk[2]; a += qsh[4 * cc + 3] * kk[3]; }
                s[i] = a;
            }
            for (int r = 0; r < 16; ++r) {
                float bv; int bi;
                if (s[0] >= s[1]) { bv = s[0]; bi = lane; } else { bv = s[1]; bi = lane + 64; }
                wave_argmax(bv, bi);
                if (bi == lane) s[0] = -INFINITY;
                if (bi == lane + 64) s[1] = -INFINITY;
                if (lane == 0) { tv[p * 16 + r] = bv; ti[p * 16 + r] = bi; }
            }
            WAVE_LDS_SYNC();
        }
        float cv[4];
#pragma unroll
        for (int j = 0; j < 4; ++j) { const int f = lane * 4 + j; cv[j] = tv[f >> 4] + tv[16 + (f & 15)]; }
        float fs = 0.f; int fp = 0;
        for (int r = 0; r < 16; ++r) {
            float bv = cv[0]; int bi = lane * 4;
#pragma unroll
            for (int j = 1; j < 4; ++j) if (cv[j] > bv) { bv = cv[j]; bi = lane * 4 + j; }
            wave_argmax(bv, bi);
#pragma unroll
            for (int j = 0; j < 4; ++j) if (bi == lane * 4 + j) cv[j] = -INFINITY;
            if (lane == r) { fs = bv; fp = bi; }
        }
        const float m = wave_max(lane < 16 ? fs : -INFINITY);
        const float e = lane < 16 ? expf(fs - m) : 0.f;
        const float sum = wave_sum(e);
        if (lane < 16) {
            const int id = ti[fp >> 4] * NKEYS + ti[16 + (fp & 15)];
            eidx[(size_t)item * 16 + lane] = id;
            gate[(size_t)item * 16 + lane] = e / sum;
        }
        WAVE_LDS_SYNC();
    }
}

__device__ __forceinline__ void phase_gather_naive(const Ctx& c, const float* __restrict__ x1, const int* __restrict__ eidx, const float* __restrict__ gate,
                                                   const float* __restrict__ U, const float* __restrict__ V, const float* __restrict__ g, const float* __restrict__ bta,
                                                   float* __restrict__ out, bf16_t* __restrict__ outb) {
    const int lane = c.lane, gw = c.bid * NWAVES + c.wid, NGW = c.G * NWAVES;
    for (int tok = gw; tok < NTOK; tok += NGW) {
        const f32x4* xr = (const f32x4*)(x1 + (size_t)tok * D);
        f32x4 xv[4], acc[4];
#pragma unroll
        for (int j = 0; j < 4; ++j) { xv[j] = xr[lane + 64 * j]; acc[j] = (f32x4){0.f, 0.f, 0.f, 0.f}; }
        for (int k = 0; k < 128; ++k) {
            const int e = eidx[(size_t)tok * 128 + k];
            const float gk = gate[(size_t)tok * 128 + k];
            const f32x4* ur = (const f32x4*)(U + (size_t)e * D);
            const f32x4* vr = (const f32x4*)(V + (size_t)e * D);
            float d = 0.f;
#pragma unroll
            for (int j = 0; j < 4; ++j) { const f32x4 uu = ur[lane + 64 * j]; d += (xv[j][0] * uu[0] + xv[j][1] * uu[1]) + (xv[j][2] * uu[2] + xv[j][3] * uu[3]); }
            d = wave_sum(d);
            const float a = 0.5f * d * (1.f + erff(d * 0.70710678118654752f)) * gk;
#pragma unroll
            for (int j = 0; j < 4; ++j) acc[j] += a * vr[lane + 64 * j];
        }
#pragma unroll
        for (int j = 0; j < 4; ++j) acc[j] = ALPHA * xv[j] + acc[j];
        ln_store_row(acc, lane, g, bta, out + (size_t)tok * D, outb + (size_t)tok * D, nullptr);
    }
}

__device__ __forceinline__ float gelu_erf(float v) {
    const float av = fabsf(v), t = __builtin_amdgcn_rcpf(av * 0.2316418882f + 1.0f);
    float qq = t * 0.5307027145f + (-0.7265760135f); qq = qq * t + 0.7107068705f; qq = qq * t + (-0.142248368f); qq = qq * t + 0.127414796f; qq = qq * t;
    const float e = __builtin_amdgcn_exp2f((v * v) * (-0.72134752044f));
    const float m = v * (qq * e);
    return v < 0.f ? m : v - m;
}
#define SB() __builtin_amdgcn_sched_barrier(0)
__device__ __forceinline__ void axpy_row(f32x2 (&acc)[8], const u32x4 w, const float a) {
    const f32x2 aa = {a, a};
#pragma unroll
    for (int k = 0; k < 4; ++k) {
        const f32x2 lo = __builtin_amdgcn_cvt_pk_f32_fp8(w[k], false), hi = __builtin_amdgcn_cvt_pk_f32_fp8(w[k], true);
        acc[2 * k] = __builtin_elementwise_fma(lo, aa, acc[2 * k]); acc[2 * k + 1] = __builtin_elementwise_fma(hi, aa, acc[2 * k + 1]);
    }
}
__device__ __forceinline__ void phase_gather(const Ctx& c, const float* __restrict__ x1, const unsigned char* __restrict__ X8, const int* __restrict__ eidx, const float* __restrict__ gate,
                                             const unsigned char* __restrict__ U8, const unsigned char* __restrict__ V8, const float* __restrict__ g, const float* __restrict__ bta,
                                             float* __restrict__ out, bf16_t* __restrict__ outb) {
    const int gw = c.bid * NWAVES + c.wid, NGW = c.G * NWAVES;
    LAS unsigned char* xl = (LAS unsigned char*)c.lds + c.wid * 2048;
    const int lane = c.lane, q = lane >> 4, l15 = lane & 15;
    const unsigned lo16 = (unsigned)lane * 16u;
    int tok = gw;
    if (tok >= NTOK) return;
    int ev0 = eidx[(size_t)tok * 128 + lane], ev1 = eidx[(size_t)tok * 128 + 64 + lane];
    int en0, en1;
    { const int t1 = (tok + NGW < NTOK) ? tok + NGW : tok; en0 = eidx[(size_t)t1 * 128 + lane]; en1 = eidx[(size_t)t1 * 128 + 64 + lane]; }
    *(LAS u32x4*)(xl + lane * 16) = *(const u32x4*)(X8 + (size_t)tok * D + lo16);
    u32x4 bU0[8], bU1[8], bV0[8], bV1[8];
    {
        const unsigned char* ub = U8 + ((unsigned)__shfl(ev0, l15) * (unsigned)D + (unsigned)q * 16u);
#pragma unroll
        for (int t = 0; t < 8; ++t) bU0[t] = *(const u32x4*)(ub + 64 * t);
        SB();
#pragma unroll
        for (int t = 0; t < 8; ++t) bU1[t] = *(const u32x4*)(ub + 512 + 64 * t);
        SB();
#pragma unroll
        for (int i = 0; i < 8; ++i) { const int e = __builtin_amdgcn_readlane(ev0, i); bV0[i] = *(const u32x4*)(V8 + (size_t)e * D + lo16); }
        SB();
    }
    int slot = 0;
#pragma unroll 1
    for (; tok < NTOK; tok += NGW, slot ^= 1) {
        const int tokn = (tok + NGW < NTOK) ? tok + NGW : tok, tok2 = (tok + 2 * NGW < NTOK) ? tok + 2 * NGW : tok;
        const int nn0 = eidx[(size_t)tok2 * 128 + lane], nn1 = eidx[(size_t)tok2 * 128 + 64 + lane];
        const u32x4 xn = *(const u32x4*)(X8 + (size_t)tokn * D + lo16);
        const LAS unsigned char* xc = xl + slot * 1024 + q * 16;
        f32x2 acc[8];
#pragma unroll
        for (int k = 0; k < 8; ++k) acc[k] = (f32x2){0.f, 0.f};
        SB();
#pragma unroll 1
        for (int h = 0; h < 8; ++h) {
            const int evh = (h < 4) ? ev0 : ev1, lb = (h & 3) * 16;
            const bool last = (h == 7);
            const int evn = last ? en0 : ((h + 1 < 4) ? ev0 : ev1), lbn = last ? 0 : ((h + 1) & 3) * 16;
            const f32x4 gq = *(const f32x4*)(gate + (size_t)tok * 128 + h * 16 + 4 * q);
            SB();
#pragma unroll
            for (int i = 0; i < 8; ++i) { const int e = __builtin_amdgcn_readlane(evh, lb + 8 + i); bV1[i] = *(const u32x4*)(V8 + (size_t)e * D + lo16); }
            SB();
            f32x4 h4 = {0.f, 0.f, 0.f, 0.f};
#pragma unroll
            for (int t = 0; t < 8; ++t) {
                const u32x4 xb = *(const LAS u32x4*)(xc + 64 * t);
                const long alo = (long)(((unsigned long long)bU0[t][1] << 32) | bU0[t][0]), ahi = (long)(((unsigned long long)bU0[t][3] << 32) | bU0[t][2]);
                const long xlo = (long)(((unsigned long long)xb[1] << 32) | xb[0]), xhi = (long)(((unsigned long long)xb[3] << 32) | xb[2]);
                h4 = __builtin_amdgcn_mfma_f32_16x16x32_fp8_fp8(alo, xlo, h4, 0, 0, 0);
                h4 = __builtin_amdgcn_mfma_f32_16x16x32_fp8_fp8(ahi, xhi, h4, 0, 0, 0);
                if ((t & 3) == 3) SB();
            }
            const unsigned char* ubn = U8 + ((unsigned)__shfl(evn, lbn + l15) * (unsigned)D + (unsigned)q * 16u);
#pragma unroll
            for (int t = 0; t < 8; ++t) bU0[t] = *(const u32x4*)(ubn + 64 * t);
            SB();
#pragma unroll
            for (int t = 0; t < 8; ++t) {
                const u32x4 xb = *(const LAS u32x4*)(xc + 512 + 64 * t);
                const long alo = (long)(((unsigned long long)bU1[t][1] << 32) | bU1[t][0]), ahi = (long)(((unsigned long long)bU1[t][3] << 32) | bU1[t][2]);
                const long xlo = (long)(((unsigned long long)xb[1] << 32) | xb[0]), xhi = (long)(((unsigned long long)xb[3] << 32) | xb[2]);
                h4 = __builtin_amdgcn_mfma_f32_16x16x32_fp8_fp8(alo, xlo, h4, 0, 0, 0);
                h4 = __builtin_amdgcn_mfma_f32_16x16x32_fp8_fp8(ahi, xhi, h4, 0, 0, 0);
                if ((t & 3) == 3) SB();
            }
            int a4[4];
#pragma unroll
            for (int r = 0; r < 4; ++r) a4[r] = __builtin_bit_cast(int, gelu_erf(h4[r] * (1.f / (XS * US))) * gq[r] * (1.f / VS));
            SB();
#pragma unroll
            for (int t = 0; t < 8; ++t) bU1[t] = *(const u32x4*)(ubn + 512 + 64 * t);
            SB();
#pragma unroll
            for (int i = 0; i < 8; ++i) { axpy_row(acc, bV0[i], __builtin_bit_cast(float, __builtin_amdgcn_readlane(a4[i & 3], 16 * (i >> 2)))); if (i & 1) SB(); }
#pragma unroll
            for (int i = 0; i < 8; ++i) { const int e = __builtin_amdgcn_readlane(evn, lbn + i); bV0[i] = *(const u32x4*)(V8 + (size_t)e * D + lo16); }
            SB();
#pragma unroll
            for (int i = 0; i < 8; ++i) { axpy_row(acc, bV1[i], __builtin_bit_cast(float, __builtin_amdgcn_readlane(a4[i & 3], 32 + 16 * (i >> 2)))); if (i & 1) SB(); }
        }
        *(LAS u32x4*)(xl + (slot ^ 1) * 1024 + lane * 16) = xn;
        const f32x4* xr = (const f32x4*)(x1 + (size_t)tok * D) + 4 * lane;
        float sm = 0.f;
#pragma unroll
        for (int w = 0; w < 4; ++w) { const f32x4 xv = xr[w];
            acc[2 * w][0] += ALPHA * xv[0]; acc[2 * w][1] += ALPHA * xv[1]; acc[2 * w + 1][0] += ALPHA * xv[2]; acc[2 * w + 1][1] += ALPHA * xv[3];
            sm += (acc[2 * w][0] + acc[2 * w][1]) + (acc[2 * w + 1][0] + acc[2 * w + 1][1]); }
        const float mean = wave_sum(sm) * (1.f / D); float s2 = 0.f;
#pragma unroll
        for (int k = 0; k < 8; ++k) { acc[k] = acc[k] - mean; s2 += acc[k][0] * acc[k][0] + acc[k][1] * acc[k][1]; }
        const float rstd = rsqrtf(wave_sum(s2) * (1.f / D) + LN_EPS);
#pragma unroll
        for (int w = 0; w < 4; ++w) {
            const f32x4 gg = ((const f32x4*)g)[4 * lane + w], be = ((const f32x4*)bta)[4 * lane + w];
            f32x4 o;
            o[0] = acc[2 * w][0] * rstd * gg[0] + be[0]; o[1] = acc[2 * w][1] * rstd * gg[1] + be[1];
            o[2] = acc[2 * w + 1][0] * rstd * gg[2] + be[2]; o[3] = acc[2 * w + 1][1] * rstd * gg[3] + be[3];
            ((f32x4*)(out + (size_t)tok * D))[4 * lane + w] = o;
            uint2 ob; ob.x = f2bf(o[0]) | ((unsigned)f2bf(o[1]) << 16); ob.y = f2bf(o[2]) | ((unsigned)f2bf(o[3]) << 16);
            ((uint2*)(outb + (size_t)tok * D))[4 * lane + w] = ob;
        }
        ev0 = en0; ev1 = en1; en0 = nn0; en1 = nn1;
        SB();
    }
}

constexpr size_t MiB = 1u << 20;
constexpr size_t WS_WIN = 0;
constexpr size_t WS_WO = 20 * MiB;
constexpr size_t WS_WQ = 28 * MiB;
constexpr size_t WS_XB = 48 * MiB;
constexpr size_t WS_XA = 112 * MiB;
constexpr size_t WS_X1 = 240 * MiB;
constexpr size_t WS_H = 368 * MiB;
constexpr size_t WS_Y = 512 * MiB;
constexpr size_t WS_Z = 576 * MiB;
constexpr size_t WS_QP = 368 * MiB;
constexpr size_t WS_EI = 704 * MiB;
constexpr size_t WS_GT = 720 * MiB;
constexpr size_t WS_U8 = 736 * MiB;
constexpr size_t WS_V8 = 800 * MiB;
constexpr size_t WS_X8 = 864 * MiB;
constexpr size_t WS_END = 896 * MiB;

struct Params { const float* in[16]; float* out; unsigned char* ws; };

__global__ void __launch_bounds__(NTHREADS, 2) mega_fwd(Params P) {
    extern __shared__ __attribute__((aligned(16))) unsigned char lds[];
    cg::grid_group grid = cg::this_grid();
    const float* x = P.in[0]; const float* w_in = P.in[1]; const float* w_o = P.in[2]; const float* sink = P.in[3]; const float* rpb = P.in[4]; const float* t5 = P.in[5];
    const float* ga = P.in[6]; const float* gb = P.in[7]; const float* l1g = P.in[8]; const float* l1b = P.in[9]; const float* l2g = P.in[10]; const float* l2b = P.in[11];
    const float* wq = P.in[12]; const float* keys = P.in[13]; const float* pu = P.in[14]; const float* pv = P.in[15];
    unsigned char* ws = P.ws;
    bf16_t* WinT = (bf16_t*)(ws + WS_WIN); bf16_t* WoT = (bf16_t*)(ws + WS_WO); bf16_t* WqT = (bf16_t*)(ws + WS_WQ);
    bf16_t* Xb = (bf16_t*)(ws + WS_XB); float* XA = (float*)(ws + WS_XA); float* X1 = (float*)(ws + WS_X1);
    bf16_t* H = (bf16_t*)(ws + WS_H); bf16_t* Y = (bf16_t*)(ws + WS_Y); float* Z = (float*)(ws + WS_Z); float* Qp = (float*)(ws + WS_QP);
    int* EI = (int*)(ws + WS_EI); float* GT = (float*)(ws + WS_GT);
    unsigned char* U8 = ws + WS_U8; unsigned char* V8 = ws + WS_V8; unsigned char* X8 = ws + WS_X8;

    phase_convert(make_ctx(lds), w_in, w_o, wq, x, pu, pv, WinT, WoT, WqT, Xb, U8, V8);
    grid.sync();
#pragma unroll 1
    for (int l = 0; l < DEPTH; ++l) {
        const float* xin = (l == 0) ? x : XA;
        float* xout = (l == DEPTH - 1) ? P.out : XA;
        phase_gemm_simple<EpiH, PROJ, D>(make_ctx(lds), Xb, WinT + (size_t)l * PROJ * D, EpiH{H});
        grid.sync();
        phase_attn_naive(make_ctx(lds), H, sink + l * 8, t5, rpb + (size_t)l * 8 * 15 * 31, Z);
        grid.sync();
        phase_rmsnorm(make_ctx(lds), Z, ga + l * 512, gb + l * 512, Y);
        grid.sync();
        phase_gemm_simple<EpiZ, D, D>(make_ctx(lds), Y, WoT + (size_t)l * D * D, EpiZ{xin, Z});
        grid.sync();
        phase_ln(make_ctx(lds), Z, l1g + l * D, l1b + l * D, X1, Xb, X8);
        grid.sync();
        phase_gemm_simple<EpiQ, PQ, D>(make_ctx(lds), Xb, WqT + (size_t)l * PQ * D, EpiQ{Qp});
        grid.sync();
        phase_topk_naive(make_ctx(lds), Qp, keys + (size_t)l * 8 * 2 * NKEYS * 128, EI, GT);
        grid.sync();
        phase_gather(make_ctx(lds), X1, X8, EI, GT, U8 + (size_t)l * NEXP * D, V8 + (size_t)l * NEXP * D, l2g + l * D, l2b + l * D, xout, Xb);
        grid.sync();
    }
}

extern "C" void kernel_launch(void* const* d_in, const int* in_sizes, int n_in, void* d_out, int out_size, void* d_ws, size_t ws_size, hipStream_t stream) {
    static int grid = 0;
    if (grid == 0) {
        if (n_in != 16 || ws_size < WS_END || out_size != NTOK * D) { fprintf(stderr, "kernel_launch: unexpected shapes\n"); grid = -1; return; }
        int dev = 0, cus = 0, per_cu = 0;
        hipGetDevice(&dev);
        hipDeviceGetAttribute(&cus, hipDeviceAttributeMultiprocessorCount, dev);
        hipFuncSetAttribute((const void*)mega_fwd, hipFuncAttributeMaxDynamicSharedMemorySize, LDS_BYTES);
        hipOccupancyMaxActiveBlocksPerMultiprocessor(&per_cu, (const void*)mega_fwd, NTHREADS, LDS_BYTES);
        if (per_cu < 1) { fprintf(stderr, "kernel_launch: occupancy query says %d blocks/CU\n", per_cu); grid = -1; return; }
        grid = cus;
    }
    if (grid < 0) return;
    Params P{};
    for (int i = 0; i < 16; ++i) P.in[i] = (const float*)d_in[i];
    P.out = (float*)d_out; P.ws = (unsigned char*)d_ws;
    void* args[] = {&P};
    hipError_t e = hipLaunchCooperativeKernel((const void*)mega_fwd, dim3(grid), dim3(NTHREADS), args, LDS_BYTES, stream);
    if (e != hipSuccess) fprintf(stderr, "cooperative launch failed: %s (grid %d)\n", hipGetErrorString(e), grid);
}
```

```cpp
#include <hip/hip_runtime.h>
#include <hip/hip_cooperative_groups.h>
#include <stdint.h>
#include <cstdio>
namespace cg = cooperative_groups;

typedef unsigned short bf16_t;
typedef short bf16x8 __attribute__((ext_vector_type(8)));
typedef float f32x4 __attribute__((ext_vector_type(4)));

constexpr int D = 1024, BATCH = 8, SEQ = 4096, DEPTH = 4, NTOK = BATCH * SEQ;
constexpr int HD = 64, PROJ = 2304;
constexpr int O1 = 512, O2 = 640, O3 = 768, O4 = 1280, O5 = 1792;
constexpr int PQ = 2048, NKEYS = 128, NEXP = 16384, TOPK = 16;
constexpr float LN_EPS = 1e-5f;
constexpr float NEGF = -1e30f;
constexpr float ALPHA = 1.6817928305074290f;

__device__ __forceinline__ bf16_t f2bf(float f) { unsigned u = __float_as_uint(f); return (bf16_t)((u + 0x7fffu + ((u >> 16) & 1u)) >> 16); }
__device__ __forceinline__ float bf2f(bf16_t h) { return __uint_as_float(((unsigned)h) << 16); }
__device__ __forceinline__ float wave_sum(float v) {
#pragma unroll
    for (int o = 1; o < 64; o <<= 1) v += __shfl_xor(v, o);
    return v;
}
__device__ __forceinline__ float wave_max(float v) {
#pragma unroll
    for (int o = 1; o < 64; o <<= 1) v = fmaxf(v, __shfl_xor(v, o));
    return v;
}


#define LAS __attribute__((address_space(3)))
typedef float f32x2 __attribute__((ext_vector_type(2)));
typedef unsigned u32x4 __attribute__((ext_vector_type(4)));
constexpr float XS = 8.f, US = 64.f, VS = 16.f;
__device__ __forceinline__ unsigned pack4_fp8(f32x4 v, float sc) {
    v = v * sc;
#pragma unroll
    for (int i = 0; i < 4; ++i) v[i] = fminf(fmaxf(v[i], -448.f), 448.f);
    unsigned p = 0;
    p = __builtin_amdgcn_cvt_pk_fp8_f32(v[0], v[1], p, false);
    p = __builtin_amdgcn_cvt_pk_fp8_f32(v[2], v[3], p, true);
    return p;
}
constexpr int NTHREADS = 512, NWAVES = 8;
constexpr int LDS_BYTES = 147456;

struct Ctx { int tid, lane, wid, bid, G; unsigned char* lds; };
__device__ __forceinline__ Ctx make_ctx(unsigned char* lds) {
    Ctx c; int t = threadIdx.x; asm volatile("" : "+v"(t));
    c.tid = t; c.lane = t & 63; c.wid = __builtin_amdgcn_readfirstlane(t >> 6); c.bid = blockIdx.x; c.G = gridDim.x; c.lds = lds; return c;
}

__device__ __forceinline__ void transpose_item(const float* __restrict__ W, int K, int N, bf16_t* __restrict__ WT, float* scr, int item, int lane) {
    const int nblk = N / 32, kb = item / nblk, nb = item % nblk, k0 = 64 * kb, n0 = 32 * nb;
#pragma unroll 8
    for (int i = 0; i < 32; ++i) { const int kk = 2 * i + (lane >> 5); scr[kk * 33 + (lane & 31)] = W[(size_t)(k0 + kk) * N + n0 + (lane & 31)]; }
    __builtin_amdgcn_fence(__ATOMIC_RELEASE, "wavefront"); __builtin_amdgcn_wave_barrier(); __builtin_amdgcn_fence(__ATOMIC_ACQUIRE, "wavefront");
    const int c = lane & 7;
#pragma unroll
    for (int j = 0; j < 4; ++j) {
        const int n = (lane >> 3) + 8 * j; const float* sp = scr + (8 * c) * 33 + n;
        uint4 o;
        o.x = f2bf(sp[0 * 33]) | ((unsigned)f2bf(sp[1 * 33]) << 16); o.y = f2bf(sp[2 * 33]) | ((unsigned)f2bf(sp[3 * 33]) << 16);
        o.z = f2bf(sp[4 * 33]) | ((unsigned)f2bf(sp[5 * 33]) << 16); o.w = f2bf(sp[6 * 33]) | ((unsigned)f2bf(sp[7 * 33]) << 16);
        *(uint4*)(WT + (size_t)(n0 + n) * K + k0 + 8 * c) = o;
    }
    __builtin_amdgcn_fence(__ATOMIC_RELEASE, "wavefront"); __builtin_amdgcn_wave_barrier(); __builtin_amdgcn_fence(__ATOMIC_ACQUIRE, "wavefront");
}
__device__ __forceinline__ void phase_convert(const Ctx& c, const float* w_in, const float* w_o, const float* wq, const float* x, const float* pu, const float* pv,
                                              bf16_t* WinT, bf16_t* WoT, bf16_t* WqT, bf16_t* Xb, unsigned char* U8, unsigned char* V8, const float* keys, bf16_t* Kb) {
    float* scr = (float*)(c.lds + c.wid * 16384);
    const int gw = c.bid * NWAVES + c.wid, NGW = c.G * NWAVES;
    constexpr int I_IN = (D / 64) * (PROJ / 32), I_O = (D / 64) * (D / 32), I_Q = (D / 64) * (PQ / 32);
    constexpr int NIT = DEPTH * (I_IN + I_O + I_Q);
    for (int it = gw; it < NIT; it += NGW) {
        const int l = it / (I_IN + I_O + I_Q); int r = it % (I_IN + I_O + I_Q);
        if (r < I_IN) { transpose_item(w_in + (size_t)l * D * PROJ, D, PROJ, WinT + (size_t)l * PROJ * D, scr, r, c.lane); continue; } r -= I_IN;
        if (r < I_O) { transpose_item(w_o + (size_t)l * D * D, D, D, WoT + (size_t)l * D * D, scr, r, c.lane); continue; } r -= I_O;
        transpose_item(wq + (size_t)l * D * PQ, D, PQ, WqT + (size_t)l * PQ * D, scr, r, c.lane);
    }
    const size_t n4 = (size_t)NTOK * D / 4;
    for (size_t i = (size_t)c.bid * NTHREADS + c.tid; i < n4; i += (size_t)c.G * NTHREADS) {
        const f32x4 v = ((const f32x4*)x)[i];
        uint2 o; o.x = f2bf(v[0]) | ((unsigned)f2bf(v[1]) << 16); o.y = f2bf(v[2]) | ((unsigned)f2bf(v[3]) << 16);
        ((uint2*)Xb)[i] = o;
    }
    {
        const size_t k4 = (size_t)DEPTH * 8 * 2 * NKEYS * 128 / 4;
        for (size_t i = (size_t)c.bid * NTHREADS + c.tid; i < k4; i += (size_t)c.G * NTHREADS) {
            const f32x4 v = ((const f32x4*)keys)[i];
            uint2 o; o.x = f2bf(v[0]) | ((unsigned)f2bf(v[1]) << 16); o.y = f2bf(v[2]) | ((unsigned)f2bf(v[3]) << 16);
            ((uint2*)Kb)[i] = o;
        }
    }
    const size_t n16 = (size_t)DEPTH * NEXP * D / 16;
    for (size_t i = (size_t)c.bid * NTHREADS + c.tid; i < n16; i += (size_t)c.G * NTHREADS) {
        const f32x4* pa = (const f32x4*)pu + 4 * i; const f32x4* pb = (const f32x4*)pv + 4 * i;
        uint4 oa, ob;
        oa.x = pack4_fp8(pa[0], US); oa.y = pack4_fp8(pa[1], US); oa.z = pack4_fp8(pa[2], US); oa.w = pack4_fp8(pa[3], US);
        ob.x = pack4_fp8(pb[0], VS); ob.y = pack4_fp8(pb[1], VS); ob.z = pack4_fp8(pb[2], VS); ob.w = pack4_fp8(pb[3], VS);
        ((uint4*)U8)[i] = oa; ((uint4*)V8)[i] = ob;
    }
}

struct EpiH { bf16_t* H; __device__ void operator()(int r, int c, float v) const { H[(size_t)r * PROJ + c] = f2bf(v); } };
struct EpiZ { const float* x; float* Z; __device__ void operator()(int r, int c, float v) const { size_t i = (size_t)r * D + c; Z[i] = ALPHA * x[i] + v; } };
struct EpiQ { bf16_t* Q; __device__ void operator()(int r, int c, float v) const { Q[(size_t)r * PQ + c] = f2bf(v); } };

template <class Epi, int N, int K>
__device__ __forceinline__ void phase_gemm_simple(const Ctx& c, const bf16_t* __restrict__ A, const bf16_t* __restrict__ Bt, Epi epi) {
    const int half = c.tid >> 8, tid = c.tid & 255, lane = c.lane, wid = tid >> 6, wm = wid >> 1, wn = wid & 1;
    bf16_t* sA = (bf16_t*)(c.lds + half * 20480);
    bf16_t* sB = sA + 128 * 40;
    constexpr int nN = N / 128, NT = (NTOK / 128) * nN;
    for (int t0 = c.bid * 2; t0 < NT; t0 += c.G * 2) {
        const int t = t0 + half; const bool live = t < NT;
        const int bm = (t / nN) * 128, bn = (t % nN) * 128;
        f32x4 acc[4][4];
#pragma unroll
        for (int i = 0; i < 4; ++i)
#pragma unroll
            for (int j = 0; j < 4; ++j) acc[i][j] = (f32x4){0.f, 0.f, 0.f, 0.f};
        for (int k0 = 0; k0 < K; k0 += 32) {
            if (live) {
#pragma unroll
                for (int i = 0; i < 2; ++i) {
                    const int ch = tid + i * 256, r = ch >> 2, cc = (ch & 3) * 8;
                    *(uint4*)&sA[r * 40 + cc] = *(const uint4*)&A[(size_t)(bm + r) * K + k0 + cc];
                    *(uint4*)&sB[r * 40 + cc] = *(const uint4*)&Bt[(size_t)(bn + r) * K + k0 + cc];
                }
            }
            __syncthreads();
            bf16x8 a[4], b[4];
#pragma unroll
            for (int i = 0; i < 4; ++i) {
                a[i] = *(const bf16x8*)&sA[(wm * 64 + i * 16 + (lane & 15)) * 40 + (lane >> 4) * 8];
                b[i] = *(const bf16x8*)&sB[(wn * 64 + i * 16 + (lane & 15)) * 40 + (lane >> 4) * 8];
            }
#pragma unroll
            for (int i = 0; i < 4; ++i)
#pragma unroll
                for (int j = 0; j < 4; ++j) acc[i][j] = __builtin_amdgcn_mfma_f32_16x16x32_bf16(a[i], b[j], acc[i][j], 0, 0, 0);
            __syncthreads();
        }
        if (live) {
#pragma unroll
            for (int i = 0; i < 4; ++i)
#pragma unroll
                for (int j = 0; j < 4; ++j)
#pragma unroll
                    for (int r = 0; r < 4; ++r) epi(bm + wm * 64 + i * 16 + (lane >> 4) * 4 + r, bn + wn * 64 + j * 16 + (lane & 15), acc[i][j][r]);
        }
    }
}

__device__ __forceinline__ int t5_bucket(int rel) {
    const int n = rel < 0 ? -rel : rel;
    int v;
    if (n < 8) v = n;
    else { int k = 0; k += (n >= 12); k += (n >= 16); k += (n >= 23); k += (n >= 32); k += (n >= 46); k += (n >= 64); k += (n >= 91); v = 8 + k; }
    return (rel > 0 ? 16 : 0) + v;
}
__device__ __forceinline__ float dot64_bf16(const float* qs, const bf16_t* krow) {
    float s = 0.f;
#pragma unroll
    for (int c = 0; c < 8; ++c) {
        const uint4 w = ((const uint4*)krow)[c];
        const unsigned ww[4] = {w.x, w.y, w.z, w.w};
#pragma unroll
        for (int e = 0; e < 4; ++e) { s += qs[c * 8 + 2 * e] * __uint_as_float(ww[e] << 16); s += qs[c * 8 + 2 * e + 1] * __uint_as_float(ww[e] & 0xffff0000u); }
    }
    return s;
}
#define WAVE_LDS_SYNC() do { __builtin_amdgcn_fence(__ATOMIC_RELEASE, "wavefront"); __builtin_amdgcn_wave_barrier(); __builtin_amdgcn_fence(__ATOMIC_ACQUIRE, "wavefront"); } while (0)

__device__ __forceinline__ void phase_attn_naive(const Ctx& c, const bf16_t* __restrict__ H, const float* __restrict__ sink, const float* __restrict__ t5, const float* __restrict__ rpb, float* __restrict__ Yraw) {
    float* qsh = (float*)(c.lds + c.wid * 256);
    const int lane = c.lane;
    const int gw = c.bid * NWAVES + c.wid, NGW = c.G * NWAVES;
    for (int item = gw; item < NTOK * 16; item += NGW) {
        const int tok = item >> 4, hh = item & 15;
        const int b = tok / SEQ, tt = tok % SEQ;
        if (hh < 8) {
            const int hq = hh, kvh = hq >> 2;
            qsh[lane] = bf2f(H[(size_t)tok * PROJ + hq * HD + lane]);
            WAVE_LDS_SYNC();
            float s[5];
#pragma unroll
            for (int i = 0; i < 5; ++i) {
                const int j = lane + 64 * i, rel = j - 128, kp = tt + rel;
                const bool valid = (rel <= 128) && kp >= 0 && kp < SEQ;
                float v = NEGF;
                if (valid) {
                    const bf16_t* krow = H + (size_t)(b * SEQ + kp) * PROJ + O1 + kvh * HD;
                    v = dot64_bf16(qsh, krow) * 0.125f + t5[t5_bucket(rel) * 8 + hq];
                }
                s[i] = v;
            }
            const float sk = sink[hq];
            float m = fmaxf(fmaxf(fmaxf(s[0], s[1]), fmaxf(s[2], s[3])), s[4]);
            m = fmaxf(wave_max(m), sk);
            float p[5], sum = 0.f;
#pragma unroll
            for (int i = 0; i < 5; ++i) { p[i] = expf(s[i] - m); sum += p[i]; }
            sum = wave_sum(sum) + expf(sk - m);
            const float inv = 1.f / sum;
            float acc = 0.f;
#pragma unroll
            for (int i = 0; i < 5; ++i) {
                for (int jj = 0; jj < 64; ++jj) {
                    const float pj = __shfl(p[i], jj);
                    const int rel = jj + 64 * i - 128; const int kp = tt + rel;
                    if (rel > 128 || kp < 0 || kp >= SEQ) continue;
                    acc += pj * bf2f(H[(size_t)(b * SEQ + kp) * PROJ + O2 + kvh * HD + lane]);
                }
            }
            Yraw[(size_t)tok * D + hq * HD + lane] = acc * inv;
        } else {
            const int hb = hh - 8, r = tt >> 6, cc = tt & 63;
            int rs = r - 4; rs = rs < 0 ? 0 : (rs > 56 ? 56 : rs);
            int cs = cc - 8; cs = cs < 0 ? 0 : (cs > 48 ? 48 : cs);
            qsh[lane] = bf2f(H[(size_t)tok * PROJ + O3 + hb * HD + lane]);
            WAVE_LDS_SYNC();
            float s[2];
#pragma unroll
            for (int i = 0; i < 2; ++i) {
                const int j = lane + 64 * i, kr = rs + (j >> 4), kc = cs + (j & 15);
                const bf16_t* krow = H + (size_t)(b * SEQ + kr * 64 + kc) * PROJ + O4 + hb * HD;
                const int dr = kr - r + 7; int dc = kc - cc; dc = dc < -15 ? -15 : (dc > 15 ? 15 : dc); dc += 15;
                s[i] = dot64_bf16(qsh, krow) * 0.125f + rpb[(hb * 15 + dr) * 31 + dc];
            }
            const float m = wave_max(fmaxf(s[0], s[1]));
            float p[2]; p[0] = expf(s[0] - m); p[1] = expf(s[1] - m);
            const float inv = 1.f / wave_sum(p[0] + p[1]);
            float acc = 0.f;
#pragma unroll
            for (int i = 0; i < 2; ++i)
                for (int jj = 0; jj < 64; ++jj) {
                    const float pj = __shfl(p[i], jj);
                    const int j = jj + 64 * i, kr = rs + (j >> 4), kc = cs + (j & 15);
                    acc += pj * bf2f(H[(size_t)(b * SEQ + kr * 64 + kc) * PROJ + O5 + hb * HD + lane]);
                }
            Yraw[(size_t)tok * D + 512 + hb * HD + lane] = acc * inv;
        }
        WAVE_LDS_SYNC();
    }
}

__device__ __forceinline__ void phase_rmsnorm(const Ctx& c, const float* __restrict__ Yraw, const float* __restrict__ ga, const float* __restrict__ gb, bf16_t* __restrict__ Y) {
    const int lane = c.lane, gw = c.bid * NWAVES + c.wid, NGW = c.G * NWAVES;
    for (int tok = gw; tok < NTOK; tok += NGW) {
        const float* row = Yraw + (size_t)tok * D;
        float a[8], bb[8], sa = 0.f, sb = 0.f;
#pragma unroll
        for (int i = 0; i < 8; ++i) { a[i] = row[lane + 64 * i]; bb[i] = row[512 + lane + 64 * i]; sa += a[i] * a[i]; sb += bb[i] * bb[i]; }
        const float ra = rsqrtf(wave_sum(sa) * (1.f / 512.f) + LN_EPS), rb = rsqrtf(wave_sum(sb) * (1.f / 512.f) + LN_EPS);
#pragma unroll
        for (int i = 0; i < 8; ++i) {
            Y[(size_t)tok * D + lane + 64 * i] = f2bf(a[i] * ra * ga[lane + 64 * i]);
            Y[(size_t)tok * D + 512 + lane + 64 * i] = f2bf(bb[i] * rb * gb[lane + 64 * i]);
        }
    }
}

__device__ __forceinline__ void ln_store_row(f32x4 (&v)[4], int lane, const float* __restrict__ g, const float* __restrict__ bta, float* __restrict__ orow, bf16_t* __restrict__ obrow, unsigned char* __restrict__ o8row) {
    float s = 0.f;
#pragma unroll
    for (int j = 0; j < 4; ++j) s += (v[j][0] + v[j][1]) + (v[j][2] + v[j][3]);
    const float mean = wave_sum(s) * (1.f / D); float s2 = 0.f;
#pragma unroll
    for (int j = 0; j < 4; ++j) { v[j] = v[j] - mean; s2 += (v[j][0] * v[j][0] + v[j][1] * v[j][1]) + (v[j][2] * v[j][2] + v[j][3] * v[j][3]); }
    const float rstd = rsqrtf(wave_sum(s2) * (1.f / D) + LN_EPS);
#pragma unroll
    for (int j = 0; j < 4; ++j) {
        const f32x4 gg = ((const f32x4*)g)[lane + 64 * j], be = ((const f32x4*)bta)[lane + 64 * j];
        const f32x4 o = v[j] * rstd * gg + be;
        ((f32x4*)orow)[lane + 64 * j] = o;
        uint2 ob; ob.x = f2bf(o[0]) | ((unsigned)f2bf(o[1]) << 16); ob.y = f2bf(o[2]) | ((unsigned)f2bf(o[3]) << 16);
        ((uint2*)obrow)[lane + 64 * j] = ob;
        if (o8row) ((unsigned*)o8row)[lane + 64 * j] = pack4_fp8(o, XS);
    }
}
__device__ __forceinline__ void phase_ln(const Ctx& c, const float* __restrict__ Z, const float* __restrict__ g, const float* __restrict__ bta, float* __restrict__ out, bf16_t* __restrict__ outb, unsigned char* __restrict__ out8) {
    const int lane = c.lane, gw = c.bid * NWAVES + c.wid, NGW = c.G * NWAVES;
    for (int tok = gw; tok < NTOK; tok += NGW) {
        const f32x4* zr = (const f32x4*)(Z + (size_t)tok * D);
        f32x4 v[4];
#pragma unroll
        for (int j = 0; j < 4; ++j) v[j] = zr[lane + 64 * j];
        ln_store_row(v, lane, g, bta, out + (size_t)tok * D, outb + (size_t)tok * D, out8 + (size_t)tok * D);
    }
}


#ifndef HD
#define HD __host__ __device__ __forceinline__
#endif
HD unsigned tk_f2u(float f) { return __builtin_bit_cast(unsigned, f); }
HD float tk_u2f(unsigned u) { return __builtin_bit_cast(float, u); }
template <int N> HD void bitonic_sort_desc(float (&v)[N]) {
#pragma unroll
    for (int k = 2; k <= N; k <<= 1)
#pragma unroll
        for (int j = k >> 1; j > 0; j >>= 1)
#pragma unroll
            for (int i = 0; i < N; ++i) {
                const int l = i ^ j;
                if (l > i) {
                    const bool desc = ((i & k) == 0);
                    const float a = v[i], b = v[l];
                    const float mx = __builtin_fmaxf(a, b), mn = __builtin_fminf(a, b);
                    v[i] = desc ? mx : mn; v[l] = desc ? mn : mx;
                }
            }
}
template <int N> HD void bitonic_merge_desc(float (&v)[N]) {
#pragma unroll
    for (int j = N >> 1; j > 0; j >>= 1)
#pragma unroll
        for (int i = 0; i < N; ++i) {
            const int l = i ^ j;
            if (l > i) { const float a = v[i], b = v[l]; v[i] = __builtin_fmaxf(a, b); v[l] = __builtin_fminf(a, b); }
        }
}
HD void top16_merge(float (&a)[16], const float (&b)[16]) {
#pragma unroll
    for (int i = 0; i < 16; ++i) a[i] = __builtin_fmaxf(a[i], b[15 - i]);
    bitonic_merge_desc<16>(a);
}
HD void tk_local_top16(const float (&sc)[4][16], int hh, float (&out)[16]) {
    float g[4][16];
#pragma unroll
    for (int kt = 0; kt < 4; ++kt) {
#pragma unroll
        for (int reg = 0; reg < 16; ++reg) { const int key = 32 * kt + (reg & 3) + 8 * (reg >> 2) + 4 * hh; g[kt][reg] = tk_u2f((tk_f2u(sc[kt][reg]) & ~127u) | (unsigned)(127 - key)); }
        bitonic_sort_desc<16>(g[kt]);
    }
    top16_merge(g[0], g[1]); top16_merge(g[2], g[3]); top16_merge(g[0], g[2]);
#pragma unroll
    for (int i = 0; i < 16; ++i) out[i] = g[0][i];
}
constexpr int CA0[25] = {0,0,0,0,0,0,0,0,0,0,0,0,0,0,0,0,1,1,1,1,1,1,1,1,2};
constexpr int CB0[25] = {0,1,2,3,4,5,6,7,8,9,10,11,12,13,14,15,0,1,2,3,4,5,6,7,0};
constexpr int CA1[25] = {2,2,2,2,3,3,3,3,4,4,4,5,5,6,6,7,7,8,9,10,11,12,13,14,15};
constexpr int CB1[25] = {1,2,3,4,0,1,2,3,0,1,2,0,1,0,1,0,1,0,0,0,0,0,0,0,0};
HD void tk_candidates(const float (&T0)[16], const float (&T1)[16], int hh, float (&cv)[32]) {
    float t0[16], t1[16];
#pragma unroll
    for (int i = 0; i < 16; ++i) { t0[i] = tk_u2f(tk_f2u(T0[i]) & ~127u); t1[i] = tk_u2f(tk_f2u(T1[i]) & ~127u); }
#pragma unroll
    for (int j = 0; j < 25; ++j) {
        const float s0 = t0[CA0[j]] + t1[CB0[j]], s1 = t0[CA1[j]] + t1[CB1[j]];
        const unsigned c0 = 255u - (unsigned)(16 * CA0[j] + CB0[j]), c1 = 255u - (unsigned)(16 * CA1[j] + CB1[j]);
        cv[j] = tk_u2f((tk_f2u(hh ? s1 : s0) & ~255u) | (hh ? c1 : c0));
    }
#pragma unroll
    for (int j = 25; j < 32; ++j) cv[j] = -__builtin_inff();
    bitonic_sort_desc<32>(cv);
}

__device__ __forceinline__ void wave_argmax(float& v, int& i) {
#pragma unroll
    for (int o = 32; o >= 1; o >>= 1) {
        const float ov = __shfl_xor(v, o); const int oi = __shfl_xor(i, o);
        if (ov > v || (ov == v && oi < i)) { v = ov; i = oi; }
    }
}
__device__ __forceinline__ void phase_topk_naive(const Ctx& c, const float* __restrict__ Qp, const float* __restrict__ keys, int* __restrict__ eidx, float* __restrict__ gate) {
    float* qsh = (float*)(c.lds + c.wid * 1024);
    float* tv = qsh + 128;
    int* ti = (int*)(tv + 32);
    const int lane = c.lane, gw = c.bid * NWAVES + c.wid, NGW = c.G * NWAVES;
    for (int item = gw; item < NTOK * 8; item += NGW) {
        const int tok = item >> 3, h = item & 7;
        for (int p = 0; p < 2; ++p) {
            const float* q = Qp + (size_t)tok * PQ + h * 256 + p * 128;
            qsh[lane] = q[lane]; qsh[lane + 64] = q[lane + 64];
            WAVE_LDS_SYNC();
            float s[2];
#pragma unroll
            for (int i = 0; i < 2; ++i) {
                const f32x4* kr = (const f32x4*)(keys + ((size_t)(h * 2 + p) * NKEYS + lane + 64 * i) * 128);
                float a = 0.f;
                for (int cc = 0; cc < 32; ++cc) { const f32x4 kk = kr[cc]; a += qsh[4 * cc] * kk[0]; a += qsh[4 * cc + 1] * kk[1]; a += qsh[4 * cc + 2] * kk[2]; a += qsh[4 * cc + 3] * kk[3]; }
                s[i] = a;
            }
            for (int r = 0; r < 16; ++r) {
                float bv; int bi;
                if (s[0] >= s[1]) { bv = s[0]; bi = lane; } else { bv = s[1]; bi = lane + 64; }
                wave_argmax(bv, bi);
                if (bi == lane) s[0] = -INFINITY;
                if (bi == lane + 64) s[1] = -INFINITY;
                if (lane == 0) { tv[p * 16 + r] = bv; ti[p * 16 + r] = bi; }
            }
            WAVE_LDS_SYNC();
        }
        float cv[4];
#pragma unroll
        for (int j = 0; j < 4; ++j) { const int f = lane * 4 + j; cv[j] = tv[f >> 4] + tv[16 + (f & 15)]; }
        float fs = 0.f; int fp = 0;
        for (int r = 0; r < 16; ++r) {
            float bv = cv[0]; int bi = lane * 4;
#pragma unroll
            for (int j = 1; j < 4; ++j) if (cv[j] > bv) { bv = cv[j]; bi = lane * 4 + j; }
            wave_argmax(bv, bi);
#pragma unroll
            for (int j = 0; j < 4; ++j) if (bi == lane * 4 + j) cv[j] = -INFINITY;
            if (lane == r) { fs = bv; fp = bi; }
        }
        const float m = wave_max(lane < 16 ? fs : -INFINITY);
        const float e = lane < 16 ? expf(fs - m) : 0.f;
        const float sum = wave_sum(e);
        if (lane < 16) {
            const int id = ti[fp >> 4] * NKEYS + ti[16 + (fp & 15)];
            eidx[(size_t)item * 16 + lane] = id;
            gate[(size_t)item * 16 + lane] = e / sum;
        }
        WAVE_LDS_SYNC();
    }
}

__device__ __forceinline__ void phase_gather_naive(const Ctx& c, const float* __restrict__ x1, const int* __restrict__ eidx, const float* __restrict__ gate,
                                                   const float* __restrict__ U, const float* __restrict__ V, const float* __restrict__ g, const float* __restrict__ bta,
                                                   float* __restrict__ out, bf16_t* __restrict__ outb) {
    const int lane = c.lane, gw = c.bid * NWAVES + c.wid, NGW = c.G * NWAVES;
    for (int tok = gw; tok < NTOK; tok += NGW) {
        const f32x4* xr = (const f32x4*)(x1 + (size_t)tok * D);
        f32x4 xv[4], acc[4];
#pragma unroll
        for (int j = 0; j < 4; ++j) { xv[j] = xr[lane + 64 * j]; acc[j] = (f32x4){0.f, 0.f, 0.f, 0.f}; }
        for (int k = 0; k < 128; ++k) {
            const int e = eidx[(size_t)tok * 128 + k];
            const float gk = gate[(size_t)tok * 128 + k];
            const f32x4* ur = (const f32x4*)(U + (size_t)e * D);
            const f32x4* vr = (const f32x4*)(V + (size_t)e * D);
            float d = 0.f;
#pragma unroll
            for (int j = 0; j < 4; ++j) { const f32x4 uu = ur[lane + 64 * j]; d += (xv[j][0] * uu[0] + xv[j][1] * uu[1]) + (xv[j][2] * uu[2] + xv[j][3] * uu[3]); }
            d = wave_sum(d);
            const float a = 0.5f * d * (1.f + erff(d * 0.70710678118654752f)) * gk;
#pragma unroll
            for (int j = 0; j < 4; ++j) acc[j] += a * vr[lane + 64 * j];
        }
#pragma unroll
        for (int j = 0; j < 4; ++j) acc[j] = ALPHA * xv[j] + acc[j];
        ln_store_row(acc, lane, g, bta, out + (size_t)tok * D, outb + (size_t)tok * D, nullptr);
    }
}


typedef float f32x16 __attribute__((ext_vector_type(16)));
__device__ __forceinline__ void phase_topk(const Ctx& c, const bf16_t* __restrict__ Qb, const bf16_t* __restrict__ Kb, int* __restrict__ eidx, float* __restrict__ gate) {
    LAS unsigned char* kl = (LAS unsigned char*)c.lds;
    LAS int* scr = (LAS int*)(c.lds + 65536) + c.wid * 1024;
    const int lane = c.lane, r32 = lane & 31, hh = lane >> 5;
    for (int task = c.bid; task < 8 * (NTOK / 256); task += c.G) {
        const int h = task / (NTOK / 256), tb = task % (NTOK / 256);
        __syncthreads();
#pragma unroll
        for (int i = 0; i < 8; ++i) {
            const int ch = c.tid + NTHREADS * i, row = ch >> 4, cc = ch & 15;
            const u32x4 v = *(const u32x4*)(Kb + ((size_t)(h * 256 + row) * 128 + cc * 8));
            *(LAS u32x4*)(kl + row * 256 + ((cc ^ (row & 15)) << 4)) = v;
        }
        __syncthreads();
        const int tok = tb * 256 + c.wid * 32 + r32;
        float T0[16], T1[16];
#pragma unroll
        for (int p = 0; p < 2; ++p) {
            bf16x8 bq[8];
            const bf16_t* qrow = Qb + (size_t)tok * PQ + h * 256 + p * 128 + hh * 8;
#pragma unroll
            for (int ks = 0; ks < 8; ++ks) bq[ks] = *(const bf16x8*)(qrow + 16 * ks);
            f32x16 acc[4];
#pragma unroll
            for (int kt = 0; kt < 4; ++kt)
#pragma unroll
                for (int r = 0; r < 16; ++r) acc[kt][r] = 0.f;
#pragma unroll
            for (int ks = 0; ks < 8; ++ks) {
                const int swz = ((2 * ks + hh) ^ (r32 & 15)) << 4;
#pragma unroll
                for (int kt = 0; kt < 4; ++kt) {
                    const bf16x8 a = *(const LAS bf16x8*)(kl + (p * 128 + 32 * kt + r32) * 256 + swz);
                    acc[kt] = __builtin_amdgcn_mfma_f32_32x32x16_bf16(a, bq[ks], acc[kt], 0, 0, 0);
                }
            }
            float sc[4][16], loc[16], pr[16];
#pragma unroll
            for (int kt = 0; kt < 4; ++kt)
#pragma unroll
                for (int r = 0; r < 16; ++r) sc[kt][r] = acc[kt][r];
            tk_local_top16(sc, hh, loc);
#pragma unroll
            for (int i = 0; i < 16; ++i) pr[i] = __shfl_xor(loc[i], 32);
            top16_merge(loc, pr);
            if (hh == p) {
#pragma unroll
                for (int i = 0; i < 16; ++i) scr[r32 * 32 + p * 16 + i] = 127 - (int)(tk_f2u(loc[i]) & 127u);
            }
#pragma unroll
            for (int i = 0; i < 16; ++i) { if (p == 0) T0[i] = loc[i]; else T1[i] = loc[i]; }
        }
        float cv[32], F[16], pr[16];
        tk_candidates(T0, T1, hh, cv);
#pragma unroll
        for (int i = 0; i < 16; ++i) { F[i] = cv[i]; pr[i] = __shfl_xor(cv[i], 32); }
        top16_merge(F, pr);
        WAVE_LDS_SYNC();
        const float m = tk_u2f(tk_f2u(F[0]) & ~255u);
        float e[16], sum = 0.f;
#pragma unroll
        for (int i = 0; i < 16; ++i) { e[i] = __expf(tk_u2f(tk_f2u(F[i]) & ~255u) - m); sum += e[i]; }
        const float inv = 1.f / sum;
        int ids[8]; float gs[8];
#pragma unroll
        for (int r = 0; r < 8; ++r) {
            const float fv = hh ? F[8 + r] : F[r];
            const unsigned pos = 255u - (tk_f2u(fv) & 255u);
            ids[r] = scr[r32 * 32 + (int)(pos >> 4)] * NKEYS + scr[r32 * 32 + 16 + (int)(pos & 15u)];
            gs[r] = (hh ? e[8 + r] : e[r]) * inv;
        }
        int* ep = eidx + ((size_t)tok * 8 + h) * 16 + 8 * hh; float* gp = gate + ((size_t)tok * 8 + h) * 16 + 8 * hh;
        *(int4*)ep = make_int4(ids[0], ids[1], ids[2], ids[3]); *(int4*)(ep + 4) = make_int4(ids[4], ids[5], ids[6], ids[7]);
        *(f32x4*)gp = (f32x4){gs[0], gs[1], gs[2], gs[3]}; *(f32x4*)(gp + 4) = (f32x4){gs[4], gs[5], gs[6], gs[7]};
        WAVE_LDS_SYNC();
    }
}

__device__ __forceinline__ float gelu_erf(float v) {
    const float av = fabsf(v), t = __builtin_amdgcn_rcpf(av * 0.2316418882f + 1.0f);
    float qq = t * 0.5307027145f + (-0.7265760135f); qq = qq * t + 0.7107068705f; qq = qq * t + (-0.142248368f); qq = qq * t + 0.127414796f; qq = qq * t;
    const float e = __builtin_amdgcn_exp2f((v * v) * (-0.72134752044f));
    const float m = v * (qq * e);
    return v < 0.f ? m : v - m;
}
#define SB() __builtin_amdgcn_sched_barrier(0)
__device__ __forceinline__ void axpy_row(f32x2 (&acc)[8], const u32x4 w, const float a) {
    const f32x2 aa = {a, a};
#pragma unroll
    for (int k = 0; k < 4; ++k) {
        const f32x2 lo = __builtin_amdgcn_cvt_pk_f32_fp8(w[k], false), hi = __builtin_amdgcn_cvt_pk_f32_fp8(w[k], true);
        acc[2 * k] = __builtin_elementwise_fma(lo, aa, acc[2 * k]); acc[2 * k + 1] = __builtin_elementwise_fma(hi, aa, acc[2 * k + 1]);
    }
}
__device__ __forceinline__ void phase_gather(const Ctx& c, const float* __restrict__ x1, const unsigned char* __restrict__ X8, const int* __restrict__ eidx, const float* __restrict__ gate,
                                             const unsigned char* __restrict__ U8, const unsigned char* __restrict__ V8, const float* __restrict__ g, const float* __restrict__ bta,
                                             float* __restrict__ out, bf16_t* __restrict__ outb) {
    const int gw = c.bid * NWAVES + c.wid, NGW = c.G * NWAVES;
    LAS unsigned char* xl = (LAS unsigned char*)c.lds + c.wid * 2048;
    const int lane = c.lane, q = lane >> 4, l15 = lane & 15;
    const unsigned lo16 = (unsigned)lane * 16u;
    int tok = gw;
    if (tok >= NTOK) return;
    int ev0 = eidx[(size_t)tok * 128 + lane], ev1 = eidx[(size_t)tok * 128 + 64 + lane];
    int en0, en1;
    { const int t1 = (tok + NGW < NTOK) ? tok + NGW : tok; en0 = eidx[(size_t)t1 * 128 + lane]; en1 = eidx[(size_t)t1 * 128 + 64 + lane]; }
    *(LAS u32x4*)(xl + lane * 16) = *(const u32x4*)(X8 + (size_t)tok * D + lo16);
    u32x4 bU0[8], bU1[8], bV0[8], bV1[8];
    {
        const unsigned char* ub = U8 + ((unsigned)__shfl(ev0, l15) * (unsigned)D + (unsigned)q * 16u);
#pragma unroll
        for (int t = 0; t < 8; ++t) bU0[t] = *(const u32x4*)(ub + 64 * t);
        SB();
#pragma unroll
        for (int t = 0; t < 8; ++t) bU1[t] = *(const u32x4*)(ub + 512 + 64 * t);
        SB();
#pragma unroll
        for (int i = 0; i < 8; ++i) { const int e = __builtin_amdgcn_readlane(ev0, i); bV0[i] = *(const u32x4*)(V8 + (size_t)e * D + lo16); }
        SB();
    }
    int slot = 0;
#pragma unroll 1
    for (; tok < NTOK; tok += NGW, slot ^= 1) {
        const int tokn = (tok + NGW < NTOK) ? tok + NGW : tok, tok2 = (tok + 2 * NGW < NTOK) ? tok + 2 * NGW : tok;
        const int nn0 = eidx[(size_t)tok2 * 128 + lane], nn1 = eidx[(size_t)tok2 * 128 + 64 + lane];
        const u32x4 xn = *(const u32x4*)(X8 + (size_t)tokn * D + lo16);
        const LAS unsigned char* xc = xl + slot * 1024 + q * 16;
        f32x2 acc[8];
#pragma unroll
        for (int k = 0; k < 8; ++k) acc[k] = (f32x2){0.f, 0.f};
        SB();
#pragma unroll 1
        for (int h = 0; h < 8; ++h) {
            const int evh = (h < 4) ? ev0 : ev1, lb = (h & 3) * 16;
            const bool last = (h == 7);
            const int evn = last ? en0 : ((h + 1 < 4) ? ev0 : ev1), lbn = last ? 0 : ((h + 1) & 3) * 16;
            const f32x4 gq = *(const f32x4*)(gate + (size_t)tok * 128 + h * 16 + 4 * q);
            SB();
#pragma unroll
            for (int i = 0; i < 8; ++i) { const int e = __builtin_amdgcn_readlane(evh, lb + 8 + i); bV1[i] = *(const u32x4*)(V8 + (size_t)e * D + lo16); }
            SB();
            f32x4 h4 = {0.f, 0.f, 0.f, 0.f};
#pragma unroll
            for (int t = 0; t < 8; ++t) {
                const u32x4 xb = *(const LAS u32x4*)(xc + 64 * t);
                const long alo = (long)(((unsigned long long)bU0[t][1] << 32) | bU0[t][0]), ahi = (long)(((unsigned long long)bU0[t][3] << 32) | bU0[t][2]);
                const long xlo = (long)(((unsigned long long)xb[1] << 32) | xb[0]), xhi = (long)(((unsigned long long)xb[3] << 32) | xb[2]);
                h4 = __builtin_amdgcn_mfma_f32_16x16x32_fp8_fp8(alo, xlo, h4, 0, 0, 0);
                h4 = __builtin_amdgcn_mfma_f32_16x16x32_fp8_fp8(ahi, xhi, h4, 0, 0, 0);
                if ((t & 3) == 3) SB();
            }
            const unsigned char* ubn = U8 + ((unsigned)__shfl(evn, lbn + l15) * (unsigned)D + (unsigned)q * 16u);
#pragma unroll
            for (int t = 0; t < 8; ++t) bU0[t] = *(const u32x4*)(ubn + 64 * t);
            SB();
#pragma unroll
            for (int t = 0; t < 8; ++t) {
                const u32x4 xb = *(const LAS u32x4*)(xc + 512 + 64 * t);
                const long alo = (long)(((unsigned long long)bU1[t][1] << 32) | bU1[t][0]), ahi = (long)(((unsigned long long)bU1[t][3] << 32) | bU1[t][2]);
                const long xlo = (long)(((unsigned long long)xb[1] << 32) | xb[0]), xhi = (long)(((unsigned long long)xb[3] << 32) | xb[2]);
                h4 = __builtin_amdgcn_mfma_f32_16x16x32_fp8_fp8(alo, xlo, h4, 0, 0, 0);
                h4 = __builtin_amdgcn_mfma_f32_16x16x32_fp8_fp8(ahi, xhi, h4, 0, 0, 0);
                if ((t & 3) == 3) SB();
            }
            int a4[4];
#pragma unroll
            for (int r = 0; r < 4; ++r) a4[r] = __builtin_bit_cast(int, gelu_erf(h4[r] * (1.f / (XS * US))) * gq[r] * (1.f / VS));
            SB();
#pragma unroll
            for (int t = 0; t < 8; ++t) bU1[t] = *(const u32x4*)(ubn + 512 + 64 * t);
            SB();
#pragma unroll
            for (int i = 0; i < 8; ++i) { axpy_row(acc, bV0[i], __builtin_bit_cast(float, __builtin_amdgcn_readlane(a4[i & 3], 16 * (i >> 2)))); if (i & 1) SB(); }
#pragma unroll
            for (int i = 0; i < 8; ++i) { const int e = __builtin_amdgcn_readlane(evn, lbn + i); bV0[i] = *(const u32x4*)(V8 + (size_t)e * D + lo16); }
            SB();
#pragma unroll
            for (int i = 0; i < 8; ++i) { axpy_row(acc, bV1[i], __builtin_bit_cast(float, __builtin_amdgcn_readlane(a4[i & 3], 32 + 16 * (i >> 2)))); if (i & 1) SB(); }
        }
        *(LAS u32x4*)(xl + (slot ^ 1) * 1024 + lane * 16) = xn;
        const f32x4* xr = (const f32x4*)(x1 + (size_t)tok * D) + 4 * lane;
        float sm = 0.f;
#pragma unroll
        for (int w = 0; w < 4; ++w) { const f32x4 xv = xr[w];
            acc[2 * w][0] += ALPHA * xv[0]; acc[2 * w][1] += ALPHA * xv[1]; acc[2 * w + 1][0] += ALPHA * xv[2]; acc[2 * w + 1][1] += ALPHA * xv[3];
            sm += (acc[2 * w][0] + acc[2 * w][1]) + (acc[2 * w + 1][0] + acc[2 * w + 1][1]); }
        const float mean = wave_sum(sm) * (1.f / D); float s2 = 0.f;
#pragma unroll
        for (int k = 0; k < 8; ++k) { acc[k] = acc[k] - mean; s2 += acc[k][0] * acc[k][0] + acc[k][1] * acc[k][1]; }
        const float rstd = rsqrtf(wave_sum(s2) * (1.f / D) + LN_EPS);
#pragma unroll
        for (int w = 0; w < 4; ++w) {
            const f32x4 gg = ((const f32x4*)g)[4 * lane + w], be = ((const f32x4*)bta)[4 * lane + w];
            f32x4 o;
            o[0] = acc[2 * w][0] * rstd * gg[0] + be[0]; o[1] = acc[2 * w][1] * rstd * gg[1] + be[1];
            o[2] = acc[2 * w + 1][0] * rstd * gg[2] + be[2]; o[3] = acc[2 * w + 1][1] * rstd * gg[3] + be[3];
            ((f32x4*)(out + (size_t)tok * D))[4 * lane + w] = o;
            uint2 ob; ob.x = f2bf(o[0]) | ((unsigned)f2bf(o[1]) << 16); ob.y = f2bf(o[2]) | ((unsigned)f2bf(o[3]) << 16);
            ((uint2*)(outb + (size_t)tok * D))[4 * lane + w] = ob;
        }
        ev0 = en0; ev1 = en1; en0 = nn0; en1 = nn1;
        SB();
    }
}

constexpr size_t MiB = 1u << 20;
constexpr size_t WS_WIN = 0;
constexpr size_t WS_WO = 20 * MiB;
constexpr size_t WS_WQ = 28 * MiB;
constexpr size_t WS_XB = 48 * MiB;
constexpr size_t WS_XA = 112 * MiB;
constexpr size_t WS_X1 = 240 * MiB;
constexpr size_t WS_H = 368 * MiB;
constexpr size_t WS_Y = 512 * MiB;
constexpr size_t WS_Z = 576 * MiB;
constexpr size_t WS_QP = 368 * MiB;
constexpr size_t WS_KB = 44 * MiB;
constexpr size_t WS_EI = 704 * MiB;
constexpr size_t WS_GT = 720 * MiB;
constexpr size_t WS_U8 = 736 * MiB;
constexpr size_t WS_V8 = 800 * MiB;
constexpr size_t WS_X8 = 864 * MiB;
constexpr size_t WS_END = 896 * MiB;

struct Params { const float* in[16]; float* out; unsigned char* ws; };

__global__ void __launch_bounds__(NTHREADS, 2) mega_fwd(Params P) {
    extern __shared__ __attribute__((aligned(16))) unsigned char lds[];
    cg::grid_group grid = cg::this_grid();
    const float* x = P.in[0]; const float* w_in = P.in[1]; const float* w_o = P.in[2]; const float* sink = P.in[3]; const float* rpb = P.in[4]; const float* t5 = P.in[5];
    const float* ga = P.in[6]; const float* gb = P.in[7]; const float* l1g = P.in[8]; const float* l1b = P.in[9]; const float* l2g = P.in[10]; const float* l2b = P.in[11];
    const float* wq = P.in[12]; const float* keys = P.in[13]; const float* pu = P.in[14]; const float* pv = P.in[15];
    unsigned char* ws = P.ws;
    bf16_t* WinT = (bf16_t*)(ws + WS_WIN); bf16_t* WoT = (bf16_t*)(ws + WS_WO); bf16_t* WqT = (bf16_t*)(ws + WS_WQ);
    bf16_t* Xb = (bf16_t*)(ws + WS_XB); float* XA = (float*)(ws + WS_XA); float* X1 = (float*)(ws + WS_X1);
    bf16_t* H = (bf16_t*)(ws + WS_H); bf16_t* Y = (bf16_t*)(ws + WS_Y); float* Z = (float*)(ws + WS_Z); bf16_t* Qb = (bf16_t*)(ws + WS_QP); bf16_t* Kb = (bf16_t*)(ws + WS_KB);
    int* EI = (int*)(ws + WS_EI); float* GT = (float*)(ws + WS_GT);
    unsigned char* U8 = ws + WS_U8; unsigned char* V8 = ws + WS_V8; unsigned char* X8 = ws + WS_X8;

    phase_convert(make_ctx(lds), w_in, w_o, wq, x, pu, pv, WinT, WoT, WqT, Xb, U8, V8, keys, Kb);
    grid.sync();
#pragma unroll 1
    for (int l = 0; l < DEPTH; ++l) {
        const float* xin = (l == 0) ? x : XA;
        float* xout = (l == DEPTH - 1) ? P.out : XA;
        phase_gemm_simple<EpiH, PROJ, D>(make_ctx(lds), Xb, WinT + (size_t)l * PROJ * D, EpiH{H});
        grid.sync();
        phase_attn_naive(make_ctx(lds), H, sink + l * 8, t5, rpb + (size_t)l * 8 * 15 * 31, Z);
        grid.sync();
        phase_rmsnorm(make_ctx(lds), Z, ga + l * 512, gb + l * 512, Y);
        grid.sync();
        phase_gemm_simple<EpiZ, D, D>(make_ctx(lds), Y, WoT + (size_t)l * D * D, EpiZ{xin, Z});
        grid.sync();
        phase_ln(make_ctx(lds), Z, l1g + l * D, l1b + l * D, X1, Xb, X8);
        grid.sync();
        phase_gemm_simple<EpiQ, PQ, D>(make_ctx(lds), Xb, WqT + (size_t)l * PQ * D, EpiQ{Qb});
        grid.sync();
        phase_topk(make_ctx(lds), Qb, Kb + (size_t)l * 8 * 2 * NKEYS * 128, EI, GT);
        grid.sync();
        phase_gather(make_ctx(lds), X1, X8, EI, GT, U8 + (size_t)l * NEXP * D, V8 + (size_t)l * NEXP * D, l2g + l * D, l2b + l * D, xout, Xb);
        grid.sync();
    }
}

extern "C" void kernel_launch(void* const* d_in, const int* in_sizes, int n_in, void* d_out, int out_size, void* d_ws, size_t ws_size, hipStream_t stream) {
    static int grid = 0;
    if (grid == 0) {
        if (n_in != 16 || ws_size < WS_END || out_size != NTOK * D) { fprintf(stderr, "kernel_launch: unexpected shapes\n"); grid = -1; return; }
        int dev = 0, cus = 0, per_cu = 0;
        hipGetDevice(&dev);
        hipDeviceGetAttribute(&cus, hipDeviceAttributeMultiprocessorCount, dev);
        hipFuncSetAttribute((const void*)mega_fwd, hipFuncAttributeMaxDynamicSharedMemorySize, LDS_BYTES);
        hipOccupancyMaxActiveBlocksPerMultiprocessor(&per_cu, (const void*)mega_fwd, NTHREADS, LDS_BYTES);
        if (per_cu < 1) { fprintf(stderr, "kernel_launch: occupancy query says %d blocks/CU\n", per_cu); grid = -1; return; }
        grid = cus;
    }
    if (grid < 0) return;
    Params P{};
    for (int i = 0; i < 16; ++i) P.in[i] = (const float*)d_in[i];
    P.out = (float*)d_out; P.ws = (unsigned char*)d_ws;
    void* args[] = {&P};
    hipError_t e = hipLaunchCooperativeKernel((const void*)mega_fwd, dim3(grid), dim3(NTHREADS), args, LDS_BYTES, stream);
    if (e != hipSuccess) fprintf(stderr, "cooperative launch failed: %s (grid %d)\n", hipGetErrorString(e), grid);
}
```

```cpp
#include <hip/hip_runtime.h>
#include <hip/hip_cooperative_groups.h>
#include <stdint.h>
#include <cstdio>
namespace cg = cooperative_groups;

typedef unsigned short bf16_t;
typedef short bf16x8 __attribute__((ext_vector_type(8)));
typedef float f32x4 __attribute__((ext_vector_type(4)));

constexpr int D = 1024, BATCH = 8, SEQ = 4096, DEPTH = 4, NTOK = BATCH * SEQ;
constexpr int HD = 64, PROJ = 2304;
constexpr int O1 = 512, O2 = 640, O3 = 768, O4 = 1280, O5 = 1792;
constexpr int PQ = 2048, NKEYS = 128, NEXP = 16384, TOPK = 16;
constexpr float LN_EPS = 1e-5f;
constexpr float NEGF = -1e30f;
constexpr float ALPHA = 1.6817928305074290f;

__device__ __forceinline__ bf16_t f2bf(float f) { unsigned u = __float_as_uint(f); return (bf16_t)((u + 0x7fffu + ((u >> 16) & 1u)) >> 16); }
__device__ __forceinline__ float bf2f(bf16_t h) { return __uint_as_float(((unsigned)h) << 16); }
__device__ __forceinline__ float wave_sum(float v) {
#pragma unroll
    for (int o = 1; o < 64; o <<= 1) v += __shfl_xor(v, o);
    return v;
}
__device__ __forceinline__ float wave_max(float v) {
#pragma unroll
    for (int o = 1; o < 64; o <<= 1) v = fmaxf(v, __shfl_xor(v, o));
    return v;
}


#define LAS __attribute__((address_space(3)))
typedef float f32x2 __attribute__((ext_vector_type(2)));
typedef unsigned u32x4 __attribute__((ext_vector_type(4)));
typedef unsigned u32x2 __attribute__((ext_vector_type(2)));
typedef float f32x16 __attribute__((ext_vector_type(16)));
constexpr float XS = 8.f, US = 64.f, VS = 16.f;
__device__ __forceinline__ unsigned pack4_fp8(f32x4 v, float sc) {
    v = v * sc;
#pragma unroll
    for (int i = 0; i < 4; ++i) v[i] = fminf(fmaxf(v[i], -448.f), 448.f);
    unsigned p = 0;
    p = __builtin_amdgcn_cvt_pk_fp8_f32(v[0], v[1], p, false);
    p = __builtin_amdgcn_cvt_pk_fp8_f32(v[2], v[3], p, true);
    return p;
}
constexpr int NTHREADS = 512, NWAVES = 8;
constexpr int LDS_BYTES = 147456;

struct Ctx { int tid, lane, wid, bid, G; unsigned char* lds; };
__device__ __forceinline__ Ctx make_ctx(unsigned char* lds) {
    Ctx c; int t = threadIdx.x; asm volatile("" : "+v"(t));
    c.tid = t; c.lane = t & 63; c.wid = __builtin_amdgcn_readfirstlane(t >> 6); c.bid = blockIdx.x; c.G = gridDim.x; c.lds = lds; return c;
}

__device__ __forceinline__ void transpose_item(const float* __restrict__ W, int K, int N, bf16_t* __restrict__ WT, float* scr, int item, int lane) {
    const int nblk = N / 32, kb = item / nblk, nb = item % nblk, k0 = 64 * kb, n0 = 32 * nb;
#pragma unroll 8
    for (int i = 0; i < 32; ++i) { const int kk = 2 * i + (lane >> 5); scr[kk * 33 + (lane & 31)] = W[(size_t)(k0 + kk) * N + n0 + (lane & 31)]; }
    __builtin_amdgcn_fence(__ATOMIC_RELEASE, "wavefront"); __builtin_amdgcn_wave_barrier(); __builtin_amdgcn_fence(__ATOMIC_ACQUIRE, "wavefront");
    const int c = lane & 7;
#pragma unroll
    for (int j = 0; j < 4; ++j) {
        const int n = (lane >> 3) + 8 * j; const float* sp = scr + (8 * c) * 33 + n;
        uint4 o;
        o.x = f2bf(sp[0 * 33]) | ((unsigned)f2bf(sp[1 * 33]) << 16); o.y = f2bf(sp[2 * 33]) | ((unsigned)f2bf(sp[3 * 33]) << 16);
        o.z = f2bf(sp[4 * 33]) | ((unsigned)f2bf(sp[5 * 33]) << 16); o.w = f2bf(sp[6 * 33]) | ((unsigned)f2bf(sp[7 * 33]) << 16);
        *(uint4*)(WT + (size_t)(n0 + n) * K + k0 + 8 * c) = o;
    }
    __builtin_amdgcn_fence(__ATOMIC_RELEASE, "wavefront"); __builtin_amdgcn_wave_barrier(); __builtin_amdgcn_fence(__ATOMIC_ACQUIRE, "wavefront");
}
__device__ __forceinline__ void phase_convert(const Ctx& c, const float* w_in, const float* w_o, const float* wq, const float* x, const float* pu, const float* pv,
                                              bf16_t* WinT, bf16_t* WoT, bf16_t* WqT, bf16_t* Xb, unsigned char* U8, unsigned char* V8, const float* keys, bf16_t* Kb) {
    float* scr = (float*)(c.lds + c.wid * 16384);
    const int gw = c.bid * NWAVES + c.wid, NGW = c.G * NWAVES;
    constexpr int I_IN = (D / 64) * (PROJ / 32), I_O = (D / 64) * (D / 32), I_Q = (D / 64) * (PQ / 32);
    constexpr int NIT = DEPTH * (I_IN + I_O + I_Q);
    for (int it = gw; it < NIT; it += NGW) {
        const int l = it / (I_IN + I_O + I_Q); int r = it % (I_IN + I_O + I_Q);
        if (r < I_IN) { transpose_item(w_in + (size_t)l * D * PROJ, D, PROJ, WinT + (size_t)l * PROJ * D, scr, r, c.lane); continue; } r -= I_IN;
        if (r < I_O) { transpose_item(w_o + (size_t)l * D * D, D, D, WoT + (size_t)l * D * D, scr, r, c.lane); continue; } r -= I_O;
        transpose_item(wq + (size_t)l * D * PQ, D, PQ, WqT + (size_t)l * PQ * D, scr, r, c.lane);
    }
    const size_t n4 = (size_t)NTOK * D / 4;
    for (size_t i = (size_t)c.bid * NTHREADS + c.tid; i < n4; i += (size_t)c.G * NTHREADS) {
        const f32x4 v = ((const f32x4*)x)[i];
        uint2 o; o.x = f2bf(v[0]) | ((unsigned)f2bf(v[1]) << 16); o.y = f2bf(v[2]) | ((unsigned)f2bf(v[3]) << 16);
        ((uint2*)Xb)[i] = o;
    }
    {
        const size_t k4 = (size_t)DEPTH * 8 * 2 * NKEYS * 128 / 4;
        for (size_t i = (size_t)c.bid * NTHREADS + c.tid; i < k4; i += (size_t)c.G * NTHREADS) {
            const f32x4 v = ((const f32x4*)keys)[i];
            uint2 o; o.x = f2bf(v[0]) | ((unsigned)f2bf(v[1]) << 16); o.y = f2bf(v[2]) | ((unsigned)f2bf(v[3]) << 16);
            ((uint2*)Kb)[i] = o;
        }
    }
    const size_t n16 = (size_t)DEPTH * NEXP * D / 16;
    for (size_t i = (size_t)c.bid * NTHREADS + c.tid; i < n16; i += (size_t)c.G * NTHREADS) {
        const f32x4* pa = (const f32x4*)pu + 4 * i; const f32x4* pb = (const f32x4*)pv + 4 * i;
        uint4 oa, ob;
        oa.x = pack4_fp8(pa[0], US); oa.y = pack4_fp8(pa[1], US); oa.z = pack4_fp8(pa[2], US); oa.w = pack4_fp8(pa[3], US);
        ob.x = pack4_fp8(pb[0], VS); ob.y = pack4_fp8(pb[1], VS); ob.z = pack4_fp8(pb[2], VS); ob.w = pack4_fp8(pb[3], VS);
        ((uint4*)U8)[i] = oa; ((uint4*)V8)[i] = ob;
    }
}

struct EpiH { bf16_t* H; __device__ void operator()(int r, int c, float v) const { H[(size_t)r * PROJ + c] = f2bf(v); } };
struct EpiZ { const float* x; float* Z; __device__ void operator()(int r, int c, float v) const { size_t i = (size_t)r * D + c; Z[i] = ALPHA * x[i] + v; } };
struct EpiQ { bf16_t* Q; __device__ void operator()(int r, int c, float v) const { Q[(size_t)r * PQ + c] = f2bf(v); } };

template <class Epi, int N, int K>
__device__ __forceinline__ void phase_gemm_simple(const Ctx& c, const bf16_t* __restrict__ A, const bf16_t* __restrict__ Bt, Epi epi) {
    const int half = c.tid >> 8, tid = c.tid & 255, lane = c.lane, wid = tid >> 6, wm = wid >> 1, wn = wid & 1;
    bf16_t* sA = (bf16_t*)(c.lds + half * 20480);
    bf16_t* sB = sA + 128 * 40;
    constexpr int nN = N / 128, NT = (NTOK / 128) * nN;
    for (int t0 = c.bid * 2; t0 < NT; t0 += c.G * 2) {
        const int t = t0 + half; const bool live = t < NT;
        const int bm = (t / nN) * 128, bn = (t % nN) * 128;
        f32x4 acc[4][4];
#pragma unroll
        for (int i = 0; i < 4; ++i)
#pragma unroll
            for (int j = 0; j < 4; ++j) acc[i][j] = (f32x4){0.f, 0.f, 0.f, 0.f};
        for (int k0 = 0; k0 < K; k0 += 32) {
            if (live) {
#pragma unroll
                for (int i = 0; i < 2; ++i) {
                    const int ch = tid + i * 256, r = ch >> 2, cc = (ch & 3) * 8;
                    *(uint4*)&sA[r * 40 + cc] = *(const uint4*)&A[(size_t)(bm + r) * K + k0 + cc];
                    *(uint4*)&sB[r * 40 + cc] = *(const uint4*)&Bt[(size_t)(bn + r) * K + k0 + cc];
                }
            }
            __syncthreads();
            bf16x8 a[4], b[4];
#pragma unroll
            for (int i = 0; i < 4; ++i) {
                a[i] = *(const bf16x8*)&sA[(wm * 64 + i * 16 + (lane & 15)) * 40 + (lane >> 4) * 8];
                b[i] = *(const bf16x8*)&sB[(wn * 64 + i * 16 + (lane & 15)) * 40 + (lane >> 4) * 8];
            }
#pragma unroll
            for (int i = 0; i < 4; ++i)
#pragma unroll
                for (int j = 0; j < 4; ++j) acc[i][j] = __builtin_amdgcn_mfma_f32_16x16x32_bf16(a[i], b[j], acc[i][j], 0, 0, 0);
            __syncthreads();
        }
        if (live) {
#pragma unroll
            for (int i = 0; i < 4; ++i)
#pragma unroll
                for (int j = 0; j < 4; ++j)
#pragma unroll
                    for (int r = 0; r < 4; ++r) epi(bm + wm * 64 + i * 16 + (lane >> 4) * 4 + r, bn + wn * 64 + j * 16 + (lane & 15), acc[i][j][r]);
        }
    }
}

__device__ __forceinline__ int t5_bucket(int rel) {
    const int n = rel < 0 ? -rel : rel;
    int v;
    if (n < 8) v = n;
    else { int k = 0; k += (n >= 12); k += (n >= 16); k += (n >= 23); k += (n >= 32); k += (n >= 46); k += (n >= 64); k += (n >= 91); v = 8 + k; }
    return (rel > 0 ? 16 : 0) + v;
}
__device__ __forceinline__ float dot64_bf16(const float* qs, const bf16_t* krow) {
    float s = 0.f;
#pragma unroll
    for (int c = 0; c < 8; ++c) {
        const uint4 w = ((const uint4*)krow)[c];
        const unsigned ww[4] = {w.x, w.y, w.z, w.w};
#pragma unroll
        for (int e = 0; e < 4; ++e) { s += qs[c * 8 + 2 * e] * __uint_as_float(ww[e] << 16); s += qs[c * 8 + 2 * e + 1] * __uint_as_float(ww[e] & 0xffff0000u); }
    }
    return s;
}
#define WAVE_LDS_SYNC() do { __builtin_amdgcn_fence(__ATOMIC_RELEASE, "wavefront"); __builtin_amdgcn_wave_barrier(); __builtin_amdgcn_fence(__ATOMIC_ACQUIRE, "wavefront"); } while (0)

__device__ __forceinline__ void phase_attn_naive(const Ctx& c, const bf16_t* __restrict__ H, const float* __restrict__ sink, const float* __restrict__ t5, const float* __restrict__ rpb, float* __restrict__ Yraw) {
    float* qsh = (float*)(c.lds + c.wid * 256);
    const int lane = c.lane;
    const int gw = c.bid * NWAVES + c.wid, NGW = c.G * NWAVES;
    for (int item = gw; item < NTOK * 16; item += NGW) {
        const int tok = item >> 4, hh = item & 15;
        const int b = tok / SEQ, tt = tok % SEQ;
        if (hh < 8) {
            const int hq = hh, kvh = hq >> 2;
            qsh[lane] = bf2f(H[(size_t)tok * PROJ + hq * HD + lane]);
            WAVE_LDS_SYNC();
            float s[5];
#pragma unroll
            for (int i = 0; i < 5; ++i) {
                const int j = lane + 64 * i, rel = j - 128, kp = tt + rel;
                const bool valid = (rel <= 128) && kp >= 0 && kp < SEQ;
                float v = NEGF;
                if (valid) {
                    const bf16_t* krow = H + (size_t)(b * SEQ + kp) * PROJ + O1 + kvh * HD;
                    v = dot64_bf16(qsh, krow) * 0.125f + t5[t5_bucket(rel) * 8 + hq];
                }
                s[i] = v;
            }
            const float sk = sink[hq];
            float m = fmaxf(fmaxf(fmaxf(s[0], s[1]), fmaxf(s[2], s[3])), s[4]);
            m = fmaxf(wave_max(m), sk);
            float p[5], sum = 0.f;
#pragma unroll
            for (int i = 0; i < 5; ++i) { p[i] = expf(s[i] - m); sum += p[i]; }
            sum = wave_sum(sum) + expf(sk - m);
            const float inv = 1.f / sum;
            float acc = 0.f;
#pragma unroll
            for (int i = 0; i < 5; ++i) {
                for (int jj = 0; jj < 64; ++jj) {
                    const float pj = __shfl(p[i], jj);
                    const int rel = jj + 64 * i - 128; const int kp = tt + rel;
                    if (rel > 128 || kp < 0 || kp >= SEQ) continue;
                    acc += pj * bf2f(H[(size_t)(b * SEQ + kp) * PROJ + O2 + kvh * HD + lane]);
                }
            }
            Yraw[(size_t)tok * D + hq * HD + lane] = acc * inv;
        } else {
            const int hb = hh - 8, r = tt >> 6, cc = tt & 63;
            int rs = r - 4; rs = rs < 0 ? 0 : (rs > 56 ? 56 : rs);
            int cs = cc - 8; cs = cs < 0 ? 0 : (cs > 48 ? 48 : cs);
            qsh[lane] = bf2f(H[(size_t)tok * PROJ + O3 + hb * HD + lane]);
            WAVE_LDS_SYNC();
            float s[2];
#pragma unroll
            for (int i = 0; i < 2; ++i) {
                const int j = lane + 64 * i, kr = rs + (j >> 4), kc = cs + (j & 15);
                const bf16_t* krow = H + (size_t)(b * SEQ + kr * 64 + kc) * PROJ + O4 + hb * HD;
                const int dr = kr - r + 7; int dc = kc - cc; dc = dc < -15 ? -15 : (dc > 15 ? 15 : dc); dc += 15;
                s[i] = dot64_bf16(qsh, krow) * 0.125f + rpb[(hb * 15 + dr) * 31 + dc];
            }
            const float m = wave_max(fmaxf(s[0], s[1]));
            float p[2]; p[0] = expf(s[0] - m); p[1] = expf(s[1] - m);
            const float inv = 1.f / wave_sum(p[0] + p[1]);
            float acc = 0.f;
#pragma unroll
            for (int i = 0; i < 2; ++i)
                for (int jj = 0; jj < 64; ++jj) {
                    const float pj = __shfl(p[i], jj);
                    const int j = jj + 64 * i, kr = rs + (j >> 4), kc = cs + (j & 15);
                    acc += pj * bf2f(H[(size_t)(b * SEQ + kr * 64 + kc) * PROJ + O5 + hb * HD + lane]);
                }
            Yraw[(size_t)tok * D + 512 + hb * HD + lane] = acc * inv;
        }
        WAVE_LDS_SYNC();
    }
}


struct AttnState { float m, l; f32x16 o0, o1; };
__device__ __forceinline__ void attn_state_init(AttnState& st) {
    st.m = -1e30f; st.l = 0.f;
#pragma unroll
    for (int r = 0; r < 16; ++r) { st.o0[r] = 0.f; st.o1[r] = 0.f; }
}
__device__ __forceinline__ void attn_stage_kv(const Ctx& c, LAS unsigned char* Ks, LAS unsigned char* VT, const bf16_t* __restrict__ H, int b, int tok0, int koff, int voff) {
#pragma unroll
    for (int i = 0; i < 6; ++i) {
        const int ch = c.tid + NTHREADS * i, row = ch >> 3, cc = ch & 7;
        int t = tok0 + row; t = t < 0 ? 0 : (t > SEQ - 1 ? SEQ - 1 : t);
        const bf16_t* src = H + (size_t)(b * SEQ + t) * PROJ;
        const u32x4 kv = *(const u32x4*)(src + koff + cc * 8);
        const u32x4 vv = *(const u32x4*)(src + voff + cc * 8);
        *(LAS u32x4*)(Ks + row * 128 + ((cc ^ (row & 7)) << 4)) = kv;
        LAS bf16_t* vt = (LAS bf16_t*)VT + (cc * 8) * 388 + row;
#pragma unroll
        for (int k = 0; k < 4; ++k) { vt[(2 * k) * 388] = (bf16_t)(vv[k] & 0xffffu); vt[(2 * k + 1) * 388] = (bf16_t)(vv[k] >> 16); }
    }
}
__device__ __forceinline__ void attn_qk(f32x16& s, const bf16x8 (&qf)[4], const LAS unsigned char* Ks, int kt, int r32, int hh) {
#pragma unroll
    for (int r = 0; r < 16; ++r) s[r] = 0.f;
#pragma unroll
    for (int ks = 0; ks < 4; ++ks) {
        const bf16x8 a = *(const LAS bf16x8*)(Ks + (32 * kt + r32) * 128 + (((2 * ks + hh) ^ (r32 & 7)) << 4));
        s = __builtin_amdgcn_mfma_f32_32x32x16_bf16(a, qf[ks], s, 0, 0, 0);
    }
}
__device__ __forceinline__ void attn_softmax_pv(AttnState& st, f32x16& s, const LAS unsigned char* VT, int kt, int r32, int hh) {
    float tmax = s[0];
#pragma unroll
    for (int r = 1; r < 16; ++r) tmax = fmaxf(tmax, s[r]);
    tmax = fmaxf(tmax, __shfl_xor(tmax, 32));
    const float mn = fmaxf(st.m, tmax), alpha = __expf(st.m - mn);
    st.m = mn;
    float psum = 0.f;
#pragma unroll
    for (int r = 0; r < 16; ++r) { s[r] = __expf(s[r] - mn); psum += s[r]; }
    st.l = st.l * alpha + psum;
#pragma unroll
    for (int r = 0; r < 16; ++r) { st.o0[r] *= alpha; st.o1[r] *= alpha; }
    bf16x8 pb[2];
#pragma unroll
    for (int s2 = 0; s2 < 2; ++s2)
#pragma unroll
        for (int j = 0; j < 8; ++j) pb[s2][j] = (short)f2bf(s[8 * s2 + j]);
#pragma unroll
    for (int s2 = 0; s2 < 2; ++s2) {
        const LAS unsigned char* vp0 = VT + (r32 * 388 + 32 * kt + 16 * s2 + 4 * hh) * 2;
        const LAS unsigned char* vp1 = vp0 + 32 * 388 * 2;
        const u32x2 a0 = *(const LAS u32x2*)vp0, a1 = *(const LAS u32x2*)(vp0 + 16);
        const u32x2 b0 = *(const LAS u32x2*)vp1, b1 = *(const LAS u32x2*)(vp1 + 16);
        const u32x4 fa = {a0[0], a0[1], a1[0], a1[1]}, fb = {b0[0], b0[1], b1[0], b1[1]};
        st.o0 = __builtin_amdgcn_mfma_f32_32x32x16_bf16(__builtin_bit_cast(bf16x8, fa), pb[s2], st.o0, 0, 0, 0);
        st.o1 = __builtin_amdgcn_mfma_f32_32x32x16_bf16(__builtin_bit_cast(bf16x8, fb), pb[s2], st.o1, 0, 0, 0);
    }
}
__device__ __forceinline__ void attn_store(const AttnState& st, float scale, float* __restrict__ yrow  , int hh) {
#pragma unroll
    for (int g4 = 0; g4 < 4; ++g4) {
        f32x4 a, b;
#pragma unroll
        for (int e = 0; e < 4; ++e) { a[e] = st.o0[4 * g4 + e] * scale; b[e] = st.o1[4 * g4 + e] * scale; }
        *(f32x4*)(yrow + 8 * g4 + 4 * hh) = a;
        *(f32x4*)(yrow + 32 + 8 * g4 + 4 * hh) = b;
    }
}
__device__ __forceinline__ void phase_attn(const Ctx& c, const bf16_t* __restrict__ H, const float* __restrict__ sink, const float* __restrict__ t5, const float* __restrict__ rpb, float* __restrict__ Yraw) {
    LAS unsigned char* Ks = (LAS unsigned char*)c.lds;
    LAS unsigned char* VT = Ks + 49152;
    LAS float* TB = (LAS float*)(Ks + 98816);
    const int lane = c.lane, r32 = lane & 31, hh = lane >> 5, w = c.wid;
    constexpr int NWIN = BATCH * 2 * (SEQ / 128), NNA = BATCH * 8 * 16;
    for (int u = c.bid; u < NWIN + NNA; u += c.G) {
        __syncthreads();
        if (u < NWIN) {
            const int b = u / (2 * (SEQ / 128)), kvh = (u / (SEQ / 128)) & 1, n = u % (SEQ / 128);
            attn_stage_kv(c, Ks, VT, H, b, 128 * (n - 1), O1 + kvh * HD, O2 + kvh * HD);
            for (int i = c.tid; i < 511 * 4; i += NTHREADS) {
                const int rel = (i >> 2) - 255, g = i & 3;
                TB[i] = (rel >= -128 && rel <= 128) ? t5[t5_bucket(rel) * 8 + kvh * 4 + g] : -INFINITY;
            }
            __syncthreads();
            const int g = w >> 1, hq = kvh * 4 + g;
            const float sk = sink[hq];
#pragma unroll 1
            for (int qi = 0; qi < 2; ++qi) {
                const int qt = 2 * (w & 1) + qi, i0 = 32 * qt;
                const int tok = b * SEQ + 128 * n + i0 + r32;
                bf16x8 qf[4];
#pragma unroll
                for (int ks = 0; ks < 4; ++ks) qf[ks] = *(const bf16x8*)(H + (size_t)tok * PROJ + hq * HD + 16 * ks + 8 * hh);
                AttnState st; attn_state_init(st);
                int kt0 = qt, kt1 = qt + 8;
                if (n == 0 && kt0 < 4) kt0 = 4;
                if (n == SEQ / 128 - 1 && kt1 > 7) kt1 = 7;
#pragma unroll 1
                for (int kt = kt0; kt <= kt1; ++kt) {
                    f32x16 s; attn_qk(s, qf, Ks, kt, r32, hh);
                    const LAS float* tb = TB + (32 * kt + 4 * hh - (i0 + r32) + 127) * 4 + g;
#pragma unroll
                    for (int r = 0; r < 16; ++r) s[r] = s[r] * 0.125f + tb[((r & 3) + 8 * (r >> 2)) * 4];
                    attn_softmax_pv(st, s, VT, kt, r32, hh);
                }
                const float l = st.l + __shfl_xor(st.l, 32);
                const float mf = fmaxf(st.m, sk), ef = __expf(st.m - mf);
                const float scale = ef / (l * ef + __expf(sk - mf));
                attn_store(st, scale, Yraw + (size_t)tok * D + hq * HD, hh);
            }
        } else {
            const int v = u - NWIN, b = v / (8 * 16), hb = (v / 16) & 7, R0 = 4 * (v & 15);
            int kr0 = R0 - 4; kr0 = kr0 < 0 ? 0 : (kr0 > 56 ? 56 : kr0);
            const int r = R0 + (w >> 1), cq = 32 * (w & 1) + r32;
            int rs = r - 4; rs = rs < 0 ? 0 : (rs > 56 ? 56 : rs);
            int cs = cq - 8; cs = cs < 0 ? 0 : (cs > 48 ? 48 : cs);
            const int tok = b * SEQ + r * 64 + cq;
            bf16x8 qf[4];
#pragma unroll
            for (int ks = 0; ks < 4; ++ks) qf[ks] = *(const bf16x8*)(H + (size_t)tok * PROJ + O3 + hb * HD + 16 * ks + 8 * hh);
            AttnState st; attn_state_init(st);
#pragma unroll 1
            for (int pass = 0; pass < 2; ++pass) {
                if (pass) __syncthreads();
                attn_stage_kv(c, Ks, VT, H, b, (kr0 + 6 * pass) * 64, O4 + hb * HD, O5 + hb * HD);
                if (pass == 0) for (int i = c.tid; i < 15 * 31; i += NTHREADS) TB[i] = rpb[hb * 15 * 31 + i];
                __syncthreads();
#pragma unroll 1
                for (int kt = 0; kt < 12; ++kt) {
                    const int kr = kr0 + 6 * pass + (kt >> 1);
                    if (kr < rs || kr >= rs + 8) continue;
                    f32x16 s; attn_qk(s, qf, Ks, kt, r32, hh);
                    const LAS float* tb = TB + (kr - r + 7) * 31 + 15;
                    const int kc0 = 32 * (kt & 1) + 4 * hh;
#pragma unroll
                    for (int rr = 0; rr < 16; ++rr) {
                        const int kc = kc0 + (rr & 3) + 8 * (rr >> 2);
                        int dc = kc - cq; dc = dc < -15 ? -15 : (dc > 15 ? 15 : dc);
                        const bool ok = (kc >= cs) && (kc < cs + 16);
                        s[rr] = ok ? s[rr] * 0.125f + tb[dc] : -INFINITY;
                    }
                    attn_softmax_pv(st, s, VT, kt, r32, hh);
                }
            }
            const float l = st.l + __shfl_xor(st.l, 32);
            attn_store(st, 1.f / l, Yraw + (size_t)tok * D + 512 + hb * HD, hh);
        }
    }
}

__device__ __forceinline__ void phase_rmsnorm(const Ctx& c, const float* __restrict__ Yraw, const float* __restrict__ ga, const float* __restrict__ gb, bf16_t* __restrict__ Y) {
    const int lane = c.lane, gw = c.bid * NWAVES + c.wid, NGW = c.G * NWAVES;
    for (int tok = gw; tok < NTOK; tok += NGW) {
        const float* row = Yraw + (size_t)tok * D;
        float a[8], bb[8], sa = 0.f, sb = 0.f;
#pragma unroll
        for (int i = 0; i < 8; ++i) { a[i] = row[lane + 64 * i]; bb[i] = row[512 + lane + 64 * i]; sa += a[i] * a[i]; sb += bb[i] * bb[i]; }
        const float ra = rsqrtf(wave_sum(sa) * (1.f / 512.f) + LN_EPS), rb = rsqrtf(wave_sum(sb) * (1.f / 512.f) + LN_EPS);
#pragma unroll
        for (int i = 0; i < 8; ++i) {
            Y[(size_t)tok * D + lane + 64 * i] = f2bf(a[i] * ra * ga[lane + 64 * i]);
            Y[(size_t)tok * D + 512 + lane + 64 * i] = f2bf(bb[i] * rb * gb[lane + 64 * i]);
        }
    }
}

__device__ __forceinline__ void ln_store_row(f32x4 (&v)[4], int lane, const float* __restrict__ g, const float* __restrict__ bta, float* __restrict__ orow, bf16_t* __restrict__ obrow, unsigned char* __restrict__ o8row) {
    float s = 0.f;
#pragma unroll
    for (int j = 0; j < 4; ++j) s += (v[j][0] + v[j][1]) + (v[j][2] + v[j][3]);
    const float mean = wave_sum(s) * (1.f / D); float s2 = 0.f;
#pragma unroll
    for (int j = 0; j < 4; ++j) { v[j] = v[j] - mean; s2 += (v[j][0] * v[j][0] + v[j][1] * v[j][1]) + (v[j][2] * v[j][2] + v[j][3] * v[j][3]); }
    const float rstd = rsqrtf(wave_sum(s2) * (1.f / D) + LN_EPS);
#pragma unroll
    for (int j = 0; j < 4; ++j) {
        const f32x4 gg = ((const f32x4*)g)[lane + 64 * j], be = ((const f32x4*)bta)[lane + 64 * j];
        const f32x4 o = v[j] * rstd * gg + be;
        ((f32x4*)orow)[lane + 64 * j] = o;
        uint2 ob; ob.x = f2bf(o[0]) | ((unsigned)f2bf(o[1]) << 16); ob.y = f2bf(o[2]) | ((unsigned)f2bf(o[3]) << 16);
        ((uint2*)obrow)[lane + 64 * j] = ob;
        if (o8row) ((unsigned*)o8row)[lane + 64 * j] = pack4_fp8(o, XS);
    }
}
__device__ __forceinline__ void phase_ln(const Ctx& c, const float* __restrict__ Z, const float* __restrict__ g, const float* __restrict__ bta, float* __restrict__ out, bf16_t* __restrict__ outb, unsigned char* __restrict__ out8) {
    const int lane = c.lane, gw = c.bid * NWAVES + c.wid, NGW = c.G * NWAVES;
    for (int tok = gw; tok < NTOK; tok += NGW) {
        const f32x4* zr = (const f32x4*)(Z + (size_t)tok * D);
        f32x4 v[4];
#pragma unroll
        for (int j = 0; j < 4; ++j) v[j] = zr[lane + 64 * j];
        ln_store_row(v, lane, g, bta, out + (size_t)tok * D, outb + (size_t)tok * D, out8 + (size_t)tok * D);
    }
}


#ifndef HD
#define HD __host__ __device__ __forceinline__
#endif
HD unsigned tk_f2u(float f) { return __builtin_bit_cast(unsigned, f); }
HD float tk_u2f(unsigned u) { return __builtin_bit_cast(float, u); }
template <int N> HD void bitonic_sort_desc(float (&v)[N]) {
#pragma unroll
    for (int k = 2; k <= N; k <<= 1)
#pragma unroll
        for (int j = k >> 1; j > 0; j >>= 1)
#pragma unroll
            for (int i = 0; i < N; ++i) {
                const int l = i ^ j;
                if (l > i) {
                    const bool desc = ((i & k) == 0);
                    const float a = v[i], b = v[l];
                    const float mx = __builtin_fmaxf(a, b), mn = __builtin_fminf(a, b);
                    v[i] = desc ? mx : mn; v[l] = desc ? mn : mx;
                }
            }
}
template <int N> HD void bitonic_merge_desc(float (&v)[N]) {
#pragma unroll
    for (int j = N >> 1; j > 0; j >>= 1)
#pragma unroll
        for (int i = 0; i < N; ++i) {
            const int l = i ^ j;
            if (l > i) { const float a = v[i], b = v[l]; v[i] = __builtin_fmaxf(a, b); v[l] = __builtin_fminf(a, b); }
        }
}
HD void top16_merge(float (&a)[16], const float (&b)[16]) {
#pragma unroll
    for (int i = 0; i < 16; ++i) a[i] = __builtin_fmaxf(a[i], b[15 - i]);
    bitonic_merge_desc<16>(a);
}
HD void tk_local_top16(const float (&sc)[4][16], int hh, float (&out)[16]) {
    float g[4][16];
#pragma unroll
    for (int kt = 0; kt < 4; ++kt) {
#pragma unroll
        for (int reg = 0; reg < 16; ++reg) { const int key = 32 * kt + (reg & 3) + 8 * (reg >> 2) + 4 * hh; g[kt][reg] = tk_u2f((tk_f2u(sc[kt][reg]) & ~127u) | (unsigned)(127 - key)); }
        bitonic_sort_desc<16>(g[kt]);
    }
    top16_merge(g[0], g[1]); top16_merge(g[2], g[3]); top16_merge(g[0], g[2]);
#pragma unroll
    for (int i = 0; i < 16; ++i) out[i] = g[0][i];
}
constexpr int CA0[25] = {0,0,0,0,0,0,0,0,0,0,0,0,0,0,0,0,1,1,1,1,1,1,1,1,2};
constexpr int CB0[25] = {0,1,2,3,4,5,6,7,8,9,10,11,12,13,14,15,0,1,2,3,4,5,6,7,0};
constexpr int CA1[25] = {2,2,2,2,3,3,3,3,4,4,4,5,5,6,6,7,7,8,9,10,11,12,13,14,15};
constexpr int CB1[25] = {1,2,3,4,0,1,2,3,0,1,2,0,1,0,1,0,1,0,0,0,0,0,0,0,0};
HD void tk_candidates(const float (&T0)[16], const float (&T1)[16], int hh, float (&cv)[32]) {
    float t0[16], t1[16];
#pragma unroll
    for (int i = 0; i < 16; ++i) { t0[i] = tk_u2f(tk_f2u(T0[i]) & ~127u); t1[i] = tk_u2f(tk_f2u(T1[i]) & ~127u); }
#pragma unroll
    for (int j = 0; j < 25; ++j) {
        const float s0 = t0[CA0[j]] + t1[CB0[j]], s1 = t0[CA1[j]] + t1[CB1[j]];
        const unsigned c0 = 255u - (unsigned)(16 * CA0[j] + CB0[j]), c1 = 255u - (unsigned)(16 * CA1[j] + CB1[j]);
        cv[j] = tk_u2f((tk_f2u(hh ? s1 : s0) & ~255u) | (hh ? c1 : c0));
    }
#pragma unroll
    for (int j = 25; j < 32; ++j) cv[j] = -__builtin_inff();
    bitonic_sort_desc<32>(cv);
}

__device__ __forceinline__ void wave_argmax(float& v, int& i) {
#pragma unroll
    for (int o = 32; o >= 1; o >>= 1) {
        const float ov = __shfl_xor(v, o); const int oi = __shfl_xor(i, o);
        if (ov > v || (ov == v && oi < i)) { v = ov; i = oi; }
    }
}
__device__ __forceinline__ void phase_topk_naive(const Ctx& c, const float* __restrict__ Qp, const float* __restrict__ keys, int* __restrict__ eidx, float* __restrict__ gate) {
    float* qsh = (float*)(c.lds + c.wid * 1024);
    float* tv = qsh + 128;
    int* ti = (int*)(tv + 32);
    const int lane = c.lane, gw = c.bid * NWAVES + c.wid, NGW = c.G * NWAVES;
    for (int item = gw; item < NTOK * 8; item += NGW) {
        const int tok = item >> 3, h = item & 7;
        for (int p = 0; p < 2; ++p) {
            const float* q = Qp + (size_t)tok * PQ + h * 256 + p * 128;
            qsh[lane] = q[lane]; qsh[lane + 64] = q[lane + 64];
            WAVE_LDS_SYNC();
            float s[2];
#pragma unroll
            for (int i = 0; i < 2; ++i) {
                const f32x4* kr = (const f32x4*)(keys + ((size_t)(h * 2 + p) * NKEYS + lane + 64 * i) * 128);
                float a = 0.f;
                for (int cc = 0; cc < 32; ++cc) { const f32x4 kk = kr[cc]; a += qsh[4 * cc] * kk[0]; a += qsh[4 * cc + 1] * kk[1]; a += qsh[4 * cc + 2] * kk[2]; a += qsh[4 * cc + 3] * kk[3]; }
                s[i] = a;
            }
            for (int r = 0; r < 16; ++r) {
                float bv; int bi;
                if (s[0] >= s[1]) { bv = s[0]; bi = lane; } else { bv = s[1]; bi = lane + 64; }
                wave_argmax(bv, bi);
                if (bi == lane) s[0] = -INFINITY;
                if (bi == lane + 64) s[1] = -INFINITY;
                if (lane == 0) { tv[p * 16 + r] = bv; ti[p * 16 + r] = bi; }
            }
            WAVE_LDS_SYNC();
        }
        float cv[4];
#pragma unroll
        for (int j = 0; j < 4; ++j) { const int f = lane * 4 + j; cv[j] = tv[f >> 4] + tv[16 + (f & 15)]; }
        float fs = 0.f; int fp = 0;
        for (int r = 0; r < 16; ++r) {
            float bv = cv[0]; int bi = lane * 4;
#pragma unroll
            for (int j = 1; j < 4; ++j) if (cv[j] > bv) { bv = cv[j]; bi = lane * 4 + j; }
            wave_argmax(bv, bi);
#pragma unroll
            for (int j = 0; j < 4; ++j) if (bi == lane * 4 + j) cv[j] = -INFINITY;
            if (lane == r) { fs = bv; fp = bi; }
        }
        const float m = wave_max(lane < 16 ? fs : -INFINITY);
        const float e = lane < 16 ? expf(fs - m) : 0.f;
        const float sum = wave_sum(e);
        if (lane < 16) {
            const int id = ti[fp >> 4] * NKEYS + ti[16 + (fp & 15)];
            eidx[(size_t)item * 16 + lane] = id;
            gate[(size_t)item * 16 + lane] = e / sum;
        }
        WAVE_LDS_SYNC();
    }
}

__device__ __forceinline__ void phase_gather_naive(const Ctx& c, const float* __restrict__ x1, const int* __restrict__ eidx, const float* __restrict__ gate,
                                                   const float* __restrict__ U, const float* __restrict__ V, const float* __restrict__ g, const float* __restrict__ bta,
                                                   float* __restrict__ out, bf16_t* __restrict__ outb) {
    const int lane = c.lane, gw = c.bid * NWAVES + c.wid, NGW = c.G * NWAVES;
    for (int tok = gw; tok < NTOK; tok += NGW) {
        const f32x4* xr = (const f32x4*)(x1 + (size_t)tok * D);
        f32x4 xv[4], acc[4];
#pragma unroll
        for (int j = 0; j < 4; ++j) { xv[j] = xr[lane + 64 * j]; acc[j] = (f32x4){0.f, 0.f, 0.f, 0.f}; }
        for (int k = 0; k < 128; ++k) {
            const int e = eidx[(size_t)tok * 128 + k];
            const float gk = gate[(size_t)tok * 128 + k];
            const f32x4* ur = (const f32x4*)(U + (size_t)e * D);
            const f32x4* vr = (const f32x4*)(V + (size_t)e * D);
            float d = 0.f;
#pragma unroll
            for (int j = 0; j < 4; ++j) { const f32x4 uu = ur[lane + 64 * j]; d += (xv[j][0] * uu[0] + xv[j][1] * uu[1]) + (xv[j][2] * uu[2] + xv[j][3] * uu[3]); }
            d = wave_sum(d);
            const float a = 0.5f * d * (1.f + erff(d * 0.70710678118654752f)) * gk;
#pragma unroll
            for (int j = 0; j < 4; ++j) acc[j] += a * vr[lane + 64 * j];
        }
#pragma unroll
        for (int j = 0; j < 4; ++j) acc[j] = ALPHA * xv[j] + acc[j];
        ln_store_row(acc, lane, g, bta, out + (size_t)tok * D, outb + (size_t)tok * D, nullptr);
    }
}


__device__ __forceinline__ void phase_topk(const Ctx& c, const bf16_t* __restrict__ Qb, const bf16_t* __restrict__ Kb, int* __restrict__ eidx, float* __restrict__ gate) {
    LAS unsigned char* kl = (LAS unsigned char*)c.lds;
    LAS int* scr = (LAS int*)(c.lds + 65536) + c.wid * 1024;
    const int lane = c.lane, r32 = lane & 31, hh = lane >> 5;
    for (int task = c.bid; task < 8 * (NTOK / 256); task += c.G) {
        const int h = task / (NTOK / 256), tb = task % (NTOK / 256);
        __syncthreads();
#pragma unroll
        for (int i = 0; i < 8; ++i) {
            const int ch = c.tid + NTHREADS * i, row = ch >> 4, cc = ch & 15;
            const u32x4 v = *(const u32x4*)(Kb + ((size_t)(h * 256 + row) * 128 + cc * 8));
            *(LAS u32x4*)(kl + row * 256 + ((cc ^ (row & 15)) << 4)) = v;
        }
        __syncthreads();
        const int tok = tb * 256 + c.wid * 32 + r32;
        float T0[16], T1[16];
#pragma unroll
        for (int p = 0; p < 2; ++p) {
            bf16x8 bq[8];
            const bf16_t* qrow = Qb + (size_t)tok * PQ + h * 256 + p * 128 + hh * 8;
#pragma unroll
            for (int ks = 0; ks < 8; ++ks) bq[ks] = *(const bf16x8*)(qrow + 16 * ks);
            f32x16 acc[4];
#pragma unroll
            for (int kt = 0; kt < 4; ++kt)
#pragma unroll
                for (int r = 0; r < 16; ++r) acc[kt][r] = 0.f;
#pragma unroll
            for (int ks = 0; ks < 8; ++ks) {
                const int swz = ((2 * ks + hh) ^ (r32 & 15)) << 4;
#pragma unroll
                for (int kt = 0; kt < 4; ++kt) {
                    const bf16x8 a = *(const LAS bf16x8*)(kl + (p * 128 + 32 * kt + r32) * 256 + swz);
                    acc[kt] = __builtin_amdgcn_mfma_f32_32x32x16_bf16(a, bq[ks], acc[kt], 0, 0, 0);
                }
            }
            float sc[4][16], loc[16], pr[16];
#pragma unroll
            for (int kt = 0; kt < 4; ++kt)
#pragma unroll
                for (int r = 0; r < 16; ++r) sc[kt][r] = acc[kt][r];
            tk_local_top16(sc, hh, loc);
#pragma unroll
            for (int i = 0; i < 16; ++i) pr[i] = __shfl_xor(loc[i], 32);
            top16_merge(loc, pr);
            if (hh == p) {
#pragma unroll
                for (int i = 0; i < 16; ++i) scr[r32 * 32 + p * 16 + i] = 127 - (int)(tk_f2u(loc[i]) & 127u);
            }
#pragma unroll
            for (int i = 0; i < 16; ++i) { if (p == 0) T0[i] = loc[i]; else T1[i] = loc[i]; }
        }
        float cv[32], F[16], pr[16];
        tk_candidates(T0, T1, hh, cv);
#pragma unroll
        for (int i = 0; i < 16; ++i) { F[i] = cv[i]; pr[i] = __shfl_xor(cv[i], 32); }
        top16_merge(F, pr);
        WAVE_LDS_SYNC();
        const float m = tk_u2f(tk_f2u(F[0]) & ~255u);
        float e[16], sum = 0.f;
#pragma unroll
        for (int i = 0; i < 16; ++i) { e[i] = __expf(tk_u2f(tk_f2u(F[i]) & ~255u) - m); sum += e[i]; }
        const float inv = 1.f / sum;
        int ids[8]; float gs[8];
#pragma unroll
        for (int r = 0; r < 8; ++r) {
            const float fv = hh ? F[8 + r] : F[r];
            const unsigned pos = 255u - (tk_f2u(fv) & 255u);
            ids[r] = scr[r32 * 32 + (int)(pos >> 4)] * NKEYS + scr[r32 * 32 + 16 + (int)(pos & 15u)];
            gs[r] = (hh ? e[8 + r] : e[r]) * inv;
        }
        int* ep = eidx + ((size_t)tok * 8 + h) * 16 + 8 * hh; float* gp = gate + ((size_t)tok * 8 + h) * 16 + 8 * hh;
        *(int4*)ep = make_int4(ids[0], ids[1], ids[2], ids[3]); *(int4*)(ep + 4) = make_int4(ids[4], ids[5], ids[6], ids[7]);
        *(f32x4*)gp = (f32x4){gs[0], gs[1], gs[2], gs[3]}; *(f32x4*)(gp + 4) = (f32x4){gs[4], gs[5], gs[6], gs[7]};
        WAVE_LDS_SYNC();
    }
}

__device__ __forceinline__ float gelu_erf(float v) {
    const float av = fabsf(v), t = __builtin_amdgcn_rcpf(av * 0.2316418882f + 1.0f);
    float qq = t * 0.5307027145f + (-0.7265760135f); qq = qq * t + 0.7107068705f; qq = qq * t + (-0.142248368f); qq = qq * t + 0.127414796f; qq = qq * t;
    const float e = __builtin_amdgcn_exp2f((v * v) * (-0.72134752044f));
    const float m = v * (qq * e);
    return v < 0.f ? m : v - m;
}
#define SB() __builtin_amdgcn_sched_barrier(0)
__device__ __forceinline__ void axpy_row(f32x2 (&acc)[8], const u32x4 w, const float a) {
    const f32x2 aa = {a, a};
#pragma unroll
    for (int k = 0; k < 4; ++k) {
        const f32x2 lo = __builtin_amdgcn_cvt_pk_f32_fp8(w[k], false), hi = __builtin_amdgcn_cvt_pk_f32_fp8(w[k], true);
        acc[2 * k] = __builtin_elementwise_fma(lo, aa, acc[2 * k]); acc[2 * k + 1] = __builtin_elementwise_fma(hi, aa, acc[2 * k + 1]);
    }
}
__device__ __forceinline__ void phase_gather(const Ctx& c, const float* __restrict__ x1, const unsigned char* __restrict__ X8, const int* __restrict__ eidx, const float* __restrict__ gate,
                                             const unsigned char* __restrict__ U8, const unsigned char* __restrict__ V8, const float* __restrict__ g, const float* __restrict__ bta,
                                             float* __restrict__ out, bf16_t* __restrict__ outb) {
    const int gw = c.bid * NWAVES + c.wid, NGW = c.G * NWAVES;
    LAS unsigned char* xl = (LAS unsigned char*)c.lds + c.wid * 2048;
    const int lane = c.lane, q = lane >> 4, l15 = lane & 15;
    const unsigned lo16 = (unsigned)lane * 16u;
    int tok = gw;
    if (tok >= NTOK) return;
    int ev0 = eidx[(size_t)tok * 128 + lane], ev1 = eidx[(size_t)tok * 128 + 64 + lane];
    int en0, en1;
    { const int t1 = (tok + NGW < NTOK) ? tok + NGW : tok; en0 = eidx[(size_t)t1 * 128 + lane]; en1 = eidx[(size_t)t1 * 128 + 64 + lane]; }
    *(LAS u32x4*)(xl + lane * 16) = *(const u32x4*)(X8 + (size_t)tok * D + lo16);
    u32x4 bU0[8], bU1[8], bV0[8], bV1[8];
    {
        const unsigned char* ub = U8 + ((unsigned)__shfl(ev0, l15) * (unsigned)D + (unsigned)q * 16u);
#pragma unroll
        for (int t = 0; t < 8; ++t) bU0[t] = *(const u32x4*)(ub + 64 * t);
        SB();
#pragma unroll
        for (int t = 0; t < 8; ++t) bU1[t] = *(const u32x4*)(ub + 512 + 64 * t);
        SB();
#pragma unroll
        for (int i = 0; i < 8; ++i) { const int e = __builtin_amdgcn_readlane(ev0, i); bV0[i] = *(const u32x4*)(V8 + (size_t)e * D + lo16); }
        SB();
    }
    int slot = 0;
#pragma unroll 1
    for (; tok < NTOK; tok += NGW, slot ^= 1) {
        const int tokn = (tok + NGW < NTOK) ? tok + NGW : tok, tok2 = (tok + 2 * NGW < NTOK) ? tok + 2 * NGW : tok;
        const int nn0 = eidx[(size_t)tok2 * 128 + lane], nn1 = eidx[(size_t)tok2 * 128 + 64 + lane];
        const u32x4 xn = *(const u32x4*)(X8 + (size_t)tokn * D + lo16);
        const LAS unsigned char* xc = xl + slot * 1024 + q * 16;
        f32x2 acc[8];
#pragma unroll
        for (int k = 0; k < 8; ++k) acc[k] = (f32x2){0.f, 0.f};
        SB();
#pragma unroll 1
        for (int h = 0; h < 8; ++h) {
            const int evh = (h < 4) ? ev0 : ev1, lb = (h & 3) * 16;
            const bool last = (h == 7);
            const int evn = last ? en0 : ((h + 1 < 4) ? ev0 : ev1), lbn = last ? 0 : ((h + 1) & 3) * 16;
            const f32x4 gq = *(const f32x4*)(gate + (size_t)tok * 128 + h * 16 + 4 * q);
            SB();
#pragma unroll
            for (int i = 0; i < 8; ++i) { const int e = __builtin_amdgcn_readlane(evh, lb + 8 + i); bV1[i] = *(const u32x4*)(V8 + (size_t)e * D + lo16); }
            SB();
            f32x4 h4 = {0.f, 0.f, 0.f, 0.f};
#pragma unroll
            for (int t = 0; t < 8; ++t) {
                const u32x4 xb = *(const LAS u32x4*)(xc + 64 * t);
                const long alo = (long)(((unsigned long long)bU0[t][1] << 32) | bU0[t][0]), ahi = (long)(((unsigned long long)bU0[t][3] << 32) | bU0[t][2]);
                const long xlo = (long)(((unsigned long long)xb[1] << 32) | xb[0]), xhi = (long)(((unsigned long long)xb[3] << 32) | xb[2]);
                h4 = __builtin_amdgcn_mfma_f32_16x16x32_fp8_fp8(alo, xlo, h4, 0, 0, 0);
                h4 = __builtin_amdgcn_mfma_f32_16x16x32_fp8_fp8(ahi, xhi, h4, 0, 0, 0);
                if ((t & 3) == 3) SB();
            }
            const unsigned char* ubn = U8 + ((unsigned)__shfl(evn, lbn + l15) * (unsigned)D + (unsigned)q * 16u);
#pragma unroll
            for (int t = 0; t < 8; ++t) bU0[t] = *(const u32x4*)(ubn + 64 * t);
            SB();
#pragma unroll
            for (int t = 0; t < 8; ++t) {
                const u32x4 xb = *(const LAS u32x4*)(xc + 512 + 64 * t);
                const long alo = (long)(((unsigned long long)bU1[t][1] << 32) | bU1[t][0]), ahi = (long)(((unsigned long long)bU1[t][3] << 32) | bU1[t][2]);
                const long xlo = (long)(((unsigned long long)xb[1] << 32) | xb[0]), xhi = (long)(((unsigned long long)xb[3] << 32) | xb[2]);
                h4 = __builtin_amdgcn_mfma_f32_16x16x32_fp8_fp8(alo, xlo, h4, 0, 0, 0);
                h4 = __builtin_amdgcn_mfma_f32_16x16x32_fp8_fp8(ahi, xhi, h4, 0, 0, 0);
                if ((t & 3) == 3) SB();
            }
            int a4[4];
#pragma unroll
            for (int r = 0; r < 4; ++r) a4[r] = __builtin_bit_cast(int, gelu_erf(h4[r] * (1.f / (XS * US))) * gq[r] * (1.f / VS));
            SB();
#pragma unroll
            for (int t = 0; t < 8; ++t) bU1[t] = *(const u32x4*)(ubn + 512 + 64 * t);
            SB();
#pragma unroll
            for (int i = 0; i < 8; ++i) { axpy_row(acc, bV0[i], __builtin_bit_cast(float, __builtin_amdgcn_readlane(a4[i & 3], 16 * (i >> 2)))); if (i & 1) SB(); }
#pragma unroll
            for (int i = 0; i < 8; ++i) { const int e = __builtin_amdgcn_readlane(evn, lbn + i); bV0[i] = *(const u32x4*)(V8 + (size_t)e * D + lo16); }
            SB();
#pragma unroll
            for (int i = 0; i < 8; ++i) { axpy_row(acc, bV1[i], __builtin_bit_cast(float, __builtin_amdgcn_readlane(a4[i & 3], 32 + 16 * (i >> 2)))); if (i & 1) SB(); }
        }
        *(LAS u32x4*)(xl + (slot ^ 1) * 1024 + lane * 16) = xn;
        const f32x4* xr = (const f32x4*)(x1 + (size_t)tok * D) + 4 * lane;
        float sm = 0.f;
#pragma unroll
        for (int w = 0; w < 4; ++w) { const f32x4 xv = xr[w];
            acc[2 * w][0] += ALPHA * xv[0]; acc[2 * w][1] += ALPHA * xv[1]; acc[2 * w + 1][0] += ALPHA * xv[2]; acc[2 * w + 1][1] += ALPHA * xv[3];
            sm += (acc[2 * w][0] + acc[2 * w][1]) + (acc[2 * w + 1][0] + acc[2 * w + 1][1]); }
        const float mean = wave_sum(sm) * (1.f / D); float s2 = 0.f;
#pragma unroll
        for (int k = 0; k < 8; ++k) { acc[k] = acc[k] - mean; s2 += acc[k][0] * acc[k][0] + acc[k][1] * acc[k][1]; }
        const float rstd = rsqrtf(wave_sum(s2) * (1.f / D) + LN_EPS);
#pragma unroll
        for (int w = 0; w < 4; ++w) {
            const f32x4 gg = ((const f32x4*)g)[4 * lane + w], be = ((const f32x4*)bta)[4 * lane + w];
            f32x4 o;
            o[0] = acc[2 * w][0] * rstd * gg[0] + be[0]; o[1] = acc[2 * w][1] * rstd * gg[1] + be[1];
            o[2] = acc[2 * w + 1][0] * rstd * gg[2] + be[2]; o[3] = acc[2 * w + 1][1] * rstd * gg[3] + be[3];
            ((f32x4*)(out + (size_t)tok * D))[4 * lane + w] = o;
            uint2 ob; ob.x = f2bf(o[0]) | ((unsigned)f2bf(o[1]) << 16); ob.y = f2bf(o[2]) | ((unsigned)f2bf(o[3]) << 16);
            ((uint2*)(outb + (size_t)tok * D))[4 * lane + w] = ob;
        }
        ev0 = en0; ev1 = en1; en0 = nn0; en1 = nn1;
        SB();
    }
}

constexpr size_t MiB = 1u << 20;
constexpr size_t WS_WIN = 0;
constexpr size_t WS_WO = 20 * MiB;
constexpr size_t WS_WQ = 28 * MiB;
constexpr size_t WS_XB = 48 * MiB;
constexpr size_t WS_XA = 112 * MiB;
constexpr size_t WS_X1 = 240 * MiB;
constexpr size_t WS_H = 368 * MiB;
constexpr size_t WS_Y = 512 * MiB;
constexpr size_t WS_Z = 576 * MiB;
constexpr size_t WS_QP = 368 * MiB;
constexpr size_t WS_KB = 44 * MiB;
constexpr size_t WS_EI = 704 * MiB;
constexpr size_t WS_GT = 720 * MiB;
constexpr size_t WS_U8 = 736 * MiB;
constexpr size_t WS_V8 = 800 * MiB;
constexpr size_t WS_X8 = 864 * MiB;
constexpr size_t WS_END = 896 * MiB;

struct Params { const float* in[16]; float* out; unsigned char* ws; };

__global__ void __launch_bounds__(NTHREADS, 2) mega_fwd(Params P) {
    extern __shared__ __attribute__((aligned(16))) unsigned char lds[];
    cg::grid_group grid = cg::this_grid();
    const float* x = P.in[0]; const float* w_in = P.in[1]; const float* w_o = P.in[2]; const float* sink = P.in[3]; const float* rpb = P.in[4]; const float* t5 = P.in[5];
    const float* ga = P.in[6]; const float* gb = P.in[7]; const float* l1g = P.in[8]; const float* l1b = P.in[9]; const float* l2g = P.in[10]; const float* l2b = P.in[11];
    const float* wq = P.in[12]; const float* keys = P.in[13]; const float* pu = P.in[14]; const float* pv = P.in[15];
    unsigned char* ws = P.ws;
    bf16_t* WinT = (bf16_t*)(ws + WS_WIN); bf16_t* WoT = (bf16_t*)(ws + WS_WO); bf16_t* WqT = (bf16_t*)(ws + WS_WQ);
    bf16_t* Xb = (bf16_t*)(ws + WS_XB); float* XA = (float*)(ws + WS_XA); float* X1 = (float*)(ws + WS_X1);
    bf16_t* H = (bf16_t*)(ws + WS_H); bf16_t* Y = (bf16_t*)(ws + WS_Y); float* Z = (float*)(ws + WS_Z); bf16_t* Qb = (bf16_t*)(ws + WS_QP); bf16_t* Kb = (bf16_t*)(ws + WS_KB);
    int* EI = (int*)(ws + WS_EI); float* GT = (float*)(ws + WS_GT);
    unsigned char* U8 = ws + WS_U8; unsigned char* V8 = ws + WS_V8; unsigned char* X8 = ws + WS_X8;

    phase_convert(make_ctx(lds), w_in, w_o, wq, x, pu, pv, WinT, WoT, WqT, Xb, U8, V8, keys, Kb);
    grid.sync();
#pragma unroll 1
    for (int l = 0; l < DEPTH; ++l) {
        const float* xin = (l == 0) ? x : XA;
        float* xout = (l == DEPTH - 1) ? P.out : XA;
        phase_gemm_simple<EpiH, PROJ, D>(make_ctx(lds), Xb, WinT + (size_t)l * PROJ * D, EpiH{H});
        grid.sync();
        phase_attn(make_ctx(lds), H, sink + l * 8, t5, rpb + (size_t)l * 8 * 15 * 31, Z);
        grid.sync();
        phase_rmsnorm(make_ctx(lds), Z, ga + l * 512, gb + l * 512, Y);
        grid.sync();
        phase_gemm_simple<EpiZ, D, D>(make_ctx(lds), Y, WoT + (size_t)l * D * D, EpiZ{xin, Z});
        grid.sync();
        phase_ln(make_ctx(lds), Z, l1g + l * D, l1b + l * D, X1, Xb, X8);
        grid.sync();
        phase_gemm_simple<EpiQ, PQ, D>(make_ctx(lds), Xb, WqT + (size_t)l * PQ * D, EpiQ{Qb});
        grid.sync();
        phase_topk(make_ctx(lds), Qb, Kb + (size_t)l * 8 * 2 * NKEYS * 128, EI, GT);
        grid.sync();
        phase_gather(make_ctx(lds), X1, X8, EI, GT, U8 + (size_t)l * NEXP * D, V8 + (size_t)l * NEXP * D, l2g + l * D, l2b + l * D, xout, Xb);
        grid.sync();
    }
}

extern "C" void kernel_launch(void* const* d_in, const int* in_sizes, int n_in, void* d_out, int out_size, void* d_ws, size_t ws_size, hipStream_t stream) {
    static int grid = 0;
    if (grid == 0) {
        if (n_in != 16 || ws_size < WS_END || out_size != NTOK * D) { fprintf(stderr, "kernel_launch: unexpected shapes\n"); grid = -1; return; }
        int dev = 0, cus = 0, per_cu = 0;
        hipGetDevice(&dev);
        hipDeviceGetAttribute(&cus, hipDeviceAttributeMultiprocessorCount, dev);
        hipFuncSetAttribute((const void*)mega_fwd, hipFuncAttributeMaxDynamicSharedMemorySize, LDS_BYTES);
        hipOccupancyMaxActiveBlocksPerMultiprocessor(&per_cu, (const void*)mega_fwd, NTHREADS, LDS_BYTES);
        if (per_cu < 1) { fprintf(stderr, "kernel_launch: occupancy query says %d blocks/CU\n", per_cu); grid = -1; return; }
        grid = cus;
    }
    if (grid < 0) return;
    Params P{};
    for (int i = 0; i < 16; ++i) P.in[i] = (const float*)d_in[i];
    P.out = (float*)d_out; P.ws = (unsigned char*)d_ws;
    void* args[] = {&P};
    hipError_t e = hipLaunchCooperativeKernel((const void*)mega_fwd, dim3(grid), dim3(NTHREADS), args, LDS_BYTES, stream);
    if (e != hipSuccess) fprintf(stderr, "cooperative launch failed: %s (grid %d)\n", hipGetErrorString(e), grid);
}
```

```cpp
#include <hip/hip_runtime.h>
#include <hip/hip_cooperative_groups.h>
#include <stdint.h>
#include <cstdio>
namespace cg = cooperative_groups;

typedef unsigned short bf16_t;
typedef short bf16x8 __attribute__((ext_vector_type(8)));
typedef float f32x4 __attribute__((ext_vector_type(4)));

constexpr int D = 1024, BATCH = 8, SEQ = 4096, DEPTH = 4, NTOK = BATCH * SEQ;
constexpr int HD = 64, PROJ = 2304;
constexpr int O1 = 512, O2 = 640, O3 = 768, O4 = 1280, O5 = 1792;
constexpr int PQ = 2048, NKEYS = 128, NEXP = 16384, TOPK = 16;
constexpr float LN_EPS = 1e-5f;
constexpr float NEGF = -1e30f;
constexpr float ALPHA = 1.6817928305074290f;

__device__ __forceinline__ bf16_t f2bf(float f) { unsigned u = __float_as_uint(f); return (bf16_t)((u + 0x7fffu + ((u >> 16) & 1u)) >> 16); }
__device__ __forceinline__ float bf2f(bf16_t h) { return __uint_as_float(((unsigned)h) << 16); }
__device__ __forceinline__ float wave_sum(float v) {
#pragma unroll
    for (int o = 1; o < 64; o <<= 1) v += __shfl_xor(v, o);
    return v;
}
__device__ __forceinline__ float wave_max(float v) {
#pragma unroll
    for (int o = 1; o < 64; o <<= 1) v = fmaxf(v, __shfl_xor(v, o));
    return v;
}


#define LAS __attribute__((address_space(3)))
typedef float f32x2 __attribute__((ext_vector_type(2)));
typedef unsigned u32x4 __attribute__((ext_vector_type(4)));
typedef unsigned u32x2 __attribute__((ext_vector_type(2)));
typedef float f32x16 __attribute__((ext_vector_type(16)));
constexpr float XS = 8.f, US = 64.f, VS = 16.f;
__device__ __forceinline__ unsigned pack4_fp8(f32x4 v, float sc) {
    v = v * sc;
#pragma unroll
    for (int i = 0; i < 4; ++i) v[i] = fminf(fmaxf(v[i], -448.f), 448.f);
    unsigned p = 0;
    p = __builtin_amdgcn_cvt_pk_fp8_f32(v[0], v[1], p, false);
    p = __builtin_amdgcn_cvt_pk_fp8_f32(v[2], v[3], p, true);
    return p;
}
constexpr int NTHREADS = 512, NWAVES = 8;
constexpr int LDS_BYTES = 147456;

struct Ctx { int tid, lane, wid, bid, G; unsigned char* lds; };
__device__ __forceinline__ Ctx make_ctx(unsigned char* lds) {
    Ctx c; int t = threadIdx.x; asm volatile("" : "+v"(t));
    c.tid = t; c.lane = t & 63; c.wid = __builtin_amdgcn_readfirstlane(t >> 6); c.bid = blockIdx.x; c.G = gridDim.x; c.lds = lds; return c;
}

__device__ __forceinline__ void transpose_item(const float* __restrict__ W, int K, int N, bf16_t* __restrict__ WT, float* scr, int item, int lane) {
    const int nblk = N / 32, kb = item / nblk, nb = item % nblk, k0 = 64 * kb, n0 = 32 * nb;
#pragma unroll 8
    for (int i = 0; i < 32; ++i) { const int kk = 2 * i + (lane >> 5); scr[kk * 33 + (lane & 31)] = W[(size_t)(k0 + kk) * N + n0 + (lane & 31)]; }
    __builtin_amdgcn_fence(__ATOMIC_RELEASE, "wavefront"); __builtin_amdgcn_wave_barrier(); __builtin_amdgcn_fence(__ATOMIC_ACQUIRE, "wavefront");
    const int c = lane & 7;
#pragma unroll
    for (int j = 0; j < 4; ++j) {
        const int n = (lane >> 3) + 8 * j; const float* sp = scr + (8 * c) * 33 + n;
        uint4 o;
        o.x = f2bf(sp[0 * 33]) | ((unsigned)f2bf(sp[1 * 33]) << 16); o.y = f2bf(sp[2 * 33]) | ((unsigned)f2bf(sp[3 * 33]) << 16);
        o.z = f2bf(sp[4 * 33]) | ((unsigned)f2bf(sp[5 * 33]) << 16); o.w = f2bf(sp[6 * 33]) | ((unsigned)f2bf(sp[7 * 33]) << 16);
        *(uint4*)(WT + (size_t)(n0 + n) * K + k0 + 8 * c) = o;
    }
    __builtin_amdgcn_fence(__ATOMIC_RELEASE, "wavefront"); __builtin_amdgcn_wave_barrier(); __builtin_amdgcn_fence(__ATOMIC_ACQUIRE, "wavefront");
}
__device__ __forceinline__ void phase_convert(const Ctx& c, const float* w_in, const float* w_o, const float* wq, const float* x, const float* pu, const float* pv,
                                              bf16_t* WinT, bf16_t* WoT, bf16_t* WqT, bf16_t* Xb, unsigned char* U8, unsigned char* V8, const float* keys, bf16_t* Kb) {
    float* scr = (float*)(c.lds + c.wid * 16384);
    const int gw = c.bid * NWAVES + c.wid, NGW = c.G * NWAVES;
    constexpr int I_IN = (D / 64) * (PROJ / 32), I_O = (D / 64) * (D / 32), I_Q = (D / 64) * (PQ / 32);
    constexpr int NIT = DEPTH * (I_IN + I_O + I_Q);
    for (int it = gw; it < NIT; it += NGW) {
        const int l = it / (I_IN + I_O + I_Q); int r = it % (I_IN + I_O + I_Q);
        if (r < I_IN) { transpose_item(w_in + (size_t)l * D * PROJ, D, PROJ, WinT + (size_t)l * PROJ * D, scr, r, c.lane); continue; } r -= I_IN;
        if (r < I_O) { transpose_item(w_o + (size_t)l * D * D, D, D, WoT + (size_t)l * D * D, scr, r, c.lane); continue; } r -= I_O;
        transpose_item(wq + (size_t)l * D * PQ, D, PQ, WqT + (size_t)l * PQ * D, scr, r, c.lane);
    }
    const size_t n4 = (size_t)NTOK * D / 4;
    for (size_t i = (size_t)c.bid * NTHREADS + c.tid; i < n4; i += (size_t)c.G * NTHREADS) {
        const f32x4 v = ((const f32x4*)x)[i];
        uint2 o; o.x = f2bf(v[0]) | ((unsigned)f2bf(v[1]) << 16); o.y = f2bf(v[2]) | ((unsigned)f2bf(v[3]) << 16);
        ((uint2*)Xb)[i] = o;
    }
    {
        const size_t k4 = (size_t)DEPTH * 8 * 2 * NKEYS * 128 / 4;
        for (size_t i = (size_t)c.bid * NTHREADS + c.tid; i < k4; i += (size_t)c.G * NTHREADS) {
            const f32x4 v = ((const f32x4*)keys)[i];
            uint2 o; o.x = f2bf(v[0]) | ((unsigned)f2bf(v[1]) << 16); o.y = f2bf(v[2]) | ((unsigned)f2bf(v[3]) << 16);
            ((uint2*)Kb)[i] = o;
        }
    }
    const size_t n16 = (size_t)DEPTH * NEXP * D / 16;
    for (size_t i = (size_t)c.bid * NTHREADS + c.tid; i < n16; i += (size_t)c.G * NTHREADS) {
        const f32x4* pa = (const f32x4*)pu + 4 * i; const f32x4* pb = (const f32x4*)pv + 4 * i;
        uint4 oa, ob;
        oa.x = pack4_fp8(pa[0], US); oa.y = pack4_fp8(pa[1], US); oa.z = pack4_fp8(pa[2], US); oa.w = pack4_fp8(pa[3], US);
        ob.x = pack4_fp8(pb[0], VS); ob.y = pack4_fp8(pb[1], VS); ob.z = pack4_fp8(pb[2], VS); ob.w = pack4_fp8(pb[3], VS);
        ((uint4*)U8)[i] = oa; ((uint4*)V8)[i] = ob;
    }
}


namespace pg8 {
#define PG8_LAS __attribute__((address_space(3)))
typedef unsigned short bf16_t;
typedef short bf16x8 __attribute__((ext_vector_type(8)));
typedef float f32x4 __attribute__((ext_vector_type(4)));
typedef unsigned u32x4 __attribute__((ext_vector_type(4)));
constexpr int BM = 256, BK = 64, HALF = 128, HTB = HALF * BK * 2  , STAGE_BYTES = 8 * HTB, NXCD = 8, WGM = 8;

__host__ __device__ __forceinline__ int lds_byte(int r, int c) { const int st = (r >> 4) * 2 + (c >> 5), rr = r & 15, cc = c & 31, ob = rr * 64 + cc * 2; return st * 1024 + (ob ^ (((ob >> 9) & 1) << 5)); }
__host__ __device__ __forceinline__ void stage_rc(int b, int& R, int& C) { const int st = b / 1024, sb = b % 1024, swz = sb ^ (((sb >> 9) & 1) << 5); R = (st >> 1) * 16 + swz / 64; C = (st & 1) * 32 + (swz % 64) / 2; }
__host__ __device__ __forceinline__ int perm32(int rho) { const int n = rho >> 4, i = rho & 15; return 8 * (i >> 2) + 4 * n + (i & 3); }

struct Unit { int pm, pn; };
struct Gemm { const bf16_t* A; const bf16_t* Bt; int M, N, K; };

struct StaticOrder {
    int nM, nN, nwg, G, c;
    __host__ __device__ void init(int M, int N, int G_, int c_) { nM = M / BM; nN = N / BM; nwg = nM * nN; G = G_; c = c_; }
    __host__ __device__ bool next(int i, Unit& u) const {
        const long L = (long)i * G + c; if (L >= nwg) return false;
        int wgid = (int)L; { const int q = nwg / NXCD, r = nwg % NXCD, xcd = wgid % NXCD, off = wgid / NXCD; wgid = (xcd < r ? xcd * (q + 1) : r * (q + 1) + (xcd - r) * q) + off; }
        const int nig = WGM * nN, gid = wgid / nig, fm = gid * WGM, gsz = (nM - fm) < WGM ? (nM - fm) : WGM;
        u.pm = fm + ((wgid % nig) % gsz); u.pn = (wgid % nig) / gsz; return true;
    }
    __device__ __forceinline__ void a_ready(const Unit&) const {}
    __device__ __forceinline__ void done(const Unit&) const {}
};

__device__ __forceinline__ unsigned cvt_pk_bf16(float lo, float hi) { unsigned r; asm volatile("v_cvt_pk_bf16_f32 %0, %1, %2" : "=v"(r) : "v"(lo), "v"(hi)); return r; }
typedef float f32x2 __attribute__((ext_vector_type(2)));
__device__ __forceinline__ f32x2 gelu_pk(f32x2 v) {
    const f32x2 av = __builtin_elementwise_abs(v), d = av * 0.2316418882f + 1.0f;
    f32x2 t; t.x = __builtin_amdgcn_rcpf(d.x); t.y = __builtin_amdgcn_rcpf(d.y);
    f32x2 q = t * 0.5307027145f + (-0.7265760135f); q = q * t + 0.7107068705f; q = q * t + (-0.142248368f); q = q * t + 0.127414796f; q = q * t;
    const f32x2 s = (v * v) * (-0.72134752044f);
    f32x2 e; e.x = __builtin_amdgcn_exp2f(s.x); e.y = __builtin_amdgcn_exp2f(s.y);
    const f32x2 m = v * (q * e), r = v - m;
    f32x2 o; o.x = v.x < 0.f ? m.x : r.x; o.y = v.y < 0.f ? m.y : r.y; return o;
}

template <int ACT  > struct EpiBf16 {
    static constexpr bool PERM = true, AFTER_DRAIN = false; static_assert(ACT == 0 || ACT == 1, "EpiBf16: ACT is 0 (none) or 1 (gelu_pk)");
    bf16_t* O; int ldc; const float* bias; int split_cols; size_t split_stride; float scale0;
    __device__ __forceinline__ void operator()(const f32x4 (&acc)[2][2][4][2], const Unit& u, int wr, int wc, int fr, int fq) const {
        const int row0 = u.pm * BM + wr * 64 + fr; int colt = u.pn * BM; bf16_t* base = O;
        float sc = 1.f; if (split_cols) { const int t = colt / split_cols; base += (size_t)t * split_stride; colt -= t * split_cols; if (t == 0) sc = scale0; }
        const int col0 = colt + wc * 32 + 8 * fq, bcol0 = u.pn * BM + wc * 32 + 8 * fq;
        f32x4 bv[2][2];
#pragma unroll
        for (int bj = 0; bj < 2; ++bj)
#pragma unroll
            for (int n = 0; n < 2; ++n) bv[bj][n] = bias ? *(const f32x4*)(bias + bcol0 + bj * HALF + 4 * n) : (f32x4){0.f, 0.f, 0.f, 0.f};
#pragma unroll
        for (int ai = 0; ai < 2; ++ai)
#pragma unroll
            for (int m = 0; m < 4; ++m) { bf16_t* rowp = base + (size_t)(row0 + ai * HALF + m * 16) * ldc + col0;
#pragma unroll
                for (int bj = 0; bj < 2; ++bj) { f32x4 v0 = acc[ai][bj][m][0] + bv[bj][0], v1 = acc[ai][bj][m][1] + bv[bj][1];
                    if (ACT == 1) { f32x2 a = gelu_pk((f32x2){v0[0], v0[1]}), b = gelu_pk((f32x2){v0[2], v0[3]}), c = gelu_pk((f32x2){v1[0], v1[1]}), d = gelu_pk((f32x2){v1[2], v1[3]});
                        v0 = (f32x4){a.x, a.y, b.x, b.y}; v1 = (f32x4){c.x, c.y, d.x, d.y}; }
                    v0 = v0 * sc; v1 = v1 * sc; u32x4 w; w.x = cvt_pk_bf16(v0[0], v0[1]); w.y = cvt_pk_bf16(v0[2], v0[3]); w.z = cvt_pk_bf16(v1[0], v1[1]); w.w = cvt_pk_bf16(v1[2], v1[3]);
                    *(u32x4*)(rowp + bj * HALF) = w; } }
    }
};

template <class Epi, class Sched, bool ALIGN_EPI = false, bool SP2 = false>
__device__ __forceinline__ void gemm_phase(PG8_LAS unsigned char* lds, const Gemm g, const Sched& S, const Epi& E) {
    int tid = threadIdx.x; asm volatile("" : "+v"(tid));
    const int wid = __builtin_amdgcn_readfirstlane(tid >> 6), lane = tid & 63, wr = wid >> 2, wc = wid & 3, fr = lane & 15, fq = lane >> 4;
    const int K = g.K, nt = K / BK;
    unsigned voffA[2], voffB[2];
#pragma unroll
    for (int i = 0; i < 2; ++i) { int R, C; stage_rc(tid * 16 + i * 8192, R, C); const int Rb = Epi::PERM ? ((R & ~31) + perm32(R & 31)) : R;
        voffA[i] = (unsigned)(R * K + C) * 2u; voffB[i] = (unsigned)(Rb * K + C) * 2u; }
    const size_t kstep = (size_t)(BK * 2);
    const size_t hstep = (size_t)HALF * K * 2;
    const size_t tstep = 2 * hstep;
    const unsigned ldsw = (unsigned)wid * 1024u;
    const int aoff = lds_byte(wr * 64 + fr, fq * 8), boff = lds_byte(wc * 32 + fr, fq * 8);
#define PG8_SA(b, h) (((b) * 2 + (h)) * HTB)
#define PG8_SB(b, h) ((4 + (b) * 2 + (h)) * HTB)
#define PG8_STAGE(bufoff, gbase, voff) do { _Pragma("unroll") for (int _i = 0; _i < 2; ++_i) \
        __builtin_amdgcn_global_load_lds((const unsigned*)((const char*)(gbase) + (voff)[_i]), (PG8_LAS unsigned*)(lds + (bufoff) + ldsw + _i * 8192), 16, 0, 0); } while (0)
#define PG8_LDA(dst, b, h) do { _Pragma("unroll") for (int m = 0; m < 4; ++m) _Pragma("unroll") for (int k = 0; k < 2; ++k) dst[m][k] = *(const PG8_LAS bf16x8*)(lds + PG8_SA(b, h) + aoff + m * 2048 + k * 1024); } while (0)
#define PG8_LDB(dst, b, h) do { _Pragma("unroll") for (int n = 0; n < 2; ++n) _Pragma("unroll") for (int k = 0; k < 2; ++k) dst[n][k] = *(const PG8_LAS bf16x8*)(lds + PG8_SB(b, h) + boff + n * 2048 + k * 1024); } while (0)
#define PG8_MMA(ai, bj, At, Bt) do { __builtin_amdgcn_s_setprio(1); _Pragma("unroll") for (int m = 0; m < 4; ++m) _Pragma("unroll") for (int n = 0; n < 2; ++n) _Pragma("unroll") for (int k = 0; k < 2; ++k) \
        acc[ai][bj][m][n] = __builtin_amdgcn_mfma_f32_16x16x32_bf16(Bt[n][k], At[m][k], acc[ai][bj][m][n], 0, 0, 0); __builtin_amdgcn_s_setprio(0); } while (0)
#define PG8_WAIT_V(n) asm volatile("s_waitcnt vmcnt(" #n ")" ::: "memory")
#define PG8_WAIT_L(n) asm volatile("s_waitcnt lgkmcnt(" #n ")" ::: "memory")
#define PG8_BAR __builtin_amdgcn_s_barrier()
#define PG8_SCHED __builtin_amdgcn_sched_barrier(0)
    Unit cur, nxt; int ui = 0;
    if (!S.next(0, cur)) return;
    f32x4 acc[2][2][4][2];
#pragma unroll
    for (int a = 0; a < 2; ++a)
#pragma unroll
        for (int b = 0; b < 2; ++b)
#pragma unroll
            for (int m = 0; m < 4; ++m)
#pragma unroll
                for (int n = 0; n < 2; ++n) acc[a][b][m][n] = (f32x4){0.f, 0.f, 0.f, 0.f};
    bf16x8 At[4][2], B0[2][2], B1[2][2];
    const char* cA = (const char*)g.A + (size_t)cur.pm * tstep; const char* cB = (const char*)g.Bt + (size_t)cur.pn * tstep;
    S.a_ready(cur);
    if constexpr (SP2) {
        PG8_STAGE(PG8_SB(0, 0), cB, voffB); PG8_STAGE(PG8_SB(0, 1), cB + hstep, voffB); PG8_STAGE(PG8_SA(0, 0), cA, voffA); PG8_STAGE(PG8_SA(0, 1), cA + hstep, voffA);
        if (wr == 1) PG8_BAR;
        PG8_WAIT_V(2); PG8_BAR;
        PG8_STAGE(PG8_SB(1, 0), cB + kstep, voffB); PG8_STAGE(PG8_SA(1, 0), cA + kstep, voffA); PG8_STAGE(PG8_SB(1, 1), cB + hstep + kstep, voffB);
        PG8_WAIT_V(6); PG8_BAR;
    } else {
        PG8_STAGE(PG8_SB(0, 0), cB, voffB); PG8_STAGE(PG8_SA(0, 0), cA, voffA); PG8_STAGE(PG8_SB(0, 1), cB + hstep, voffB); PG8_STAGE(PG8_SA(0, 1), cA + hstep, voffA);
        if (wr == 1) PG8_BAR;
        PG8_WAIT_V(4); PG8_BAR;
        PG8_STAGE(PG8_SB(1, 0), cB + kstep, voffB); PG8_STAGE(PG8_SA(1, 0), cA + kstep, voffA); PG8_STAGE(PG8_SB(1, 1), cB + hstep + kstep, voffB);
        PG8_WAIT_V(6); PG8_BAR;
    }
    for (;;) {
        const bool has_next = S.next(ui + 1, nxt);
        const char* nA = has_next ? (const char*)g.A + (size_t)nxt.pm * tstep : cA; const char* nB = has_next ? (const char*)g.Bt + (size_t)nxt.pn * tstep : cB;
        for (int t = 0; t < nt; t += 2) {
            const bool last = (t == nt - 2);
            const char* a1 = cA + (size_t)(t + 1) * kstep;
            const char* a2 = last ? nA : cA + (size_t)(t + 2) * kstep; const char* b2 = last ? nB : cB + (size_t)(t + 2) * kstep;
            const char* a3 = a2 + kstep; const char* b3 = b2 + kstep;
            if (last && has_next) S.a_ready(nxt);
            if constexpr (SP2) {
            PG8_LDB(B0, 0, 0); PG8_LDB(B1, 0, 1); PG8_SCHED; PG8_LDA(At, 0, 0); PG8_STAGE(PG8_SA(1, 1), a1 + hstep, voffA);
            PG8_WAIT_V(8); PG8_WAIT_L(0); PG8_BAR; PG8_MMA(0, 0, At, B0); PG8_MMA(0, 1, At, B1); PG8_BAR; PG8_SCHED;
            PG8_LDA(At, 0, 1); PG8_STAGE(PG8_SB(0, 0), b2, voffB); PG8_STAGE(PG8_SB(0, 1), b2 + hstep, voffB); PG8_STAGE(PG8_SA(0, 0), a2, voffA);
            PG8_WAIT_V(8); PG8_WAIT_L(0); PG8_BAR; PG8_MMA(1, 0, At, B0); PG8_MMA(1, 1, At, B1); PG8_BAR; PG8_SCHED;
            PG8_LDB(B0, 1, 0); PG8_LDB(B1, 1, 1); PG8_SCHED; PG8_LDA(At, 1, 0); PG8_STAGE(PG8_SA(0, 1), a2 + hstep, voffA);
            PG8_WAIT_V(8); PG8_WAIT_L(0); PG8_BAR; PG8_MMA(0, 0, At, B0); PG8_MMA(0, 1, At, B1); PG8_BAR; PG8_SCHED;
            PG8_LDA(At, 1, 1); PG8_STAGE(PG8_SB(1, 0), b3, voffB); PG8_STAGE(PG8_SB(1, 1), b3 + hstep, voffB); PG8_STAGE(PG8_SA(1, 0), a3, voffA);
            PG8_WAIT_V(8); PG8_WAIT_L(0); PG8_BAR; PG8_MMA(1, 0, At, B0); PG8_MMA(1, 1, At, B1); PG8_BAR; PG8_SCHED;
            } else {
            PG8_LDB(B0, 0, 0); PG8_SCHED; PG8_LDA(At, 0, 0); PG8_STAGE(PG8_SA(1, 1), a1 + hstep, voffA);
            PG8_WAIT_L(8); PG8_BAR; PG8_WAIT_L(0); PG8_MMA(0, 0, At, B0); PG8_BAR; PG8_SCHED;
            PG8_LDB(B1, 0, 1); PG8_STAGE(PG8_SB(0, 0), b2, voffB);
            PG8_BAR; PG8_WAIT_L(0); PG8_MMA(0, 1, At, B1); PG8_BAR;
            PG8_LDA(At, 0, 1); PG8_STAGE(PG8_SA(0, 0), a2, voffA);
            PG8_BAR; PG8_WAIT_L(0); PG8_MMA(1, 0, At, B0); PG8_BAR; PG8_SCHED;
            PG8_STAGE(PG8_SB(0, 1), b2 + hstep, voffB);
            PG8_WAIT_V(6); PG8_BAR; PG8_MMA(1, 1, At, B1); PG8_BAR;
            PG8_LDB(B0, 1, 0); PG8_SCHED; PG8_LDA(At, 1, 0); PG8_STAGE(PG8_SA(0, 1), a2 + hstep, voffA);
            PG8_WAIT_L(8); PG8_BAR; PG8_WAIT_L(0); PG8_MMA(0, 0, At, B0); PG8_BAR; PG8_SCHED;
            PG8_LDB(B1, 1, 1); PG8_STAGE(PG8_SB(1, 0), b3, voffB);
            PG8_BAR; PG8_WAIT_L(0); PG8_MMA(0, 1, At, B1); PG8_BAR;
            PG8_LDA(At, 1, 1); PG8_STAGE(PG8_SA(1, 0), a3, voffA);
            PG8_BAR; PG8_WAIT_L(0); PG8_MMA(1, 0, At, B0); PG8_BAR; PG8_SCHED;
            PG8_STAGE(PG8_SB(1, 1), b3 + hstep, voffB);
            PG8_WAIT_V(6); PG8_BAR; PG8_MMA(1, 1, At, B1); PG8_BAR;
            }
        }
        if constexpr (ALIGN_EPI) { if (wr == 0) PG8_BAR; }
        if constexpr (!Epi::AFTER_DRAIN) { E(acc, cur, wr, wc, fr, fq); S.done(cur); }
        if (!has_next) break;
#pragma unroll
        for (int a = 0; a < 2; ++a)
#pragma unroll
            for (int b = 0; b < 2; ++b)
#pragma unroll
                for (int m = 0; m < 4; ++m)
#pragma unroll
                    for (int n = 0; n < 2; ++n) acc[a][b][m][n] = (f32x4){0.f, 0.f, 0.f, 0.f};
        cur = nxt; cA = nA; cB = nB; ++ui;
        if constexpr (ALIGN_EPI) { if (wr == 1) PG8_BAR; }
    }
    PG8_WAIT_V(0);
    if constexpr (!ALIGN_EPI) { if (wr == 0) PG8_BAR; }
    PG8_BAR;
    if constexpr (Epi::AFTER_DRAIN) { E.fused(acc, cur, wr, wc, fr, fq, lds, wid, lane); S.done(cur); }
#undef PG8_SA
#undef PG8_SB
#undef PG8_STAGE
#undef PG8_LDA
#undef PG8_LDB
#undef PG8_MMA
#undef PG8_WAIT_V
#undef PG8_WAIT_L
#undef PG8_BAR
#undef PG8_SCHED
}
}
struct EpiZf32 {
    static constexpr bool PERM = false, AFTER_DRAIN = false;
    const float* x; float* Z;
    __device__ __forceinline__ void operator()(const pg8::f32x4 (&acc)[2][2][4][2], const pg8::Unit& u, int wr, int wc, int fr, int fq) const {
#pragma unroll
        for (int ai = 0; ai < 2; ++ai)
#pragma unroll
            for (int m = 0; m < 4; ++m) {
                const size_t rowoff = (size_t)(u.pm * 256 + ai * 128 + wr * 64 + m * 16 + fr) * D + u.pn * 256 + wc * 32 + 4 * fq;
#pragma unroll
                for (int bj = 0; bj < 2; ++bj)
#pragma unroll
                    for (int n = 0; n < 2; ++n) {
                        const size_t i = rowoff + bj * 128 + n * 16;
                        const pg8::f32x4 xv = *(const pg8::f32x4*)(x + i);
                        *(pg8::f32x4*)(Z + i) = xv * ALPHA + acc[ai][bj][m][n];
                    }
            }
    }
};
template <class Epi, bool ALIGN>
__device__ __forceinline__ void phase_gemm(unsigned char* lds, const bf16_t* A, const bf16_t* Bt, int N, const Epi& E) {
    pg8::Gemm g{A, Bt, NTOK, N, D};
    pg8::StaticOrder S; S.init(NTOK, N, (int)gridDim.x, (int)blockIdx.x);
    pg8::gemm_phase<Epi, pg8::StaticOrder, ALIGN, true>((PG8_LAS unsigned char*)lds, g, S, E);
}

struct EpiH { bf16_t* H; __device__ void operator()(int r, int c, float v) const { H[(size_t)r * PROJ + c] = f2bf(v); } };
struct EpiZ { const float* x; float* Z; __device__ void operator()(int r, int c, float v) const { size_t i = (size_t)r * D + c; Z[i] = ALPHA * x[i] + v; } };
struct EpiQ { bf16_t* Q; __device__ void operator()(int r, int c, float v) const { Q[(size_t)r * PQ + c] = f2bf(v); } };

template <class Epi, int N, int K>
__device__ __forceinline__ void phase_gemm_simple(const Ctx& c, const bf16_t* __restrict__ A, const bf16_t* __restrict__ Bt, Epi epi) {
    const int half = c.tid >> 8, tid = c.tid & 255, lane = c.lane, wid = tid >> 6, wm = wid >> 1, wn = wid & 1;
    bf16_t* sA = (bf16_t*)(c.lds + half * 20480);
    bf16_t* sB = sA + 128 * 40;
    constexpr int nN = N / 128, NT = (NTOK / 128) * nN;
    for (int t0 = c.bid * 2; t0 < NT; t0 += c.G * 2) {
        const int t = t0 + half; const bool live = t < NT;
        const int bm = (t / nN) * 128, bn = (t % nN) * 128;
        f32x4 acc[4][4];
#pragma unroll
        for (int i = 0; i < 4; ++i)
#pragma unroll
            for (int j = 0; j < 4; ++j) acc[i][j] = (f32x4){0.f, 0.f, 0.f, 0.f};
        for (int k0 = 0; k0 < K; k0 += 32) {
            if (live) {
#pragma unroll
                for (int i = 0; i < 2; ++i) {
                    const int ch = tid + i * 256, r = ch >> 2, cc = (ch & 3) * 8;
                    *(uint4*)&sA[r * 40 + cc] = *(const uint4*)&A[(size_t)(bm + r) * K + k0 + cc];
                    *(uint4*)&sB[r * 40 + cc] = *(const uint4*)&Bt[(size_t)(bn + r) * K + k0 + cc];
                }
            }
            __syncthreads();
            bf16x8 a[4], b[4];
#pragma unroll
            for (int i = 0; i < 4; ++i) {
                a[i] = *(const bf16x8*)&sA[(wm * 64 + i * 16 + (lane & 15)) * 40 + (lane >> 4) * 8];
                b[i] = *(const bf16x8*)&sB[(wn * 64 + i * 16 + (lane & 15)) * 40 + (lane >> 4) * 8];
            }
#pragma unroll
            for (int i = 0; i < 4; ++i)
#pragma unroll
                for (int j = 0; j < 4; ++j) acc[i][j] = __builtin_amdgcn_mfma_f32_16x16x32_bf16(a[i], b[j], acc[i][j], 0, 0, 0);
            __syncthreads();
        }
        if (live) {
#pragma unroll
            for (int i = 0; i < 4; ++i)
#pragma unroll
                for (int j = 0; j < 4; ++j)
#pragma unroll
                    for (int r = 0; r < 4; ++r) epi(bm + wm * 64 + i * 16 + (lane >> 4) * 4 + r, bn + wn * 64 + j * 16 + (lane & 15), acc[i][j][r]);
        }
    }
}

__device__ __forceinline__ int t5_bucket(int rel) {
    const int n = rel < 0 ? -rel : rel;
    int v;
    if (n < 8) v = n;
    else { int k = 0; k += (n >= 12); k += (n >= 16); k += (n >= 23); k += (n >= 32); k += (n >= 46); k += (n >= 64); k += (n >= 91); v = 8 + k; }
    return (rel > 0 ? 16 : 0) + v;
}
__device__ __forceinline__ float dot64_bf16(const float* qs, const bf16_t* krow) {
    float s = 0.f;
#pragma unroll
    for (int c = 0; c < 8; ++c) {
        const uint4 w = ((const uint4*)krow)[c];
        const unsigned ww[4] = {w.x, w.y, w.z, w.w};
#pragma unroll
        for (int e = 0; e < 4; ++e) { s += qs[c * 8 + 2 * e] * __uint_as_float(ww[e] << 16); s += qs[c * 8 + 2 * e + 1] * __uint_as_float(ww[e] & 0xffff0000u); }
    }
    return s;
}
#define WAVE_LDS_SYNC() do { __builtin_amdgcn_fence(__ATOMIC_RELEASE, "wavefront"); __builtin_amdgcn_wave_barrier(); __builtin_amdgcn_fence(__ATOMIC_ACQUIRE, "wavefront"); } while (0)

__device__ __forceinline__ void phase_attn_naive(const Ctx& c, const bf16_t* __restrict__ H, const float* __restrict__ sink, const float* __restrict__ t5, const float* __restrict__ rpb, float* __restrict__ Yraw) {
    float* qsh = (float*)(c.lds + c.wid * 256);
    const int lane = c.lane;
    const int gw = c.bid * NWAVES + c.wid, NGW = c.G * NWAVES;
    for (int item = gw; item < NTOK * 16; item += NGW) {
        const int tok = item >> 4, hh = item & 15;
        const int b = tok / SEQ, tt = tok % SEQ;
        if (hh < 8) {
            const int hq = hh, kvh = hq >> 2;
            qsh[lane] = bf2f(H[(size_t)tok * PROJ + hq * HD + lane]);
            WAVE_LDS_SYNC();
            float s[5];
#pragma unroll
            for (int i = 0; i < 5; ++i) {
                const int j = lane + 64 * i, rel = j - 128, kp = tt + rel;
                const bool valid = (rel <= 128) && kp >= 0 && kp < SEQ;
                float v = NEGF;
                if (valid) {
                    const bf16_t* krow = H + (size_t)(b * SEQ + kp) * PROJ + O1 + kvh * HD;
                    v = dot64_bf16(qsh, krow) * 0.125f + t5[t5_bucket(rel) * 8 + hq];
                }
                s[i] = v;
            }
            const float sk = sink[hq];
            float m = fmaxf(fmaxf(fmaxf(s[0], s[1]), fmaxf(s[2], s[3])), s[4]);
            m = fmaxf(wave_max(m), sk);
            float p[5], sum = 0.f;
#pragma unroll
            for (int i = 0; i < 5; ++i) { p[i] = expf(s[i] - m); sum += p[i]; }
            sum = wave_sum(sum) + expf(sk - m);
            const float inv = 1.f / sum;
            float acc = 0.f;
#pragma unroll
            for (int i = 0; i < 5; ++i) {
                for (int jj = 0; jj < 64; ++jj) {
                    const float pj = __shfl(p[i], jj);
                    const int rel = jj + 64 * i - 128; const int kp = tt + rel;
                    if (rel > 128 || kp < 0 || kp >= SEQ) continue;
                    acc += pj * bf2f(H[(size_t)(b * SEQ + kp) * PROJ + O2 + kvh * HD + lane]);
                }
            }
            Yraw[(size_t)tok * D + hq * HD + lane] = acc * inv;
        } else {
            const int hb = hh - 8, r = tt >> 6, cc = tt & 63;
            int rs = r - 4; rs = rs < 0 ? 0 : (rs > 56 ? 56 : rs);
            int cs = cc - 8; cs = cs < 0 ? 0 : (cs > 48 ? 48 : cs);
            qsh[lane] = bf2f(H[(size_t)tok * PROJ + O3 + hb * HD + lane]);
            WAVE_LDS_SYNC();
            float s[2];
#pragma unroll
            for (int i = 0; i < 2; ++i) {
                const int j = lane + 64 * i, kr = rs + (j >> 4), kc = cs + (j & 15);
                const bf16_t* krow = H + (size_t)(b * SEQ + kr * 64 + kc) * PROJ + O4 + hb * HD;
                const int dr = kr - r + 7; int dc = kc - cc; dc = dc < -15 ? -15 : (dc > 15 ? 15 : dc); dc += 15;
                s[i] = dot64_bf16(qsh, krow) * 0.125f + rpb[(hb * 15 + dr) * 31 + dc];
            }
            const float m = wave_max(fmaxf(s[0], s[1]));
            float p[2]; p[0] = expf(s[0] - m); p[1] = expf(s[1] - m);
            const float inv = 1.f / wave_sum(p[0] + p[1]);
            float acc = 0.f;
#pragma unroll
            for (int i = 0; i < 2; ++i)
                for (int jj = 0; jj < 64; ++jj) {
                    const float pj = __shfl(p[i], jj);
                    const int j = jj + 64 * i, kr = rs + (j >> 4), kc = cs + (j & 15);
                    acc += pj * bf2f(H[(size_t)(b * SEQ + kr * 64 + kc) * PROJ + O5 + hb * HD + lane]);
                }
            Yraw[(size_t)tok * D + 512 + hb * HD + lane] = acc * inv;
        }
        WAVE_LDS_SYNC();
    }
}


struct AttnState { float m, l; f32x16 o0, o1; };
__device__ __forceinline__ void attn_state_init(AttnState& st) {
    st.m = -1e30f; st.l = 0.f;
#pragma unroll
    for (int r = 0; r < 16; ++r) { st.o0[r] = 0.f; st.o1[r] = 0.f; }
}
__device__ __forceinline__ void attn_stage_kv(const Ctx& c, LAS unsigned char* Ks, LAS unsigned char* VT, const bf16_t* __restrict__ H, int b, int tok0, int koff, int voff) {
#pragma unroll
    for (int i = 0; i < 6; ++i) {
        const int ch = c.tid + NTHREADS * i, row = ch >> 3, cc = ch & 7;
        int t = tok0 + row; t = t < 0 ? 0 : (t > SEQ - 1 ? SEQ - 1 : t);
        const bf16_t* src = H + (size_t)(b * SEQ + t) * PROJ;
        const u32x4 kv = *(const u32x4*)(src + koff + cc * 8);
        const u32x4 vv = *(const u32x4*)(src + voff + cc * 8);
        *(LAS u32x4*)(Ks + row * 128 + ((cc ^ (row & 7)) << 4)) = kv;
        LAS bf16_t* vt = (LAS bf16_t*)VT + (cc * 8) * 388 + row;
#pragma unroll
        for (int k = 0; k < 4; ++k) { vt[(2 * k) * 388] = (bf16_t)(vv[k] & 0xffffu); vt[(2 * k + 1) * 388] = (bf16_t)(vv[k] >> 16); }
    }
}
__device__ __forceinline__ void attn_qk(f32x16& s, const bf16x8 (&qf)[4], const LAS unsigned char* Ks, int kt, int r32, int hh) {
#pragma unroll
    for (int r = 0; r < 16; ++r) s[r] = 0.f;
#pragma unroll
    for (int ks = 0; ks < 4; ++ks) {
        const bf16x8 a = *(const LAS bf16x8*)(Ks + (32 * kt + r32) * 128 + (((2 * ks + hh) ^ (r32 & 7)) << 4));
        s = __builtin_amdgcn_mfma_f32_32x32x16_bf16(a, qf[ks], s, 0, 0, 0);
    }
}
__device__ __forceinline__ void attn_softmax_pv(AttnState& st, f32x16& s, const LAS unsigned char* VT, int kt, int r32, int hh) {
    float tmax = s[0];
#pragma unroll
    for (int r = 1; r < 16; ++r) tmax = fmaxf(tmax, s[r]);
    tmax = fmaxf(tmax, __shfl_xor(tmax, 32));
    const float mn = fmaxf(st.m, tmax), alpha = __expf(st.m - mn);
    st.m = mn;
    float psum = 0.f;
#pragma unroll
    for (int r = 0; r < 16; ++r) { s[r] = __expf(s[r] - mn); psum += s[r]; }
    st.l = st.l * alpha + psum;
#pragma unroll
    for (int r = 0; r < 16; ++r) { st.o0[r] *= alpha; st.o1[r] *= alpha; }
    bf16x8 pb[2];
#pragma unroll
    for (int s2 = 0; s2 < 2; ++s2)
#pragma unroll
        for (int j = 0; j < 8; ++j) pb[s2][j] = (short)f2bf(s[8 * s2 + j]);
#pragma unroll
    for (int s2 = 0; s2 < 2; ++s2) {
        const LAS unsigned char* vp0 = VT + (r32 * 388 + 32 * kt + 16 * s2 + 4 * hh) * 2;
        const LAS unsigned char* vp1 = vp0 + 32 * 388 * 2;
        const u32x2 a0 = *(const LAS u32x2*)vp0, a1 = *(const LAS u32x2*)(vp0 + 16);
        const u32x2 b0 = *(const LAS u32x2*)vp1, b1 = *(const LAS u32x2*)(vp1 + 16);
        const u32x4 fa = {a0[0], a0[1], a1[0], a1[1]}, fb = {b0[0], b0[1], b1[0], b1[1]};
        st.o0 = __builtin_amdgcn_mfma_f32_32x32x16_bf16(__builtin_bit_cast(bf16x8, fa), pb[s2], st.o0, 0, 0, 0);
        st.o1 = __builtin_amdgcn_mfma_f32_32x32x16_bf16(__builtin_bit_cast(bf16x8, fb), pb[s2], st.o1, 0, 0, 0);
    }
}
__device__ __forceinline__ void attn_store(const AttnState& st, float scale, float* __restrict__ yrow  , int hh) {
#pragma unroll
    for (int g4 = 0; g4 < 4; ++g4) {
        f32x4 a, b;
#pragma unroll
        for (int e = 0; e < 4; ++e) { a[e] = st.o0[4 * g4 + e] * scale; b[e] = st.o1[4 * g4 + e] * scale; }
        *(f32x4*)(yrow + 8 * g4 + 4 * hh) = a;
        *(f32x4*)(yrow + 32 + 8 * g4 + 4 * hh) = b;
    }
}
__device__ __forceinline__ void phase_attn(const Ctx& c, const bf16_t* __restrict__ H, const float* __restrict__ sink, const float* __restrict__ t5, const float* __restrict__ rpb, float* __restrict__ Yraw) {
    LAS unsigned char* Ks = (LAS unsigned char*)c.lds;
    LAS unsigned char* VT = Ks + 49152;
    LAS float* TB = (LAS float*)(Ks + 98816);
    const int lane = c.lane, r32 = lane & 31, hh = lane >> 5, w = c.wid;
    constexpr int NWIN = BATCH * 2 * (SEQ / 128), NNA = BATCH * 8 * 16;
    for (int u = c.bid; u < NWIN + NNA; u += c.G) {
        __syncthreads();
        if (u < NWIN) {
            const int b = u / (2 * (SEQ / 128)), kvh = (u / (SEQ / 128)) & 1, n = u % (SEQ / 128);
            attn_stage_kv(c, Ks, VT, H, b, 128 * (n - 1), O1 + kvh * HD, O2 + kvh * HD);
            for (int i = c.tid; i < 511 * 4; i += NTHREADS) {
                const int rel = (i >> 2) - 255, g = i & 3;
                TB[i] = (rel >= -128 && rel <= 128) ? t5[t5_bucket(rel) * 8 + kvh * 4 + g] : -INFINITY;
            }
            __syncthreads();
            const int g = w >> 1, hq = kvh * 4 + g;
            const float sk = sink[hq];
#pragma unroll 1
            for (int qi = 0; qi < 2; ++qi) {
                const int qt = 2 * (w & 1) + qi, i0 = 32 * qt;
                const int tok = b * SEQ + 128 * n + i0 + r32;
                bf16x8 qf[4];
#pragma unroll
                for (int ks = 0; ks < 4; ++ks) qf[ks] = *(const bf16x8*)(H + (size_t)tok * PROJ + hq * HD + 16 * ks + 8 * hh);
                AttnState st; attn_state_init(st);
                int kt0 = qt, kt1 = qt + 8;
                if (n == 0 && kt0 < 4) kt0 = 4;
                if (n == SEQ / 128 - 1 && kt1 > 7) kt1 = 7;
#pragma unroll 1
                for (int kt = kt0; kt <= kt1; ++kt) {
                    f32x16 s; attn_qk(s, qf, Ks, kt, r32, hh);
                    const LAS float* tb = TB + (32 * kt + 4 * hh - (i0 + r32) + 127) * 4 + g;
#pragma unroll
                    for (int r = 0; r < 16; ++r) s[r] = s[r] * 0.125f + tb[((r & 3) + 8 * (r >> 2)) * 4];
                    attn_softmax_pv(st, s, VT, kt, r32, hh);
                }
                const float l = st.l + __shfl_xor(st.l, 32);
                const float mf = fmaxf(st.m, sk), ef = __expf(st.m - mf);
                const float scale = ef / (l * ef + __expf(sk - mf));
                attn_store(st, scale, Yraw + (size_t)tok * D + hq * HD, hh);
            }
        } else {
            const int v = u - NWIN, b = v / (8 * 16), hb = (v / 16) & 7, R0 = 4 * (v & 15);
            int kr0 = R0 - 4; kr0 = kr0 < 0 ? 0 : (kr0 > 56 ? 56 : kr0);
            const int r = R0 + (w >> 1), cq = 32 * (w & 1) + r32;
            int rs = r - 4; rs = rs < 0 ? 0 : (rs > 56 ? 56 : rs);
            int cs = cq - 8; cs = cs < 0 ? 0 : (cs > 48 ? 48 : cs);
            const int tok = b * SEQ + r * 64 + cq;
            bf16x8 qf[4];
#pragma unroll
            for (int ks = 0; ks < 4; ++ks) qf[ks] = *(const bf16x8*)(H + (size_t)tok * PROJ + O3 + hb * HD + 16 * ks + 8 * hh);
            AttnState st; attn_state_init(st);
#pragma unroll 1
            for (int pass = 0; pass < 2; ++pass) {
                if (pass) __syncthreads();
                attn_stage_kv(c, Ks, VT, H, b, (kr0 + 6 * pass) * 64, O4 + hb * HD, O5 + hb * HD);
                if (pass == 0) for (int i = c.tid; i < 15 * 31; i += NTHREADS) TB[i] = rpb[hb * 15 * 31 + i];
                __syncthreads();
#pragma unroll 1
                for (int kt = 0; kt < 12; ++kt) {
                    const int kr = kr0 + 6 * pass + (kt >> 1);
                    if (kr < rs || kr >= rs + 8) continue;
                    f32x16 s; attn_qk(s, qf, Ks, kt, r32, hh);
                    const LAS float* tb = TB + (kr - r + 7) * 31 + 15;
                    const int kc0 = 32 * (kt & 1) + 4 * hh;
#pragma unroll
                    for (int rr = 0; rr < 16; ++rr) {
                        const int kc = kc0 + (rr & 3) + 8 * (rr >> 2);
                        int dc = kc - cq; dc = dc < -15 ? -15 : (dc > 15 ? 15 : dc);
                        const bool ok = (kc >= cs) && (kc < cs + 16);
                        s[rr] = ok ? s[rr] * 0.125f + tb[dc] : -INFINITY;
                    }
                    attn_softmax_pv(st, s, VT, kt, r32, hh);
                }
            }
            const float l = st.l + __shfl_xor(st.l, 32);
            attn_store(st, 1.f / l, Yraw + (size_t)tok * D + 512 + hb * HD, hh);
        }
    }
}

__device__ __forceinline__ void phase_rmsnorm(const Ctx& c, const float* __restrict__ Yraw, const float* __restrict__ ga, const float* __restrict__ gb, bf16_t* __restrict__ Y) {
    const int lane = c.lane, gw = c.bid * NWAVES + c.wid, NGW = c.G * NWAVES;
    for (int tok = gw; tok < NTOK; tok += NGW) {
        const float* row = Yraw + (size_t)tok * D;
        float a[8], bb[8], sa = 0.f, sb = 0.f;
#pragma unroll
        for (int i = 0; i < 8; ++i) { a[i] = row[lane + 64 * i]; bb[i] = row[512 + lane + 64 * i]; sa += a[i] * a[i]; sb += bb[i] * bb[i]; }
        const float ra = rsqrtf(wave_sum(sa) * (1.f / 512.f) + LN_EPS), rb = rsqrtf(wave_sum(sb) * (1.f / 512.f) + LN_EPS);
#pragma unroll
        for (int i = 0; i < 8; ++i) {
            Y[(size_t)tok * D + lane + 64 * i] = f2bf(a[i] * ra * ga[lane + 64 * i]);
            Y[(size_t)tok * D + 512 + lane + 64 * i] = f2bf(bb[i] * rb * gb[lane + 64 * i]);
        }
    }
}

__device__ __forceinline__ void ln_store_row(f32x4 (&v)[4], int lane, const float* __restrict__ g, const float* __restrict__ bta, float* __restrict__ orow, bf16_t* __restrict__ obrow, unsigned char* __restrict__ o8row) {
    float s = 0.f;
#pragma unroll
    for (int j = 0; j < 4; ++j) s += (v[j][0] + v[j][1]) + (v[j][2] + v[j][3]);
    const float mean = wave_sum(s) * (1.f / D); float s2 = 0.f;
#pragma unroll
    for (int j = 0; j < 4; ++j) { v[j] = v[j] - mean; s2 += (v[j][0] * v[j][0] + v[j][1] * v[j][1]) + (v[j][2] * v[j][2] + v[j][3] * v[j][3]); }
    const float rstd = rsqrtf(wave_sum(s2) * (1.f / D) + LN_EPS);
#pragma unroll
    for (int j = 0; j < 4; ++j) {
        const f32x4 gg = ((const f32x4*)g)[lane + 64 * j], be = ((const f32x4*)bta)[lane + 64 * j];
        const f32x4 o = v[j] * rstd * gg + be;
        ((f32x4*)orow)[lane + 64 * j] = o;
        uint2 ob; ob.x = f2bf(o[0]) | ((unsigned)f2bf(o[1]) << 16); ob.y = f2bf(o[2]) | ((unsigned)f2bf(o[3]) << 16);
        ((uint2*)obrow)[lane + 64 * j] = ob;
        if (o8row) ((unsigned*)o8row)[lane + 64 * j] = pack4_fp8(o, XS);
    }
}
__device__ __forceinline__ void phase_ln(const Ctx& c, const float* __restrict__ Z, const float* __restrict__ g, const float* __restrict__ bta, float* __restrict__ out, bf16_t* __restrict__ outb, unsigned char* __restrict__ out8) {
    const int lane = c.lane, gw = c.bid * NWAVES + c.wid, NGW = c.G * NWAVES;
    for (int tok = gw; tok < NTOK; tok += NGW) {
        const f32x4* zr = (const f32x4*)(Z + (size_t)tok * D);
        f32x4 v[4];
#pragma unroll
        for (int j = 0; j < 4; ++j) v[j] = zr[lane + 64 * j];
        ln_store_row(v, lane, g, bta, out + (size_t)tok * D, outb + (size_t)tok * D, out8 + (size_t)tok * D);
    }
}


#ifndef HD
#define HD __host__ __device__ __forceinline__
#endif
HD unsigned tk_f2u(float f) { return __builtin_bit_cast(unsigned, f); }
HD float tk_u2f(unsigned u) { return __builtin_bit_cast(float, u); }
template <int N> HD void bitonic_sort_desc(float (&v)[N]) {
#pragma unroll
    for (int k = 2; k <= N; k <<= 1)
#pragma unroll
        for (int j = k >> 1; j > 0; j >>= 1)
#pragma unroll
            for (int i = 0; i < N; ++i) {
                const int l = i ^ j;
                if (l > i) {
                    const bool desc = ((i & k) == 0);
                    const float a = v[i], b = v[l];
                    const float mx = __builtin_fmaxf(a, b), mn = __builtin_fminf(a, b);
                    v[i] = desc ? mx : mn; v[l] = desc ? mn : mx;
                }
            }
}
template <int N> HD void bitonic_merge_desc(float (&v)[N]) {
#pragma unroll
    for (int j = N >> 1; j > 0; j >>= 1)
#pragma unroll
        for (int i = 0; i < N; ++i) {
            const int l = i ^ j;
            if (l > i) { const float a = v[i], b = v[l]; v[i] = __builtin_fmaxf(a, b); v[l] = __builtin_fminf(a, b); }
        }
}
HD void top16_merge(float (&a)[16], const float (&b)[16]) {
#pragma unroll
    for (int i = 0; i < 16; ++i) a[i] = __builtin_fmaxf(a[i], b[15 - i]);
    bitonic_merge_desc<16>(a);
}
HD void tk_local_top16(const float (&sc)[4][16], int hh, float (&out)[16]) {
    float g[4][16];
#pragma unroll
    for (int kt = 0; kt < 4; ++kt) {
#pragma unroll
        for (int reg = 0; reg < 16; ++reg) { const int key = 32 * kt + (reg & 3) + 8 * (reg >> 2) + 4 * hh; g[kt][reg] = tk_u2f((tk_f2u(sc[kt][reg]) & ~127u) | (unsigned)(127 - key)); }
        bitonic_sort_desc<16>(g[kt]);
    }
    top16_merge(g[0], g[1]); top16_merge(g[2], g[3]); top16_merge(g[0], g[2]);
#pragma unroll
    for (int i = 0; i < 16; ++i) out[i] = g[0][i];
}
constexpr int CA0[25] = {0,0,0,0,0,0,0,0,0,0,0,0,0,0,0,0,1,1,1,1,1,1,1,1,2};
constexpr int CB0[25] = {0,1,2,3,4,5,6,7,8,9,10,11,12,13,14,15,0,1,2,3,4,5,6,7,0};
constexpr int CA1[25] = {2,2,2,2,3,3,3,3,4,4,4,5,5,6,6,7,7,8,9,10,11,12,13,14,15};
constexpr int CB1[25] = {1,2,3,4,0,1,2,3,0,1,2,0,1,0,1,0,1,0,0,0,0,0,0,0,0};
HD void tk_candidates(const float (&T0)[16], const float (&T1)[16], int hh, float (&cv)[32]) {
    float t0[16], t1[16];
#pragma unroll
    for (int i = 0; i < 16; ++i) { t0[i] = tk_u2f(tk_f2u(T0[i]) & ~127u); t1[i] = tk_u2f(tk_f2u(T1[i]) & ~127u); }
#pragma unroll
    for (int j = 0; j < 25; ++j) {
        const float s0 = t0[CA0[j]] + t1[CB0[j]], s1 = t0[CA1[j]] + t1[CB1[j]];
        const unsigned c0 = 255u - (unsigned)(16 * CA0[j] + CB0[j]), c1 = 255u - (unsigned)(16 * CA1[j] + CB1[j]);
        cv[j] = tk_u2f((tk_f2u(hh ? s1 : s0) & ~255u) | (hh ? c1 : c0));
    }
#pragma unroll
    for (int j = 25; j < 32; ++j) cv[j] = -__builtin_inff();
    bitonic_sort_desc<32>(cv);
}

__device__ __forceinline__ void wave_argmax(float& v, int& i) {
#pragma unroll
    for (int o = 32; o >= 1; o >>= 1) {
        const float ov = __shfl_xor(v, o); const int oi = __shfl_xor(i, o);
        if (ov > v || (ov == v && oi < i)) { v = ov; i = oi; }
    }
}
__device__ __forceinline__ void phase_topk_naive(const Ctx& c, const float* __restrict__ Qp, const float* __restrict__ keys, int* __restrict__ eidx, float* __restrict__ gate) {
    float* qsh = (float*)(c.lds + c.wid * 1024);
    float* tv = qsh + 128;
    int* ti = (int*)(tv + 32);
    const int lane = c.lane, gw = c.bid * NWAVES + c.wid, NGW = c.G * NWAVES;
    for (int item = gw; item < NTOK * 8; item += NGW) {
        const int tok = item >> 3, h = item & 7;
        for (int p = 0; p < 2; ++p) {
            const float* q = Qp + (size_t)tok * PQ + h * 256 + p * 128;
            qsh[lane] = q[lane]; qsh[lane + 64] = q[lane + 64];
            WAVE_LDS_SYNC();
            float s[2];
#pragma unroll
            for (int i = 0; i < 2; ++i) {
                const f32x4* kr = (const f32x4*)(keys + ((size_t)(h * 2 + p) * NKEYS + lane + 64 * i) * 128);
                float a = 0.f;
                for (int cc = 0; cc < 32; ++cc) { const f32x4 kk = kr[cc]; a += qsh[4 * cc] * kk[0]; a += qsh[4 * cc + 1] * kk[1]; a += qsh[4 * cc + 2] * kk[2]; a += qsh[4 * cc + 3] * kk[3]; }
                s[i] = a;
            }
            for (int r = 0; r < 16; ++r) {
                float bv; int bi;
                if (s[0] >= s[1]) { bv = s[0]; bi = lane; } else { bv = s[1]; bi = lane + 64; }
                wave_argmax(bv, bi);
                if (bi == lane) s[0] = -INFINITY;
                if (bi == lane + 64) s[1] = -INFINITY;
                if (lane == 0) { tv[p * 16 + r] = bv; ti[p * 16 + r] = bi; }
            }
            WAVE_LDS_SYNC();
        }
        float cv[4];
#pragma unroll
        for (int j = 0; j < 4; ++j) { const int f = lane * 4 + j; cv[j] = tv[f >> 4] + tv[16 + (f & 15)]; }
        float fs = 0.f; int fp = 0;
        for (int r = 0; r < 16; ++r) {
            float bv = cv[0]; int bi = lane * 4;
#pragma unroll
            for (int j = 1; j < 4; ++j) if (cv[j] > bv) { bv = cv[j]; bi = lane * 4 + j; }
            wave_argmax(bv, bi);
#pragma unroll
            for (int j = 0; j < 4; ++j) if (bi == lane * 4 + j) cv[j] = -INFINITY;
            if (lane == r) { fs = bv; fp = bi; }
        }
        const float m = wave_max(lane < 16 ? fs : -INFINITY);
        const float e = lane < 16 ? expf(fs - m) : 0.f;
        const float sum = wave_sum(e);
        if (lane < 16) {
            const int id = ti[fp >> 4] * NKEYS + ti[16 + (fp & 15)];
            eidx[(size_t)item * 16 + lane] = id;
            gate[(size_t)item * 16 + lane] = e / sum;
        }
        WAVE_LDS_SYNC();
    }
}

__device__ __forceinline__ void phase_gather_naive(const Ctx& c, const float* __restrict__ x1, const int* __restrict__ eidx, const float* __restrict__ gate,
                                                   const float* __restrict__ U, const float* __restrict__ V, const float* __restrict__ g, const float* __restrict__ bta,
                                                   float* __restrict__ out, bf16_t* __restrict__ outb) {
    const int lane = c.lane, gw = c.bid * NWAVES + c.wid, NGW = c.G * NWAVES;
    for (int tok = gw; tok < NTOK; tok += NGW) {
        const f32x4* xr = (const f32x4*)(x1 + (size_t)tok * D);
        f32x4 xv[4], acc[4];
#pragma unroll
        for (int j = 0; j < 4; ++j) { xv[j] = xr[lane + 64 * j]; acc[j] = (f32x4){0.f, 0.f, 0.f, 0.f}; }
        for (int k = 0; k < 128; ++k) {
            const int e = eidx[(size_t)tok * 128 + k];
            const float gk = gate[(size_t)tok * 128 + k];
            const f32x4* ur = (const f32x4*)(U + (size_t)e * D);
            const f32x4* vr = (const f32x4*)(V + (size_t)e * D);
            float d = 0.f;
#pragma unroll
            for (int j = 0; j < 4; ++j) { const f32x4 uu = ur[lane + 64 * j]; d += (xv[j][0] * uu[0] + xv[j][1] * uu[1]) + (xv[j][2] * uu[2] + xv[j][3] * uu[3]); }
            d = wave_sum(d);
            const float a = 0.5f * d * (1.f + erff(d * 0.70710678118654752f)) * gk;
#pragma unroll
            for (int j = 0; j < 4; ++j) acc[j] += a * vr[lane + 64 * j];
        }
#pragma unroll
        for (int j = 0; j < 4; ++j) acc[j] = ALPHA * xv[j] + acc[j];
        ln_store_row(acc, lane, g, bta, out + (size_t)tok * D, outb + (size_t)tok * D, nullptr);
    }
}


__device__ __forceinline__ void phase_topk(const Ctx& c, const bf16_t* __restrict__ Qb, const bf16_t* __restrict__ Kb, int* __restrict__ eidx, float* __restrict__ gate) {
    LAS unsigned char* kl = (LAS unsigned char*)c.lds;
    LAS int* scr = (LAS int*)(c.lds + 65536) + c.wid * 1024;
    const int lane = c.lane, r32 = lane & 31, hh = lane >> 5;
    for (int task = c.bid; task < 8 * (NTOK / 256); task += c.G) {
        const int h = task / (NTOK / 256), tb = task % (NTOK / 256);
        __syncthreads();
#pragma unroll
        for (int i = 0; i < 8; ++i) {
            const int ch = c.tid + NTHREADS * i, row = ch >> 4, cc = ch & 15;
            const u32x4 v = *(const u32x4*)(Kb + ((size_t)(h * 256 + row) * 128 + cc * 8));
            *(LAS u32x4*)(kl + row * 256 + ((cc ^ (row & 15)) << 4)) = v;
        }
        __syncthreads();
        const int tok = tb * 256 + c.wid * 32 + r32;
        float T0[16], T1[16];
#pragma unroll
        for (int p = 0; p < 2; ++p) {
            bf16x8 bq[8];
            const bf16_t* qrow = Qb + (size_t)tok * PQ + h * 256 + p * 128 + hh * 8;
#pragma unroll
            for (int ks = 0; ks < 8; ++ks) bq[ks] = *(const bf16x8*)(qrow + 16 * ks);
            f32x16 acc[4];
#pragma unroll
            for (int kt = 0; kt < 4; ++kt)
#pragma unroll
                for (int r = 0; r < 16; ++r) acc[kt][r] = 0.f;
#pragma unroll
            for (int ks = 0; ks < 8; ++ks) {
                const int swz = ((2 * ks + hh) ^ (r32 & 15)) << 4;
#pragma unroll
                for (int kt = 0; kt < 4; ++kt) {
                    const bf16x8 a = *(const LAS bf16x8*)(kl + (p * 128 + 32 * kt + r32) * 256 + swz);
                    acc[kt] = __builtin_amdgcn_mfma_f32_32x32x16_bf16(a, bq[ks], acc[kt], 0, 0, 0);
                }
            }
            float sc[4][16], loc[16], pr[16];
#pragma unroll
            for (int kt = 0; kt < 4; ++kt)
#pragma unroll
                for (int r = 0; r < 16; ++r) sc[kt][r] = acc[kt][r];
            tk_local_top16(sc, hh, loc);
#pragma unroll
            for (int i = 0; i < 16; ++i) pr[i] = __shfl_xor(loc[i], 32);
            top16_merge(loc, pr);
            if (hh == p) {
#pragma unroll
                for (int i = 0; i < 16; ++i) scr[r32 * 32 + p * 16 + i] = 127 - (int)(tk_f2u(loc[i]) & 127u);
            }
#pragma unroll
            for (int i = 0; i < 16; ++i) { if (p == 0) T0[i] = loc[i]; else T1[i] = loc[i]; }
        }
        float cv[32], F[16], pr[16];
        tk_candidates(T0, T1, hh, cv);
#pragma unroll
        for (int i = 0; i < 16; ++i) { F[i] = cv[i]; pr[i] = __shfl_xor(cv[i], 32); }
        top16_merge(F, pr);
        WAVE_LDS_SYNC();
        const float m = tk_u2f(tk_f2u(F[0]) & ~255u);
        float e[16], sum = 0.f;
#pragma unroll
        for (int i = 0; i < 16; ++i) { e[i] = __expf(tk_u2f(tk_f2u(F[i]) & ~255u) - m); sum += e[i]; }
        const float inv = 1.f / sum;
        int ids[8]; float gs[8];
#pragma unroll
        for (int r = 0; r < 8; ++r) {
            const float fv = hh ? F[8 + r] : F[r];
            const unsigned pos = 255u - (tk_f2u(fv) & 255u);
            ids[r] = scr[r32 * 32 + (int)(pos >> 4)] * NKEYS + scr[r32 * 32 + 16 + (int)(pos & 15u)];
            gs[r] = (hh ? e[8 + r] : e[r]) * inv;
        }
        int* ep = eidx + ((size_t)tok * 8 + h) * 16 + 8 * hh; float* gp = gate + ((size_t)tok * 8 + h) * 16 + 8 * hh;
        *(int4*)ep = make_int4(ids[0], ids[1], ids[2], ids[3]); *(int4*)(ep + 4) = make_int4(ids[4], ids[5], ids[6], ids[7]);
        *(f32x4*)gp = (f32x4){gs[0], gs[1], gs[2], gs[3]}; *(f32x4*)(gp + 4) = (f32x4){gs[4], gs[5], gs[6], gs[7]};
        WAVE_LDS_SYNC();
    }
}

__device__ __forceinline__ float gelu_erf(float v) {
    const float av = fabsf(v), t = __builtin_amdgcn_rcpf(av * 0.2316418882f + 1.0f);
    float qq = t * 0.5307027145f + (-0.7265760135f); qq = qq * t + 0.7107068705f; qq = qq * t + (-0.142248368f); qq = qq * t + 0.127414796f; qq = qq * t;
    const float e = __builtin_amdgcn_exp2f((v * v) * (-0.72134752044f));
    const float m = v * (qq * e);
    return v < 0.f ? m : v - m;
}
#define SB() __builtin_amdgcn_sched_barrier(0)
__device__ __forceinline__ void axpy_row(f32x2 (&acc)[8], const u32x4 w, const float a) {
    const f32x2 aa = {a, a};
#pragma unroll
    for (int k = 0; k < 4; ++k) {
        const f32x2 lo = __builtin_amdgcn_cvt_pk_f32_fp8(w[k], false), hi = __builtin_amdgcn_cvt_pk_f32_fp8(w[k], true);
        acc[2 * k] = __builtin_elementwise_fma(lo, aa, acc[2 * k]); acc[2 * k + 1] = __builtin_elementwise_fma(hi, aa, acc[2 * k + 1]);
    }
}
__device__ __forceinline__ void phase_gather(const Ctx& c, const float* __restrict__ x1, const unsigned char* __restrict__ X8, const int* __restrict__ eidx, const float* __restrict__ gate,
                                             const unsigned char* __restrict__ U8, const unsigned char* __restrict__ V8, const float* __restrict__ g, const float* __restrict__ bta,
                                             float* __restrict__ out, bf16_t* __restrict__ outb) {
    const int gw = c.bid * NWAVES + c.wid, NGW = c.G * NWAVES;
    LAS unsigned char* xl = (LAS unsigned char*)c.lds + c.wid * 2048;
    const int lane = c.lane, q = lane >> 4, l15 = lane & 15;
    const unsigned lo16 = (unsigned)lane * 16u;
    int tok = gw;
    if (tok >= NTOK) return;
    int ev0 = eidx[(size_t)tok * 128 + lane], ev1 = eidx[(size_t)tok * 128 + 64 + lane];
    int en0, en1;
    { const int t1 = (tok + NGW < NTOK) ? tok + NGW : tok; en0 = eidx[(size_t)t1 * 128 + lane]; en1 = eidx[(size_t)t1 * 128 + 64 + lane]; }
    *(LAS u32x4*)(xl + lane * 16) = *(const u32x4*)(X8 + (size_t)tok * D + lo16);
    u32x4 bU0[8], bU1[8], bV0[8], bV1[8];
    {
        const unsigned char* ub = U8 + ((unsigned)__shfl(ev0, l15) * (unsigned)D + (unsigned)q * 16u);
#pragma unroll
        for (int t = 0; t < 8; ++t) bU0[t] = *(const u32x4*)(ub + 64 * t);
        SB();
#pragma unroll
        for (int t = 0; t < 8; ++t) bU1[t] = *(const u32x4*)(ub + 512 + 64 * t);
        SB();
#pragma unroll
        for (int i = 0; i < 8; ++i) { const int e = __builtin_amdgcn_readlane(ev0, i); bV0[i] = *(const u32x4*)(V8 + (size_t)e * D + lo16); }
        SB();
    }
    int slot = 0;
#pragma unroll 1
    for (; tok < NTOK; tok += NGW, slot ^= 1) {
        const int tokn = (tok + NGW < NTOK) ? tok + NGW : tok, tok2 = (tok + 2 * NGW < NTOK) ? tok + 2 * NGW : tok;
        const int nn0 = eidx[(size_t)tok2 * 128 + lane], nn1 = eidx[(size_t)tok2 * 128 + 64 + lane];
        const u32x4 xn = *(const u32x4*)(X8 + (size_t)tokn * D + lo16);
        const LAS unsigned char* xc = xl + slot * 1024 + q * 16;
        f32x2 acc[8];
#pragma unroll
        for (int k = 0; k < 8; ++k) acc[k] = (f32x2){0.f, 0.f};
        SB();
#pragma unroll 1
        for (int h = 0; h < 8; ++h) {
            const int evh = (h < 4) ? ev0 : ev1, lb = (h & 3) * 16;
            const bool last = (h == 7);
            const int evn = last ? en0 : ((h + 1 < 4) ? ev0 : ev1), lbn = last ? 0 : ((h + 1) & 3) * 16;
            const f32x4 gq = *(const f32x4*)(gate + (size_t)tok * 128 + h * 16 + 4 * q);
            SB();
#pragma unroll
            for (int i = 0; i < 8; ++i) { const int e = __builtin_amdgcn_readlane(evh, lb + 8 + i); bV1[i] = *(const u32x4*)(V8 + (size_t)e * D + lo16); }
            SB();
            f32x4 h4 = {0.f, 0.f, 0.f, 0.f};
#pragma unroll
            for (int t = 0; t < 8; ++t) {
                const u32x4 xb = *(const LAS u32x4*)(xc + 64 * t);
                const long alo = (long)(((unsigned long long)bU0[t][1] << 32) | bU0[t][0]), ahi = (long)(((unsigned long long)bU0[t][3] << 32) | bU0[t][2]);
                const long xlo = (long)(((unsigned long long)xb[1] << 32) | xb[0]), xhi = (long)(((unsigned long long)xb[3] << 32) | xb[2]);
                h4 = __builtin_amdgcn_mfma_f32_16x16x32_fp8_fp8(alo, xlo, h4, 0, 0, 0);
                h4 = __builtin_amdgcn_mfma_f32_16x16x32_fp8_fp8(ahi, xhi, h4, 0, 0, 0);
                if ((t & 3) == 3) SB();
            }
            const unsigned char* ubn = U8 + ((unsigned)__shfl(evn, lbn + l15) * (unsigned)D + (unsigned)q * 16u);
#pragma unroll
            for (int t = 0; t < 8; ++t) bU0[t] = *(const u32x4*)(ubn + 64 * t);
            SB();
#pragma unroll
            for (int t = 0; t < 8; ++t) {
                const u32x4 xb = *(const LAS u32x4*)(xc + 512 + 64 * t);
                const long alo = (long)(((unsigned long long)bU1[t][1] << 32) | bU1[t][0]), ahi = (long)(((unsigned long long)bU1[t][3] << 32) | bU1[t][2]);
                const long xlo = (long)(((unsigned long long)xb[1] << 32) | xb[0]), xhi = (long)(((unsigned long long)xb[3] << 32) | xb[2]);
                h4 = __builtin_amdgcn_mfma_f32_16x16x32_fp8_fp8(alo, xlo, h4, 0, 0, 0);
                h4 = __builtin_amdgcn_mfma_f32_16x16x32_fp8_fp8(ahi, xhi, h4, 0, 0, 0);
                if ((t & 3) == 3) SB();
            }
            int a4[4];
#pragma unroll
            for (int r = 0; r < 4; ++r) a4[r] = __builtin_bit_cast(int, gelu_erf(h4[r] * (1.f / (XS * US))) * gq[r] * (1.f / VS));
            SB();
#pragma unroll
            for (int t = 0; t < 8; ++t) bU1[t] = *(const u32x4*)(ubn + 512 + 64 * t);
            SB();
#pragma unroll
            for (int i = 0; i < 8; ++i) { axpy_row(acc, bV0[i], __builtin_bit_cast(float, __builtin_amdgcn_readlane(a4[i & 3], 16 * (i >> 2)))); if (i & 1) SB(); }
#pragma unroll
            for (int i = 0; i < 8; ++i) { const int e = __builtin_amdgcn_readlane(evn, lbn + i); bV0[i] = *(const u32x4*)(V8 + (size_t)e * D + lo16); }
            SB();
#pragma unroll
            for (int i = 0; i < 8; ++i) { axpy_row(acc, bV1[i], __builtin_bit_cast(float, __builtin_amdgcn_readlane(a4[i & 3], 32 + 16 * (i >> 2)))); if (i & 1) SB(); }
        }
        *(LAS u32x4*)(xl + (slot ^ 1) * 1024 + lane * 16) = xn;
        const f32x4* xr = (const f32x4*)(x1 + (size_t)tok * D) + 4 * lane;
        float sm = 0.f;
#pragma unroll
        for (int w = 0; w < 4; ++w) { const f32x4 xv = xr[w];
            acc[2 * w][0] += ALPHA * xv[0]; acc[2 * w][1] += ALPHA * xv[1]; acc[2 * w + 1][0] += ALPHA * xv[2]; acc[2 * w + 1][1] += ALPHA * xv[3];
            sm += (acc[2 * w][0] + acc[2 * w][1]) + (acc[2 * w + 1][0] + acc[2 * w + 1][1]); }
        const float mean = wave_sum(sm) * (1.f / D); float s2 = 0.f;
#pragma unroll
        for (int k = 0; k < 8; ++k) { acc[k] = acc[k] - mean; s2 += acc[k][0] * acc[k][0] + acc[k][1] * acc[k][1]; }
        const float rstd = rsqrtf(wave_sum(s2) * (1.f / D) + LN_EPS);
#pragma unroll
        for (int w = 0; w < 4; ++w) {
            const f32x4 gg = ((const f32x4*)g)[4 * lane + w], be = ((const f32x4*)bta)[4 * lane + w];
            f32x4 o;
            o[0] = acc[2 * w][0] * rstd * gg[0] + be[0]; o[1] = acc[2 * w][1] * rstd * gg[1] + be[1];
            o[2] = acc[2 * w + 1][0] * rstd * gg[2] + be[2]; o[3] = acc[2 * w + 1][1] * rstd * gg[3] + be[3];
            ((f32x4*)(out + (size_t)tok * D))[4 * lane + w] = o;
            uint2 ob; ob.x = f2bf(o[0]) | ((unsigned)f2bf(o[1]) << 16); ob.y = f2bf(o[2]) | ((unsigned)f2bf(o[3]) << 16);
            ((uint2*)(outb + (size_t)tok * D))[4 * lane + w] = ob;
        }
        ev0 = en0; ev1 = en1; en0 = nn0; en1 = nn1;
        SB();
    }
}

constexpr size_t MiB = 1u << 20;
constexpr size_t WS_WIN = 0;
constexpr size_t WS_WO = 20 * MiB;
constexpr size_t WS_WQ = 28 * MiB;
constexpr size_t WS_XB = 48 * MiB;
constexpr size_t WS_XA = 112 * MiB;
constexpr size_t WS_X1 = 240 * MiB;
constexpr size_t WS_H = 368 * MiB;
constexpr size_t WS_Y = 512 * MiB;
constexpr size_t WS_Z = 576 * MiB;
constexpr size_t WS_QP = 368 * MiB;
constexpr size_t WS_KB = 44 * MiB;
constexpr size_t WS_EI = 704 * MiB;
constexpr size_t WS_GT = 720 * MiB;
constexpr size_t WS_U8 = 736 * MiB;
constexpr size_t WS_V8 = 800 * MiB;
constexpr size_t WS_X8 = 864 * MiB;
constexpr size_t WS_END = 896 * MiB;

struct Params { const float* in[16]; float* out; unsigned char* ws; };

__global__ void __launch_bounds__(NTHREADS, 2) mega_fwd(Params P) {
    extern __shared__ __attribute__((aligned(16))) unsigned char lds[];
    cg::grid_group grid = cg::this_grid();
    const float* x = P.in[0]; const float* w_in = P.in[1]; const float* w_o = P.in[2]; const float* sink = P.in[3]; const float* rpb = P.in[4]; const float* t5 = P.in[5];
    const float* ga = P.in[6]; const float* gb = P.in[7]; const float* l1g = P.in[8]; const float* l1b = P.in[9]; const float* l2g = P.in[10]; const float* l2b = P.in[11];
    const float* wq = P.in[12]; const float* keys = P.in[13]; const float* pu = P.in[14]; const float* pv = P.in[15];
    unsigned char* ws = P.ws;
    bf16_t* WinT = (bf16_t*)(ws + WS_WIN); bf16_t* WoT = (bf16_t*)(ws + WS_WO); bf16_t* WqT = (bf16_t*)(ws + WS_WQ);
    bf16_t* Xb = (bf16_t*)(ws + WS_XB); float* XA = (float*)(ws + WS_XA); float* X1 = (float*)(ws + WS_X1);
    bf16_t* H = (bf16_t*)(ws + WS_H); bf16_t* Y = (bf16_t*)(ws + WS_Y); float* Z = (float*)(ws + WS_Z); bf16_t* Qb = (bf16_t*)(ws + WS_QP); bf16_t* Kb = (bf16_t*)(ws + WS_KB);
    int* EI = (int*)(ws + WS_EI); float* GT = (float*)(ws + WS_GT);
    unsigned char* U8 = ws + WS_U8; unsigned char* V8 = ws + WS_V8; unsigned char* X8 = ws + WS_X8;

    phase_convert(make_ctx(lds), w_in, w_o, wq, x, pu, pv, WinT, WoT, WqT, Xb, U8, V8, keys, Kb);
    grid.sync();
#pragma unroll 1
    for (int l = 0; l < DEPTH; ++l) {
        const float* xin = (l == 0) ? x : XA;
        float* xout = (l == DEPTH - 1) ? P.out : XA;
        phase_gemm<pg8::EpiBf16<0>, true>(lds, Xb, WinT + (size_t)l * PROJ * D, PROJ, pg8::EpiBf16<0>{H, PROJ, nullptr, 0, 0, 1.f});
        grid.sync();
        phase_attn(make_ctx(lds), H, sink + l * 8, t5, rpb + (size_t)l * 8 * 15 * 31, Z);
        grid.sync();
        phase_rmsnorm(make_ctx(lds), Z, ga + l * 512, gb + l * 512, Y);
        grid.sync();
        phase_gemm<EpiZf32, true>(lds, Y, WoT + (size_t)l * D * D, D, EpiZf32{xin, Z});
        grid.sync();
        phase_ln(make_ctx(lds), Z, l1g + l * D, l1b + l * D, X1, Xb, X8);
        grid.sync();
        phase_gemm<pg8::EpiBf16<0>, true>(lds, Xb, WqT + (size_t)l * PQ * D, PQ, pg8::EpiBf16<0>{Qb, PQ, nullptr, 0, 0, 1.f});
        grid.sync();
        phase_topk(make_ctx(lds), Qb, Kb + (size_t)l * 8 * 2 * NKEYS * 128, EI, GT);
        grid.sync();
        phase_gather(make_ctx(lds), X1, X8, EI, GT, U8 + (size_t)l * NEXP * D, V8 + (size_t)l * NEXP * D, l2g + l * D, l2b + l * D, xout, Xb);
        grid.sync();
    }
}

extern "C" void kernel_launch(void* const* d_in, const int* in_sizes, int n_in, void* d_out, int out_size, void* d_ws, size_t ws_size, hipStream_t stream) {
    static int grid = 0;
    if (grid == 0) {
        if (n_in != 16 || ws_size < WS_END || out_size != NTOK * D) { fprintf(stderr, "kernel_launch: unexpected shapes\n"); grid = -1; return; }
        int dev = 0, cus = 0, per_cu = 0;
        hipGetDevice(&dev);
        hipDeviceGetAttribute(&cus, hipDeviceAttributeMultiprocessorCount, dev);
        hipFuncSetAttribute((const void*)mega_fwd, hipFuncAttributeMaxDynamicSharedMemorySize, LDS_BYTES);
        hipOccupancyMaxActiveBlocksPerMultiprocessor(&per_cu, (const void*)mega_fwd, NTHREADS, LDS_BYTES);
        if (per_cu < 1) { fprintf(stderr, "kernel_launch: occupancy query says %d blocks/CU\n", per_cu); grid = -1; return; }
        grid = cus;
    }
    if (grid < 0) return;
    Params P{};
    for (int i = 0; i < 16; ++i) P.in[i] = (const float*)d_in[i];
    P.out = (float*)d_out; P.ws = (unsigned char*)d_ws;
    void* args[] = {&P};
    hipError_t e = hipLaunchCooperativeKernel((const void*)mega_fwd, dim3(grid), dim3(NTHREADS), args, LDS_BYTES, stream);
    if (e != hipSuccess) fprintf(stderr, "cooperative launch failed: %s (grid %d)\n", hipGetErrorString(e), grid);
}
```

```cpp
#include <hip/hip_runtime.h>
#include <hip/hip_cooperative_groups.h>
#include <stdint.h>
#include <cstdio>
namespace cg = cooperative_groups;

typedef unsigned short bf16_t;
typedef short bf16x8 __attribute__((ext_vector_type(8)));
typedef float f32x4 __attribute__((ext_vector_type(4)));

constexpr int D = 1024, BATCH = 8, SEQ = 4096, DEPTH = 4, NTOK = BATCH * SEQ;
constexpr int HD = 64, PROJ = 2304;
constexpr int O1 = 512, O2 = 640, O3 = 768, O4 = 1280, O5 = 1792;
constexpr int PQ = 2048, NKEYS = 128, NEXP = 16384, TOPK = 16;
constexpr float LN_EPS = 1e-5f;
constexpr float NEGF = -1e30f;
constexpr float ALPHA = 1.6817928305074290f;

__device__ __forceinline__ bf16_t f2bf(float f) { unsigned u = __float_as_uint(f); return (bf16_t)((u + 0x7fffu + ((u >> 16) & 1u)) >> 16); }
__device__ __forceinline__ float bf2f(bf16_t h) { return __uint_as_float(((unsigned)h) << 16); }
__device__ __forceinline__ float wave_sum(float v) {
#pragma unroll
    for (int o = 1; o < 64; o <<= 1) v += __shfl_xor(v, o);
    return v;
}
__device__ __forceinline__ float wave_max(float v) {
#pragma unroll
    for (int o = 1; o < 64; o <<= 1) v = fmaxf(v, __shfl_xor(v, o));
    return v;
}


#define LAS __attribute__((address_space(3)))
typedef float f32x2 __attribute__((ext_vector_type(2)));
typedef unsigned u32x4 __attribute__((ext_vector_type(4)));
typedef unsigned u32x2 __attribute__((ext_vector_type(2)));
typedef float f32x16 __attribute__((ext_vector_type(16)));
constexpr float XS = 8.f, US = 64.f, VS = 16.f;
__device__ __forceinline__ unsigned pack4_fp8(f32x4 v, float sc) {
    v = v * sc;
#pragma unroll
    for (int i = 0; i < 4; ++i) v[i] = fminf(fmaxf(v[i], -448.f), 448.f);
    unsigned p = 0;
    p = __builtin_amdgcn_cvt_pk_fp8_f32(v[0], v[1], p, false);
    p = __builtin_amdgcn_cvt_pk_fp8_f32(v[2], v[3], p, true);
    return p;
}
constexpr int NTHREADS = 512, NWAVES = 8;
constexpr int LDS_BYTES = 147456;

struct Ctx { int tid, lane, wid, bid, G; unsigned char* lds; };
__device__ __forceinline__ Ctx make_ctx(unsigned char* lds) {
    Ctx c; int t = threadIdx.x; asm volatile("" : "+v"(t));
    c.tid = t; c.lane = t & 63; c.wid = __builtin_amdgcn_readfirstlane(t >> 6); c.bid = blockIdx.x; c.G = gridDim.x; c.lds = lds; return c;
}

__device__ __forceinline__ void transpose_item(const float* __restrict__ W, int K, int N, bf16_t* __restrict__ WT, float* scr, int item, int lane) {
    const int nblk = N / 32, kb = item / nblk, nb = item % nblk, k0 = 64 * kb, n0 = 32 * nb;
#pragma unroll 8
    for (int i = 0; i < 32; ++i) { const int kk = 2 * i + (lane >> 5); scr[kk * 33 + (lane & 31)] = W[(size_t)(k0 + kk) * N + n0 + (lane & 31)]; }
    __builtin_amdgcn_fence(__ATOMIC_RELEASE, "wavefront"); __builtin_amdgcn_wave_barrier(); __builtin_amdgcn_fence(__ATOMIC_ACQUIRE, "wavefront");
    const int c = lane & 7;
#pragma unroll
    for (int j = 0; j < 4; ++j) {
        const int n = (lane >> 3) + 8 * j; const float* sp = scr + (8 * c) * 33 + n;
        uint4 o;
        o.x = f2bf(sp[0 * 33]) | ((unsigned)f2bf(sp[1 * 33]) << 16); o.y = f2bf(sp[2 * 33]) | ((unsigned)f2bf(sp[3 * 33]) << 16);
        o.z = f2bf(sp[4 * 33]) | ((unsigned)f2bf(sp[5 * 33]) << 16); o.w = f2bf(sp[6 * 33]) | ((unsigned)f2bf(sp[7 * 33]) << 16);
        *(uint4*)(WT + (size_t)(n0 + n) * K + k0 + 8 * c) = o;
    }
    __builtin_amdgcn_fence(__ATOMIC_RELEASE, "wavefront"); __builtin_amdgcn_wave_barrier(); __builtin_amdgcn_fence(__ATOMIC_ACQUIRE, "wavefront");
}
__device__ __forceinline__ void phase_convert(const Ctx& c, const float* w_in, const float* w_o, const float* wq, const float* x, const float* pu, const float* pv,
                                              bf16_t* WinT, bf16_t* WoT, bf16_t* WqT, bf16_t* Xb, unsigned char* U8, unsigned char* V8, const float* keys, bf16_t* Kb) {
    float* scr = (float*)(c.lds + c.wid * 16384);
    const int gw = c.bid * NWAVES + c.wid, NGW = c.G * NWAVES;
    constexpr int I_IN = (D / 64) * (PROJ / 32), I_O = (D / 64) * (D / 32), I_Q = (D / 64) * (PQ / 32);
    constexpr int NIT = DEPTH * (I_IN + I_O + I_Q);
    for (int it = gw; it < NIT; it += NGW) {
        const int l = it / (I_IN + I_O + I_Q); int r = it % (I_IN + I_O + I_Q);
        if (r < I_IN) { transpose_item(w_in + (size_t)l * D * PROJ, D, PROJ, WinT + (size_t)l * PROJ * D, scr, r, c.lane); continue; } r -= I_IN;
        if (r < I_O) { transpose_item(w_o + (size_t)l * D * D, D, D, WoT + (size_t)l * D * D, scr, r, c.lane); continue; } r -= I_O;
        transpose_item(wq + (size_t)l * D * PQ, D, PQ, WqT + (size_t)l * PQ * D, scr, r, c.lane);
    }
    const size_t n4 = (size_t)NTOK * D / 4;
    for (size_t i = (size_t)c.bid * NTHREADS + c.tid; i < n4; i += (size_t)c.G * NTHREADS) {
        const f32x4 v = ((const f32x4*)x)[i];
        uint2 o; o.x = f2bf(v[0]) | ((unsigned)f2bf(v[1]) << 16); o.y = f2bf(v[2]) | ((unsigned)f2bf(v[3]) << 16);
        ((uint2*)Xb)[i] = o;
    }
    {
        const size_t k4 = (size_t)DEPTH * 8 * 2 * NKEYS * 128 / 4;
        for (size_t i = (size_t)c.bid * NTHREADS + c.tid; i < k4; i += (size_t)c.G * NTHREADS) {
            const f32x4 v = ((const f32x4*)keys)[i];
            uint2 o; o.x = f2bf(v[0]) | ((unsigned)f2bf(v[1]) << 16); o.y = f2bf(v[2]) | ((unsigned)f2bf(v[3]) << 16);
            ((uint2*)Kb)[i] = o;
        }
    }
    const size_t n16 = (size_t)DEPTH * NEXP * D / 16;
    for (size_t i = (size_t)c.bid * NTHREADS + c.tid; i < n16; i += (size_t)c.G * NTHREADS) {
        const f32x4* pa = (const f32x4*)pu + 4 * i; const f32x4* pb = (const f32x4*)pv + 4 * i;
        uint4 oa, ob;
        oa.x = pack4_fp8(pa[0], US); oa.y = pack4_fp8(pa[1], US); oa.z = pack4_fp8(pa[2], US); oa.w = pack4_fp8(pa[3], US);
        ob.x = pack4_fp8(pb[0], VS); ob.y = pack4_fp8(pb[1], VS); ob.z = pack4_fp8(pb[2], VS); ob.w = pack4_fp8(pb[3], VS);
        ((uint4*)U8)[i] = oa; ((uint4*)V8)[i] = ob;
    }
}


namespace pg8 {
#define PG8_LAS __attribute__((address_space(3)))
typedef unsigned short bf16_t;
typedef short bf16x8 __attribute__((ext_vector_type(8)));
typedef float f32x4 __attribute__((ext_vector_type(4)));
typedef unsigned u32x4 __attribute__((ext_vector_type(4)));
constexpr int BM = 256, BK = 64, HALF = 128, HTB = HALF * BK * 2  , STAGE_BYTES = 8 * HTB, NXCD = 8, WGM = 8;

__host__ __device__ __forceinline__ int lds_byte(int r, int c) { const int st = (r >> 4) * 2 + (c >> 5), rr = r & 15, cc = c & 31, ob = rr * 64 + cc * 2; return st * 1024 + (ob ^ (((ob >> 9) & 1) << 5)); }
__host__ __device__ __forceinline__ void stage_rc(int b, int& R, int& C) { const int st = b / 1024, sb = b % 1024, swz = sb ^ (((sb >> 9) & 1) << 5); R = (st >> 1) * 16 + swz / 64; C = (st & 1) * 32 + (swz % 64) / 2; }
__host__ __device__ __forceinline__ int perm32(int rho) { const int n = rho >> 4, i = rho & 15; return 8 * (i >> 2) + 4 * n + (i & 3); }

struct Unit { int pm, pn; };
struct Gemm { const bf16_t* A; const bf16_t* Bt; int M, N, K; };

struct StaticOrder {
    int nM, nN, nwg, G, c;
    __host__ __device__ void init(int M, int N, int G_, int c_) { nM = M / BM; nN = N / BM; nwg = nM * nN; G = G_; c = c_; }
    __host__ __device__ bool next(int i, Unit& u) const {
        const long L = (long)i * G + c; if (L >= nwg) return false;
        int wgid = (int)L; { const int q = nwg / NXCD, r = nwg % NXCD, xcd = wgid % NXCD, off = wgid / NXCD; wgid = (xcd < r ? xcd * (q + 1) : r * (q + 1) + (xcd - r) * q) + off; }
        const int nig = WGM * nN, gid = wgid / nig, fm = gid * WGM, gsz = (nM - fm) < WGM ? (nM - fm) : WGM;
        u.pm = fm + ((wgid % nig) % gsz); u.pn = (wgid % nig) / gsz; return true;
    }
    __device__ __forceinline__ void a_ready(const Unit&) const {}
    __device__ __forceinline__ void done(const Unit&) const {}
};

__device__ __forceinline__ unsigned cvt_pk_bf16(float lo, float hi) { unsigned r; asm volatile("v_cvt_pk_bf16_f32 %0, %1, %2" : "=v"(r) : "v"(lo), "v"(hi)); return r; }
typedef float f32x2 __attribute__((ext_vector_type(2)));
__device__ __forceinline__ f32x2 gelu_pk(f32x2 v) {
    const f32x2 av = __builtin_elementwise_abs(v), d = av * 0.2316418882f + 1.0f;
    f32x2 t; t.x = __builtin_amdgcn_rcpf(d.x); t.y = __builtin_amdgcn_rcpf(d.y);
    f32x2 q = t * 0.5307027145f + (-0.7265760135f); q = q * t + 0.7107068705f; q = q * t + (-0.142248368f); q = q * t + 0.127414796f; q = q * t;
    const f32x2 s = (v * v) * (-0.72134752044f);
    f32x2 e; e.x = __builtin_amdgcn_exp2f(s.x); e.y = __builtin_amdgcn_exp2f(s.y);
    const f32x2 m = v * (q * e), r = v - m;
    f32x2 o; o.x = v.x < 0.f ? m.x : r.x; o.y = v.y < 0.f ? m.y : r.y; return o;
}

template <int ACT  > struct EpiBf16 {
    static constexpr bool PERM = true, AFTER_DRAIN = false; static_assert(ACT == 0 || ACT == 1, "EpiBf16: ACT is 0 (none) or 1 (gelu_pk)");
    bf16_t* O; int ldc; const float* bias; int split_cols; size_t split_stride; float scale0;
    __device__ __forceinline__ void operator()(const f32x4 (&acc)[2][2][4][2], const Unit& u, int wr, int wc, int fr, int fq) const {
        const int row0 = u.pm * BM + wr * 64 + fr; int colt = u.pn * BM; bf16_t* base = O;
        float sc = 1.f; if (split_cols) { const int t = colt / split_cols; base += (size_t)t * split_stride; colt -= t * split_cols; if (t == 0) sc = scale0; }
        const int col0 = colt + wc * 32 + 8 * fq, bcol0 = u.pn * BM + wc * 32 + 8 * fq;
        f32x4 bv[2][2];
#pragma unroll
        for (int bj = 0; bj < 2; ++bj)
#pragma unroll
            for (int n = 0; n < 2; ++n) bv[bj][n] = bias ? *(const f32x4*)(bias + bcol0 + bj * HALF + 4 * n) : (f32x4){0.f, 0.f, 0.f, 0.f};
#pragma unroll
        for (int ai = 0; ai < 2; ++ai)
#pragma unroll
            for (int m = 0; m < 4; ++m) { bf16_t* rowp = base + (size_t)(row0 + ai * HALF + m * 16) * ldc + col0;
#pragma unroll
                for (int bj = 0; bj < 2; ++bj) { f32x4 v0 = acc[ai][bj][m][0] + bv[bj][0], v1 = acc[ai][bj][m][1] + bv[bj][1];
                    if (ACT == 1) { f32x2 a = gelu_pk((f32x2){v0[0], v0[1]}), b = gelu_pk((f32x2){v0[2], v0[3]}), c = gelu_pk((f32x2){v1[0], v1[1]}), d = gelu_pk((f32x2){v1[2], v1[3]});
                        v0 = (f32x4){a.x, a.y, b.x, b.y}; v1 = (f32x4){c.x, c.y, d.x, d.y}; }
                    v0 = v0 * sc; v1 = v1 * sc; u32x4 w; w.x = cvt_pk_bf16(v0[0], v0[1]); w.y = cvt_pk_bf16(v0[2], v0[3]); w.z = cvt_pk_bf16(v1[0], v1[1]); w.w = cvt_pk_bf16(v1[2], v1[3]);
                    *(u32x4*)(rowp + bj * HALF) = w; } }
    }
};

template <class Epi, class Sched, bool ALIGN_EPI = false, bool SP2 = false>
__device__ __forceinline__ void gemm_phase(PG8_LAS unsigned char* lds, const Gemm g, const Sched& S, const Epi& E) {
    int tid = threadIdx.x; asm volatile("" : "+v"(tid));
    const int wid = __builtin_amdgcn_readfirstlane(tid >> 6), lane = tid & 63, wr = wid >> 2, wc = wid & 3, fr = lane & 15, fq = lane >> 4;
    const int K = g.K, nt = K / BK;
    unsigned voffA[2], voffB[2];
#pragma unroll
    for (int i = 0; i < 2; ++i) { int R, C; stage_rc(tid * 16 + i * 8192, R, C); const int Rb = Epi::PERM ? ((R & ~31) + perm32(R & 31)) : R;
        voffA[i] = (unsigned)(R * K + C) * 2u; voffB[i] = (unsigned)(Rb * K + C) * 2u; }
    const size_t kstep = (size_t)(BK * 2);
    const size_t hstep = (size_t)HALF * K * 2;
    const size_t tstep = 2 * hstep;
    const unsigned ldsw = (unsigned)wid * 1024u;
    const int aoff = lds_byte(wr * 64 + fr, fq * 8), boff = lds_byte(wc * 32 + fr, fq * 8);
#define PG8_SA(b, h) (((b) * 2 + (h)) * HTB)
#define PG8_SB(b, h) ((4 + (b) * 2 + (h)) * HTB)
#define PG8_STAGE(bufoff, gbase, voff) do { _Pragma("unroll") for (int _i = 0; _i < 2; ++_i) \
        __builtin_amdgcn_global_load_lds((const unsigned*)((const char*)(gbase) + (voff)[_i]), (PG8_LAS unsigned*)(lds + (bufoff) + ldsw + _i * 8192), 16, 0, 0); } while (0)
#define PG8_LDA(dst, b, h) do { _Pragma("unroll") for (int m = 0; m < 4; ++m) _Pragma("unroll") for (int k = 0; k < 2; ++k) dst[m][k] = *(const PG8_LAS bf16x8*)(lds + PG8_SA(b, h) + aoff + m * 2048 + k * 1024); } while (0)
#define PG8_LDB(dst, b, h) do { _Pragma("unroll") for (int n = 0; n < 2; ++n) _Pragma("unroll") for (int k = 0; k < 2; ++k) dst[n][k] = *(const PG8_LAS bf16x8*)(lds + PG8_SB(b, h) + boff + n * 2048 + k * 1024); } while (0)
#define PG8_MMA(ai, bj, At, Bt) do { __builtin_amdgcn_s_setprio(1); _Pragma("unroll") for (int m = 0; m < 4; ++m) _Pragma("unroll") for (int n = 0; n < 2; ++n) _Pragma("unroll") for (int k = 0; k < 2; ++k) \
        acc[ai][bj][m][n] = __builtin_amdgcn_mfma_f32_16x16x32_bf16(Bt[n][k], At[m][k], acc[ai][bj][m][n], 0, 0, 0); __builtin_amdgcn_s_setprio(0); } while (0)
#define PG8_WAIT_V(n) asm volatile("s_waitcnt vmcnt(" #n ")" ::: "memory")
#define PG8_WAIT_L(n) asm volatile("s_waitcnt lgkmcnt(" #n ")" ::: "memory")
#define PG8_BAR __builtin_amdgcn_s_barrier()
#define PG8_SCHED __builtin_amdgcn_sched_barrier(0)
    Unit cur, nxt; int ui = 0;
    if (!S.next(0, cur)) return;
    f32x4 acc[2][2][4][2];
#pragma unroll
    for (int a = 0; a < 2; ++a)
#pragma unroll
        for (int b = 0; b < 2; ++b)
#pragma unroll
            for (int m = 0; m < 4; ++m)
#pragma unroll
                for (int n = 0; n < 2; ++n) acc[a][b][m][n] = (f32x4){0.f, 0.f, 0.f, 0.f};
    bf16x8 At[4][2], B0[2][2], B1[2][2];
    const char* cA = (const char*)g.A + (size_t)cur.pm * tstep; const char* cB = (const char*)g.Bt + (size_t)cur.pn * tstep;
    S.a_ready(cur);
    if constexpr (SP2) {
        PG8_STAGE(PG8_SB(0, 0), cB, voffB); PG8_STAGE(PG8_SB(0, 1), cB + hstep, voffB); PG8_STAGE(PG8_SA(0, 0), cA, voffA); PG8_STAGE(PG8_SA(0, 1), cA + hstep, voffA);
        if (wr == 1) PG8_BAR;
        PG8_WAIT_V(2); PG8_BAR;
        PG8_STAGE(PG8_SB(1, 0), cB + kstep, voffB); PG8_STAGE(PG8_SA(1, 0), cA + kstep, voffA); PG8_STAGE(PG8_SB(1, 1), cB + hstep + kstep, voffB);
        PG8_WAIT_V(6); PG8_BAR;
    } else {
        PG8_STAGE(PG8_SB(0, 0), cB, voffB); PG8_STAGE(PG8_SA(0, 0), cA, voffA); PG8_STAGE(PG8_SB(0, 1), cB + hstep, voffB); PG8_STAGE(PG8_SA(0, 1), cA + hstep, voffA);
        if (wr == 1) PG8_BAR;
        PG8_WAIT_V(4); PG8_BAR;
        PG8_STAGE(PG8_SB(1, 0), cB + kstep, voffB); PG8_STAGE(PG8_SA(1, 0), cA + kstep, voffA); PG8_STAGE(PG8_SB(1, 1), cB + hstep + kstep, voffB);
        PG8_WAIT_V(6); PG8_BAR;
    }
    for (;;) {
        const bool has_next = S.next(ui + 1, nxt);
        const char* nA = has_next ? (const char*)g.A + (size_t)nxt.pm * tstep : cA; const char* nB = has_next ? (const char*)g.Bt + (size_t)nxt.pn * tstep : cB;
        for (int t = 0; t < nt; t += 2) {
            const bool last = (t == nt - 2);
            const char* a1 = cA + (size_t)(t + 1) * kstep;
            const char* a2 = last ? nA : cA + (size_t)(t + 2) * kstep; const char* b2 = last ? nB : cB + (size_t)(t + 2) * kstep;
            const char* a3 = a2 + kstep; const char* b3 = b2 + kstep;
            if (last && has_next) S.a_ready(nxt);
            if constexpr (SP2) {
            PG8_LDB(B0, 0, 0); PG8_LDB(B1, 0, 1); PG8_SCHED; PG8_LDA(At, 0, 0); PG8_STAGE(PG8_SA(1, 1), a1 + hstep, voffA);
            PG8_WAIT_V(8); PG8_WAIT_L(0); PG8_BAR; PG8_MMA(0, 0, At, B0); PG8_MMA(0, 1, At, B1); PG8_BAR; PG8_SCHED;
            PG8_LDA(At, 0, 1); PG8_STAGE(PG8_SB(0, 0), b2, voffB); PG8_STAGE(PG8_SB(0, 1), b2 + hstep, voffB); PG8_STAGE(PG8_SA(0, 0), a2, voffA);
            PG8_WAIT_V(8); PG8_WAIT_L(0); PG8_BAR; PG8_MMA(1, 0, At, B0); PG8_MMA(1, 1, At, B1); PG8_BAR; PG8_SCHED;
            PG8_LDB(B0, 1, 0); PG8_LDB(B1, 1, 1); PG8_SCHED; PG8_LDA(At, 1, 0); PG8_STAGE(PG8_SA(0, 1), a2 + hstep, voffA);
            PG8_WAIT_V(8); PG8_WAIT_L(0); PG8_BAR; PG8_MMA(0, 0, At, B0); PG8_MMA(0, 1, At, B1); PG8_BAR; PG8_SCHED;
            PG8_LDA(At, 1, 1); PG8_STAGE(PG8_SB(1, 0), b3, voffB); PG8_STAGE(PG8_SB(1, 1), b3 + hstep, voffB); PG8_STAGE(PG8_SA(1, 0), a3, voffA);
            PG8_WAIT_V(8); PG8_WAIT_L(0); PG8_BAR; PG8_MMA(1, 0, At, B0); PG8_MMA(1, 1, At, B1); PG8_BAR; PG8_SCHED;
            } else {
            PG8_LDB(B0, 0, 0); PG8_SCHED; PG8_LDA(At, 0, 0); PG8_STAGE(PG8_SA(1, 1), a1 + hstep, voffA);
            PG8_WAIT_L(8); PG8_BAR; PG8_WAIT_L(0); PG8_MMA(0, 0, At, B0); PG8_BAR; PG8_SCHED;
            PG8_LDB(B1, 0, 1); PG8_STAGE(PG8_SB(0, 0), b2, voffB);
            PG8_BAR; PG8_WAIT_L(0); PG8_MMA(0, 1, At, B1); PG8_BAR;
            PG8_LDA(At, 0, 1); PG8_STAGE(PG8_SA(0, 0), a2, voffA);
            PG8_BAR; PG8_WAIT_L(0); PG8_MMA(1, 0, At, B0); PG8_BAR; PG8_SCHED;
            PG8_STAGE(PG8_SB(0, 1), b2 + hstep, voffB);
            PG8_WAIT_V(6); PG8_BAR; PG8_MMA(1, 1, At, B1); PG8_BAR;
            PG8_LDB(B0, 1, 0); PG8_SCHED; PG8_LDA(At, 1, 0); PG8_STAGE(PG8_SA(0, 1), a2 + hstep, voffA);
            PG8_WAIT_L(8); PG8_BAR; PG8_WAIT_L(0); PG8_MMA(0, 0, At, B0); PG8_BAR; PG8_SCHED;
            PG8_LDB(B1, 1, 1); PG8_STAGE(PG8_SB(1, 0), b3, voffB);
            PG8_BAR; PG8_WAIT_L(0); PG8_MMA(0, 1, At, B1); PG8_BAR;
            PG8_LDA(At, 1, 1); PG8_STAGE(PG8_SA(1, 0), a3, voffA);
            PG8_BAR; PG8_WAIT_L(0); PG8_MMA(1, 0, At, B0); PG8_BAR; PG8_SCHED;
            PG8_STAGE(PG8_SB(1, 1), b3 + hstep, voffB);
            PG8_WAIT_V(6); PG8_BAR; PG8_MMA(1, 1, At, B1); PG8_BAR;
            }
        }
        if constexpr (ALIGN_EPI) { if (wr == 0) PG8_BAR; }
        if constexpr (!Epi::AFTER_DRAIN) { E(acc, cur, wr, wc, fr, fq); S.done(cur); }
        if (!has_next) break;
#pragma unroll
        for (int a = 0; a < 2; ++a)
#pragma unroll
            for (int b = 0; b < 2; ++b)
#pragma unroll
                for (int m = 0; m < 4; ++m)
#pragma unroll
                    for (int n = 0; n < 2; ++n) acc[a][b][m][n] = (f32x4){0.f, 0.f, 0.f, 0.f};
        cur = nxt; cA = nA; cB = nB; ++ui;
        if constexpr (ALIGN_EPI) { if (wr == 1) PG8_BAR; }
    }
    PG8_WAIT_V(0);
    if constexpr (!ALIGN_EPI) { if (wr == 0) PG8_BAR; }
    PG8_BAR;
    if constexpr (Epi::AFTER_DRAIN) { E.fused(acc, cur, wr, wc, fr, fq, lds, wid, lane); S.done(cur); }
#undef PG8_SA
#undef PG8_SB
#undef PG8_STAGE
#undef PG8_LDA
#undef PG8_LDB
#undef PG8_MMA
#undef PG8_WAIT_V
#undef PG8_WAIT_L
#undef PG8_BAR
#undef PG8_SCHED
}
}
struct EpiZf32 {
    static constexpr bool PERM = false, AFTER_DRAIN = false;
    const float* x; float* Z;
    __device__ __forceinline__ void operator()(const pg8::f32x4 (&acc)[2][2][4][2], const pg8::Unit& u, int wr, int wc, int fr, int fq) const {
#pragma unroll
        for (int ai = 0; ai < 2; ++ai)
#pragma unroll
            for (int m = 0; m < 4; ++m) {
                const size_t rowoff = (size_t)(u.pm * 256 + ai * 128 + wr * 64 + m * 16 + fr) * D + u.pn * 256 + wc * 32 + 4 * fq;
#pragma unroll
                for (int bj = 0; bj < 2; ++bj)
#pragma unroll
                    for (int n = 0; n < 2; ++n) {
                        const size_t i = rowoff + bj * 128 + n * 16;
                        const pg8::f32x4 xv = *(const pg8::f32x4*)(x + i);
                        *(pg8::f32x4*)(Z + i) = xv * ALPHA + acc[ai][bj][m][n];
                    }
            }
    }
};
template <class Epi, bool ALIGN>
__device__ __forceinline__ void phase_gemm(unsigned char* lds, const bf16_t* A, const bf16_t* Bt, int N, const Epi& E) {
    pg8::Gemm g{A, Bt, NTOK, N, D};
    pg8::StaticOrder S; S.init(NTOK, N, (int)gridDim.x, (int)blockIdx.x);
    pg8::gemm_phase<Epi, pg8::StaticOrder, ALIGN, true>((PG8_LAS unsigned char*)lds, g, S, E);
}

struct EpiH { bf16_t* H; __device__ void operator()(int r, int c, float v) const { H[(size_t)r * PROJ + c] = f2bf(v); } };
struct EpiZ { const float* x; float* Z; __device__ void operator()(int r, int c, float v) const { size_t i = (size_t)r * D + c; Z[i] = ALPHA * x[i] + v; } };
struct EpiQ { bf16_t* Q; __device__ void operator()(int r, int c, float v) const { Q[(size_t)r * PQ + c] = f2bf(v); } };

template <class Epi, int N, int K>
__device__ __forceinline__ void phase_gemm_simple(const Ctx& c, const bf16_t* __restrict__ A, const bf16_t* __restrict__ Bt, Epi epi) {
    const int half = c.tid >> 8, tid = c.tid & 255, lane = c.lane, wid = tid >> 6, wm = wid >> 1, wn = wid & 1;
    bf16_t* sA = (bf16_t*)(c.lds + half * 20480);
    bf16_t* sB = sA + 128 * 40;
    constexpr int nN = N / 128, NT = (NTOK / 128) * nN;
    for (int t0 = c.bid * 2; t0 < NT; t0 += c.G * 2) {
        const int t = t0 + half; const bool live = t < NT;
        const int bm = (t / nN) * 128, bn = (t % nN) * 128;
        f32x4 acc[4][4];
#pragma unroll
        for (int i = 0; i < 4; ++i)
#pragma unroll
            for (int j = 0; j < 4; ++j) acc[i][j] = (f32x4){0.f, 0.f, 0.f, 0.f};
        for (int k0 = 0; k0 < K; k0 += 32) {
            if (live) {
#pragma unroll
                for (int i = 0; i < 2; ++i) {
                    const int ch = tid + i * 256, r = ch >> 2, cc = (ch & 3) * 8;
                    *(uint4*)&sA[r * 40 + cc] = *(const uint4*)&A[(size_t)(bm + r) * K + k0 + cc];
                    *(uint4*)&sB[r * 40 + cc] = *(const uint4*)&Bt[(size_t)(bn + r) * K + k0 + cc];
                }
            }
            __syncthreads();
            bf16x8 a[4], b[4];
#pragma unroll
            for (int i = 0; i < 4; ++i) {
                a[i] = *(const bf16x8*)&sA[(wm * 64 + i * 16 + (lane & 15)) * 40 + (lane >> 4) * 8];
                b[i] = *(const bf16x8*)&sB[(wn * 64 + i * 16 + (lane & 15)) * 40 + (lane >> 4) * 8];
            }
#pragma unroll
            for (int i = 0; i < 4; ++i)
#pragma unroll
                for (int j = 0; j < 4; ++j) acc[i][j] = __builtin_amdgcn_mfma_f32_16x16x32_bf16(a[i], b[j], acc[i][j], 0, 0, 0);
            __syncthreads();
        }
        if (live) {
#pragma unroll
            for (int i = 0; i < 4; ++i)
#pragma unroll
                for (int j = 0; j < 4; ++j)
#pragma unroll
                    for (int r = 0; r < 4; ++r) epi(bm + wm * 64 + i * 16 + (lane >> 4) * 4 + r, bn + wn * 64 + j * 16 + (lane & 15), acc[i][j][r]);
        }
    }
}

__device__ __forceinline__ int t5_bucket(int rel) {
    const int n = rel < 0 ? -rel : rel;
    int v;
    if (n < 8) v = n;
    else { int k = 0; k += (n >= 12); k += (n >= 16); k += (n >= 23); k += (n >= 32); k += (n >= 46); k += (n >= 64); k += (n >= 91); v = 8 + k; }
    return (rel > 0 ? 16 : 0) + v;
}
__device__ __forceinline__ float dot64_bf16(const float* qs, const bf16_t* krow) {
    float s = 0.f;
#pragma unroll
    for (int c = 0; c < 8; ++c) {
        const uint4 w = ((const uint4*)krow)[c];
        const unsigned ww[4] = {w.x, w.y, w.z, w.w};
#pragma unroll
        for (int e = 0; e < 4; ++e) { s += qs[c * 8 + 2 * e] * __uint_as_float(ww[e] << 16); s += qs[c * 8 + 2 * e + 1] * __uint_as_float(ww[e] & 0xffff0000u); }
    }
    return s;
}
#define WAVE_LDS_SYNC() do { __builtin_amdgcn_fence(__ATOMIC_RELEASE, "wavefront"); __builtin_amdgcn_wave_barrier(); __builtin_amdgcn_fence(__ATOMIC_ACQUIRE, "wavefront"); } while (0)

__device__ __forceinline__ void phase_attn_naive(const Ctx& c, const bf16_t* __restrict__ H, const float* __restrict__ sink, const float* __restrict__ t5, const float* __restrict__ rpb, float* __restrict__ Yraw) {
    float* qsh = (float*)(c.lds + c.wid * 256);
    const int lane = c.lane;
    const int gw = c.bid * NWAVES + c.wid, NGW = c.G * NWAVES;
    for (int item = gw; item < NTOK * 16; item += NGW) {
        const int tok = item >> 4, hh = item & 15;
        const int b = tok / SEQ, tt = tok % SEQ;
        if (hh < 8) {
            const int hq = hh, kvh = hq >> 2;
            qsh[lane] = bf2f(H[(size_t)tok * PROJ + hq * HD + lane]);
            WAVE_LDS_SYNC();
            float s[5];
#pragma unroll
            for (int i = 0; i < 5; ++i) {
                const int j = lane + 64 * i, rel = j - 128, kp = tt + rel;
                const bool valid = (rel <= 128) && kp >= 0 && kp < SEQ;
                float v = NEGF;
                if (valid) {
                    const bf16_t* krow = H + (size_t)(b * SEQ + kp) * PROJ + O1 + kvh * HD;
                    v = dot64_bf16(qsh, krow) * 0.125f + t5[t5_bucket(rel) * 8 + hq];
                }
                s[i] = v;
            }
            const float sk = sink[hq];
            float m = fmaxf(fmaxf(fmaxf(s[0], s[1]), fmaxf(s[2], s[3])), s[4]);
            m = fmaxf(wave_max(m), sk);
            float p[5], sum = 0.f;
#pragma unroll
            for (int i = 0; i < 5; ++i) { p[i] = expf(s[i] - m); sum += p[i]; }
            sum = wave_sum(sum) + expf(sk - m);
            const float inv = 1.f / sum;
            float acc = 0.f;
#pragma unroll
            for (int i = 0; i < 5; ++i) {
                for (int jj = 0; jj < 64; ++jj) {
                    const float pj = __shfl(p[i], jj);
                    const int rel = jj + 64 * i - 128; const int kp = tt + rel;
                    if (rel > 128 || kp < 0 || kp >= SEQ) continue;
                    acc += pj * bf2f(H[(size_t)(b * SEQ + kp) * PROJ + O2 + kvh * HD + lane]);
                }
            }
            Yraw[(size_t)tok * D + hq * HD + lane] = acc * inv;
        } else {
            const int hb = hh - 8, r = tt >> 6, cc = tt & 63;
            int rs = r - 4; rs = rs < 0 ? 0 : (rs > 56 ? 56 : rs);
            int cs = cc - 8; cs = cs < 0 ? 0 : (cs > 48 ? 48 : cs);
            qsh[lane] = bf2f(H[(size_t)tok * PROJ + O3 + hb * HD + lane]);
            WAVE_LDS_SYNC();
            float s[2];
#pragma unroll
            for (int i = 0; i < 2; ++i) {
                const int j = lane + 64 * i, kr = rs + (j >> 4), kc = cs + (j & 15);
                const bf16_t* krow = H + (size_t)(b * SEQ + kr * 64 + kc) * PROJ + O4 + hb * HD;
                const int dr = kr - r + 7; int dc = kc - cc; dc = dc < -15 ? -15 : (dc > 15 ? 15 : dc); dc += 15;
                s[i] = dot64_bf16(qsh, krow) * 0.125f + rpb[(hb * 15 + dr) * 31 + dc];
            }
            const float m = wave_max(fmaxf(s[0], s[1]));
            float p[2]; p[0] = expf(s[0] - m); p[1] = expf(s[1] - m);
            const float inv = 1.f / wave_sum(p[0] + p[1]);
            float acc = 0.f;
#pragma unroll
            for (int i = 0; i < 2; ++i)
                for (int jj = 0; jj < 64; ++jj) {
                    const float pj = __shfl(p[i], jj);
                    const int j = jj + 64 * i, kr = rs + (j >> 4), kc = cs + (j & 15);
                    acc += pj * bf2f(H[(size_t)(b * SEQ + kr * 64 + kc) * PROJ + O5 + hb * HD + lane]);
                }
            Yraw[(size_t)tok * D + 512 + hb * HD + lane] = acc * inv;
        }
        WAVE_LDS_SYNC();
    }
}


struct AttnState { float m, l; f32x16 o0, o1; };
__device__ __forceinline__ void attn_state_init(AttnState& st) {
    st.m = -1e30f; st.l = 0.f;
#pragma unroll
    for (int r = 0; r < 16; ++r) { st.o0[r] = 0.f; st.o1[r] = 0.f; }
}
__device__ __forceinline__ void attn_stage_kv(const Ctx& c, LAS unsigned char* Ks, LAS unsigned char* VT, const bf16_t* __restrict__ H, int b, int tok0, int koff, int voff) {
#pragma unroll
    for (int i = 0; i < 6; ++i) {
        const int ch = c.tid + NTHREADS * i, row = ch >> 3, cc = ch & 7;
        int t = tok0 + row; t = t < 0 ? 0 : (t > SEQ - 1 ? SEQ - 1 : t);
        const bf16_t* src = H + (size_t)(b * SEQ + t) * PROJ;
        const u32x4 kv = *(const u32x4*)(src + koff + cc * 8);
        const u32x4 vv = *(const u32x4*)(src + voff + cc * 8);
        *(LAS u32x4*)(Ks + row * 128 + ((cc ^ (row & 7)) << 4)) = kv;
        LAS bf16_t* vt = (LAS bf16_t*)VT + (cc * 8) * 388 + row;
#pragma unroll
        for (int k = 0; k < 4; ++k) { vt[(2 * k) * 388] = (bf16_t)(vv[k] & 0xffffu); vt[(2 * k + 1) * 388] = (bf16_t)(vv[k] >> 16); }
    }
}
__device__ __forceinline__ void attn_qk(f32x16& s, const bf16x8 (&qf)[4], const LAS unsigned char* Ks, int kt, int r32, int hh) {
#pragma unroll
    for (int r = 0; r < 16; ++r) s[r] = 0.f;
#pragma unroll
    for (int ks = 0; ks < 4; ++ks) {
        const bf16x8 a = *(const LAS bf16x8*)(Ks + (32 * kt + r32) * 128 + (((2 * ks + hh) ^ (r32 & 7)) << 4));
        s = __builtin_amdgcn_mfma_f32_32x32x16_bf16(a, qf[ks], s, 0, 0, 0);
    }
}
__device__ __forceinline__ void attn_softmax_pv(AttnState& st, f32x16& s, const LAS unsigned char* VT, int kt, int r32, int hh) {
    float tmax = s[0];
#pragma unroll
    for (int r = 1; r < 16; ++r) tmax = fmaxf(tmax, s[r]);
    tmax = fmaxf(tmax, __shfl_xor(tmax, 32));
    const float mn = fmaxf(st.m, tmax), alpha = __expf(st.m - mn);
    st.m = mn;
    float psum = 0.f;
#pragma unroll
    for (int r = 0; r < 16; ++r) { s[r] = __expf(s[r] - mn); psum += s[r]; }
    st.l = st.l * alpha + psum;
#pragma unroll
    for (int r = 0; r < 16; ++r) { st.o0[r] *= alpha; st.o1[r] *= alpha; }
    bf16x8 pb[2];
#pragma unroll
    for (int s2 = 0; s2 < 2; ++s2)
#pragma unroll
        for (int j = 0; j < 8; ++j) pb[s2][j] = (short)f2bf(s[8 * s2 + j]);
#pragma unroll
    for (int s2 = 0; s2 < 2; ++s2) {
        const LAS unsigned char* vp0 = VT + (r32 * 388 + 32 * kt + 16 * s2 + 4 * hh) * 2;
        const LAS unsigned char* vp1 = vp0 + 32 * 388 * 2;
        const u32x2 a0 = *(const LAS u32x2*)vp0, a1 = *(const LAS u32x2*)(vp0 + 16);
        const u32x2 b0 = *(const LAS u32x2*)vp1, b1 = *(const LAS u32x2*)(vp1 + 16);
        const u32x4 fa = {a0[0], a0[1], a1[0], a1[1]}, fb = {b0[0], b0[1], b1[0], b1[1]};
        st.o0 = __builtin_amdgcn_mfma_f32_32x32x16_bf16(__builtin_bit_cast(bf16x8, fa), pb[s2], st.o0, 0, 0, 0);
        st.o1 = __builtin_amdgcn_mfma_f32_32x32x16_bf16(__builtin_bit_cast(bf16x8, fb), pb[s2], st.o1, 0, 0, 0);
    }
}
__device__ __forceinline__ void attn_store(const AttnState& st, float scale, float* __restrict__ yrow  , int hh) {
#pragma unroll
    for (int g4 = 0; g4 < 4; ++g4) {
        f32x4 a, b;
#pragma unroll
        for (int e = 0; e < 4; ++e) { a[e] = st.o0[4 * g4 + e] * scale; b[e] = st.o1[4 * g4 + e] * scale; }
        *(f32x4*)(yrow + 8 * g4 + 4 * hh) = a;
        *(f32x4*)(yrow + 32 + 8 * g4 + 4 * hh) = b;
    }
}
__device__ __forceinline__ void phase_attn(const Ctx& c, const bf16_t* __restrict__ H, const float* __restrict__ sink, const float* __restrict__ t5, const float* __restrict__ rpb, float* __restrict__ Yraw) {
    LAS unsigned char* Ks = (LAS unsigned char*)c.lds;
    LAS unsigned char* VT = Ks + 49152;
    LAS float* TB = (LAS float*)(Ks + 98816);
    const int lane = c.lane, r32 = lane & 31, hh = lane >> 5, w = c.wid;
    constexpr int NWIN = BATCH * 2 * (SEQ / 128), NNA = BATCH * 8 * 16;
    for (int u = c.bid; u < NWIN + NNA; u += c.G) {
        __syncthreads();
        if (u < NWIN) {
            const int b = u / (2 * (SEQ / 128)), kvh = (u / (SEQ / 128)) & 1, n = u % (SEQ / 128);
            attn_stage_kv(c, Ks, VT, H, b, 128 * (n - 1), O1 + kvh * HD, O2 + kvh * HD);
            for (int i = c.tid; i < 511 * 4; i += NTHREADS) {
                const int rel = (i >> 2) - 255, g = i & 3;
                TB[i] = (rel >= -128 && rel <= 128) ? t5[t5_bucket(rel) * 8 + kvh * 4 + g] : -INFINITY;
            }
            __syncthreads();
            const int g = w >> 1, hq = kvh * 4 + g;
            const float sk = sink[hq];
#pragma unroll 1
            for (int qi = 0; qi < 2; ++qi) {
                const int qt = 2 * (w & 1) + qi, i0 = 32 * qt;
                const int tok = b * SEQ + 128 * n + i0 + r32;
                bf16x8 qf[4];
#pragma unroll
                for (int ks = 0; ks < 4; ++ks) qf[ks] = *(const bf16x8*)(H + (size_t)tok * PROJ + hq * HD + 16 * ks + 8 * hh);
                AttnState st; attn_state_init(st);
                int kt0 = qt, kt1 = qt + 8;
                if (n == 0 && kt0 < 4) kt0 = 4;
                if (n == SEQ / 128 - 1 && kt1 > 7) kt1 = 7;
#pragma unroll 1
                for (int kt = kt0; kt <= kt1; ++kt) {
                    f32x16 s; attn_qk(s, qf, Ks, kt, r32, hh);
                    const LAS float* tb = TB + (32 * kt + 4 * hh - (i0 + r32) + 127) * 4 + g;
#pragma unroll
                    for (int r = 0; r < 16; ++r) s[r] = s[r] * 0.125f + tb[((r & 3) + 8 * (r >> 2)) * 4];
                    attn_softmax_pv(st, s, VT, kt, r32, hh);
                }
                const float l = st.l + __shfl_xor(st.l, 32);
                const float mf = fmaxf(st.m, sk), ef = __expf(st.m - mf);
                const float scale = ef / (l * ef + __expf(sk - mf));
                attn_store(st, scale, Yraw + (size_t)tok * D + hq * HD, hh);
            }
        } else {
            const int v = u - NWIN, b = v / (8 * 16), hb = (v / 16) & 7, R0 = 4 * (v & 15);
            int kr0 = R0 - 4; kr0 = kr0 < 0 ? 0 : (kr0 > 56 ? 56 : kr0);
            const int r = R0 + (w >> 1), cq = 32 * (w & 1) + r32;
            int rs = r - 4; rs = rs < 0 ? 0 : (rs > 56 ? 56 : rs);
            int cs = cq - 8; cs = cs < 0 ? 0 : (cs > 48 ? 48 : cs);
            const int tok = b * SEQ + r * 64 + cq;
            bf16x8 qf[4];
#pragma unroll
            for (int ks = 0; ks < 4; ++ks) qf[ks] = *(const bf16x8*)(H + (size_t)tok * PROJ + O3 + hb * HD + 16 * ks + 8 * hh);
            AttnState st; attn_state_init(st);
#pragma unroll 1
            for (int pass = 0; pass < 2; ++pass) {
                if (pass) __syncthreads();
                attn_stage_kv(c, Ks, VT, H, b, (kr0 + 6 * pass) * 64, O4 + hb * HD, O5 + hb * HD);
                if (pass == 0) for (int i = c.tid; i < 15 * 31; i += NTHREADS) TB[i] = rpb[hb * 15 * 31 + i];
                __syncthreads();
#pragma unroll 1
                for (int kt = 0; kt < 12; ++kt) {
                    const int kr = kr0 + 6 * pass + (kt >> 1);
                    if (kr < rs || kr >= rs + 8) continue;
                    f32x16 s; attn_qk(s, qf, Ks, kt, r32, hh);
                    const LAS float* tb = TB + (kr - r + 7) * 31 + 15;
                    const int kc0 = 32 * (kt & 1) + 4 * hh;
#pragma unroll
                    for (int rr = 0; rr < 16; ++rr) {
                        const int kc = kc0 + (rr & 3) + 8 * (rr >> 2);
                        int dc = kc - cq; dc = dc < -15 ? -15 : (dc > 15 ? 15 : dc);
                        const bool ok = (kc >= cs) && (kc < cs + 16);
                        s[rr] = ok ? s[rr] * 0.125f + tb[dc] : -INFINITY;
                    }
                    attn_softmax_pv(st, s, VT, kt, r32, hh);
                }
            }
            const float l = st.l + __shfl_xor(st.l, 32);
            attn_store(st, 1.f / l, Yraw + (size_t)tok * D + 512 + hb * HD, hh);
        }
    }
}

__device__ __forceinline__ void phase_rmsnorm(const Ctx& c, const float* __restrict__ Yraw, const float* __restrict__ ga, const float* __restrict__ gb, bf16_t* __restrict__ Y) {
    const int lane = c.lane, gw = c.bid * NWAVES + c.wid, NGW = c.G * NWAVES;
    for (int tok = gw; tok < NTOK; tok += NGW) {
        const float* row = Yraw + (size_t)tok * D;
        float a[8], bb[8], sa = 0.f, sb = 0.f;
#pragma unroll
        for (int i = 0; i < 8; ++i) { a[i] = row[lane + 64 * i]; bb[i] = row[512 + lane + 64 * i]; sa += a[i] * a[i]; sb += bb[i] * bb[i]; }
        const float ra = rsqrtf(wave_sum(sa) * (1.f / 512.f) + LN_EPS), rb = rsqrtf(wave_sum(sb) * (1.f / 512.f) + LN_EPS);
#pragma unroll
        for (int i = 0; i < 8; ++i) {
            Y[(size_t)tok * D + lane + 64 * i] = f2bf(a[i] * ra * ga[lane + 64 * i]);
            Y[(size_t)tok * D + 512 + lane + 64 * i] = f2bf(bb[i] * rb * gb[lane + 64 * i]);
        }
    }
}

__device__ __forceinline__ void ln_store_row(f32x4 (&v)[4], int lane, const float* __restrict__ g, const float* __restrict__ bta, float* __restrict__ orow, bf16_t* __restrict__ obrow, unsigned char* __restrict__ o8row) {
    float s = 0.f;
#pragma unroll
    for (int j = 0; j < 4; ++j) s += (v[j][0] + v[j][1]) + (v[j][2] + v[j][3]);
    const float mean = wave_sum(s) * (1.f / D); float s2 = 0.f;
#pragma unroll
    for (int j = 0; j < 4; ++j) { v[j] = v[j] - mean; s2 += (v[j][0] * v[j][0] + v[j][1] * v[j][1]) + (v[j][2] * v[j][2] + v[j][3] * v[j][3]); }
    const float rstd = rsqrtf(wave_sum(s2) * (1.f / D) + LN_EPS);
#pragma unroll
    for (int j = 0; j < 4; ++j) {
        const f32x4 gg = ((const f32x4*)g)[lane + 64 * j], be = ((const f32x4*)bta)[lane + 64 * j];
        const f32x4 o = v[j] * rstd * gg + be;
        ((f32x4*)orow)[lane + 64 * j] = o;
        uint2 ob; ob.x = f2bf(o[0]) | ((unsigned)f2bf(o[1]) << 16); ob.y = f2bf(o[2]) | ((unsigned)f2bf(o[3]) << 16);
        ((uint2*)obrow)[lane + 64 * j] = ob;
        if (o8row) ((unsigned*)o8row)[lane + 64 * j] = pack4_fp8(o, XS);
    }
}
__device__ __forceinline__ void phase_ln(const Ctx& c, const float* __restrict__ Z, const float* __restrict__ g, const float* __restrict__ bta, float* __restrict__ out, bf16_t* __restrict__ outb, unsigned char* __restrict__ out8) {
    const int lane = c.lane, gw = c.bid * NWAVES + c.wid, NGW = c.G * NWAVES;
    for (int tok = gw; tok < NTOK; tok += NGW) {
        const f32x4* zr = (const f32x4*)(Z + (size_t)tok * D);
        f32x4 v[4];
#pragma unroll
        for (int j = 0; j < 4; ++j) v[j] = zr[lane + 64 * j];
        ln_store_row(v, lane, g, bta, out + (size_t)tok * D, outb + (size_t)tok * D, out8 + (size_t)tok * D);
    }
}


#ifndef HD
#define HD __host__ __device__ __forceinline__
#endif
HD unsigned tk_f2u(float f) { return __builtin_bit_cast(unsigned, f); }
HD float tk_u2f(unsigned u) { return __builtin_bit_cast(float, u); }
template <int N> HD void bitonic_sort_desc(float (&v)[N]) {
#pragma unroll
    for (int k = 2; k <= N; k <<= 1)
#pragma unroll
        for (int j = k >> 1; j > 0; j >>= 1)
#pragma unroll
            for (int i = 0; i < N; ++i) {
                const int l = i ^ j;
                if (l > i) {
                    const bool desc = ((i & k) == 0);
                    const float a = v[i], b = v[l];
                    const float mx = __builtin_fmaxf(a, b), mn = __builtin_fminf(a, b);
                    v[i] = desc ? mx : mn; v[l] = desc ? mn : mx;
                }
            }
}
template <int N> HD void bitonic_merge_desc(float (&v)[N]) {
#pragma unroll
    for (int j = N >> 1; j > 0; j >>= 1)
#pragma unroll
        for (int i = 0; i < N; ++i) {
            const int l = i ^ j;
            if (l > i) { const float a = v[i], b = v[l]; v[i] = __builtin_fmaxf(a, b); v[l] = __builtin_fminf(a, b); }
        }
}
HD void top16_merge(float (&a)[16], const float (&b)[16]) {
#pragma unroll
    for (int i = 0; i < 16; ++i) a[i] = __builtin_fmaxf(a[i], b[15 - i]);
    bitonic_merge_desc<16>(a);
}
HD void tk_local_top16(const float (&sc)[4][16], int hh, float (&out)[16]) {
    float g[4][16];
#pragma unroll
    for (int kt = 0; kt < 4; ++kt) {
#pragma unroll
        for (int reg = 0; reg < 16; ++reg) { const int key = 32 * kt + (reg & 3) + 8 * (reg >> 2) + 4 * hh; g[kt][reg] = tk_u2f((tk_f2u(sc[kt][reg]) & ~127u) | (unsigned)(127 - key)); }
        bitonic_sort_desc<16>(g[kt]);
    }
    top16_merge(g[0], g[1]); top16_merge(g[2], g[3]); top16_merge(g[0], g[2]);
#pragma unroll
    for (int i = 0; i < 16; ++i) out[i] = g[0][i];
}
constexpr int CA0[25] = {0,0,0,0,0,0,0,0,0,0,0,0,0,0,0,0,1,1,1,1,1,1,1,1,2};
constexpr int CB0[25] = {0,1,2,3,4,5,6,7,8,9,10,11,12,13,14,15,0,1,2,3,4,5,6,7,0};
constexpr int CA1[25] = {2,2,2,2,3,3,3,3,4,4,4,5,5,6,6,7,7,8,9,10,11,12,13,14,15};
constexpr int CB1[25] = {1,2,3,4,0,1,2,3,0,1,2,0,1,0,1,0,1,0,0,0,0,0,0,0,0};
HD void tk_candidates(const float (&T0)[16], const float (&T1)[16], int hh, float (&cv)[32]) {
    float t0[16], t1[16];
#pragma unroll
    for (int i = 0; i < 16; ++i) { t0[i] = tk_u2f(tk_f2u(T0[i]) & ~127u); t1[i] = tk_u2f(tk_f2u(T1[i]) & ~127u); }
#pragma unroll
    for (int j = 0; j < 25; ++j) {
        const float s0 = t0[CA0[j]] + t1[CB0[j]], s1 = t0[CA1[j]] + t1[CB1[j]];
        const unsigned c0 = 255u - (unsigned)(16 * CA0[j] + CB0[j]), c1 = 255u - (unsigned)(16 * CA1[j] + CB1[j]);
        cv[j] = tk_u2f((tk_f2u(hh ? s1 : s0) & ~255u) | (hh ? c1 : c0));
    }
#pragma unroll
    for (int j = 25; j < 32; ++j) cv[j] = -__builtin_inff();
    bitonic_sort_desc<32>(cv);
}

__device__ __forceinline__ void wave_argmax(float& v, int& i) {
#pragma unroll
    for (int o = 32; o >= 1; o >>= 1) {
        const float ov = __shfl_xor(v, o); const int oi = __shfl_xor(i, o);
        if (ov > v || (ov == v && oi < i)) { v = ov; i = oi; }
    }
}
__device__ __forceinline__ void phase_topk_naive(const Ctx& c, const float* __restrict__ Qp, const float* __restrict__ keys, int* __restrict__ eidx, float* __restrict__ gate) {
    float* qsh = (float*)(c.lds + c.wid * 1024);
    float* tv = qsh + 128;
    int* ti = (int*)(tv + 32);
    const int lane = c.lane, gw = c.bid * NWAVES + c.wid, NGW = c.G * NWAVES;
    for (int item = gw; item < NTOK * 8; item += NGW) {
        const int tok = item >> 3, h = item & 7;
        for (int p = 0; p < 2; ++p) {
            const float* q = Qp + (size_t)tok * PQ + h * 256 + p * 128;
            qsh[lane] = q[lane]; qsh[lane + 64] = q[lane + 64];
            WAVE_LDS_SYNC();
            float s[2];
#pragma unroll
            for (int i = 0; i < 2; ++i) {
                const f32x4* kr = (const f32x4*)(keys + ((size_t)(h * 2 + p) * NKEYS + lane + 64 * i) * 128);
                float a = 0.f;
                for (int cc = 0; cc < 32; ++cc) { const f32x4 kk = kr[cc]; a += qsh[4 * cc] * kk[0]; a += qsh[4 * cc + 1] * kk[1]; a += qsh[4 * cc + 2] * kk[2]; a += qsh[4 * cc + 3] * kk[3]; }
                s[i] = a;
            }
            for (int r = 0; r < 16; ++r) {
                float bv; int bi;
                if (s[0] >= s[1]) { bv = s[0]; bi = lane; } else { bv = s[1]; bi = lane + 64; }
                wave_argmax(bv, bi);
                if (bi == lane) s[0] = -INFINITY;
                if (bi == lane + 64) s[1] = -INFINITY;
                if (lane == 0) { tv[p * 16 + r] = bv; ti[p * 16 + r] = bi; }
            }
            WAVE_LDS_SYNC();
        }
        float cv[4];
#pragma unroll
        for (int j = 0; j < 4; ++j) { const int f = lane * 4 + j; cv[j] = tv[f >> 4] + tv[16 + (f & 15)]; }
        float fs = 0.f; int fp = 0;
        for (int r = 0; r < 16; ++r) {
            float bv = cv[0]; int bi = lane * 4;
#pragma unroll
            for (int j = 1; j < 4; ++j) if (cv[j] > bv) { bv = cv[j]; bi = lane * 4 + j; }
            wave_argmax(bv, bi);
#pragma unroll
            for (int j = 0; j < 4; ++j) if (bi == lane * 4 + j) cv[j] = -INFINITY;
            if (lane == r) { fs = bv; fp = bi; }
        }
        const float m = wave_max(lane < 16 ? fs : -INFINITY);
        const float e = lane < 16 ? expf(fs - m) : 0.f;
        const float sum = wave_sum(e);
        if (lane < 16) {
            const int id = ti[fp >> 4] * NKEYS + ti[16 + (fp & 15)];
            eidx[(size_t)item * 16 + lane] = id;
            gate[(size_t)item * 16 + lane] = e / sum;
        }
        WAVE_LDS_SYNC();
    }
}

__device__ __forceinline__ void phase_gather_naive(const Ctx& c, const float* __restrict__ x1, const int* __restrict__ eidx, const float* __restrict__ gate,
                                                   const float* __restrict__ U, const float* __restrict__ V, const float* __restrict__ g, const float* __restrict__ bta,
                                                   float* __restrict__ out, bf16_t* __restrict__ outb) {
    const int lane = c.lane, gw = c.bid * NWAVES + c.wid, NGW = c.G * NWAVES;
    for (int tok = gw; tok < NTOK; tok += NGW) {
        const f32x4* xr = (const f32x4*)(x1 + (size_t)tok * D);
        f32x4 xv[4], acc[4];
#pragma unroll
        for (int j = 0; j < 4; ++j) { xv[j] = xr[lane + 64 * j]; acc[j] = (f32x4){0.f, 0.f, 0.f, 0.f}; }
        for (int k = 0; k < 128; ++k) {
            const int e = eidx[(size_t)tok * 128 + k];
            const float gk = gate[(size_t)tok * 128 + k];
            const f32x4* ur = (const f32x4*)(U + (size_t)e * D);
            const f32x4* vr = (const f32x4*)(V + (size_t)e * D);
            float d = 0.f;
#pragma unroll
            for (int j = 0; j < 4; ++j) { const f32x4 uu = ur[lane + 64 * j]; d += (xv[j][0] * uu[0] + xv[j][1] * uu[1]) + (xv[j][2] * uu[2] + xv[j][3] * uu[3]); }
            d = wave_sum(d);
            const float a = 0.5f * d * (1.f + erff(d * 0.70710678118654752f)) * gk;
#pragma unroll
            for (int j = 0; j < 4; ++j) acc[j] += a * vr[lane + 64 * j];
        }
#pragma unroll
        for (int j = 0; j < 4; ++j) acc[j] = ALPHA * xv[j] + acc[j];
        ln_store_row(acc, lane, g, bta, out + (size_t)tok * D, outb + (size_t)tok * D, nullptr);
    }
}


__device__ __forceinline__ void phase_topk(const Ctx& c, const bf16_t* __restrict__ Qb, const bf16_t* __restrict__ Kb, int* __restrict__ eidx, float* __restrict__ gate) {
    LAS unsigned char* kl = (LAS unsigned char*)c.lds;
    LAS int* scr = (LAS int*)(c.lds + 65536) + c.wid * 1024;
    const int lane = c.lane, r32 = lane & 31, hh = lane >> 5;
    for (int task = c.bid; task < 8 * (NTOK / 256); task += c.G) {
        const int h = task / (NTOK / 256), tb = task % (NTOK / 256);
        __syncthreads();
#pragma unroll
        for (int i = 0; i < 8; ++i) {
            const int ch = c.tid + NTHREADS * i, row = ch >> 4, cc = ch & 15;
            const u32x4 v = *(const u32x4*)(Kb + ((size_t)(h * 256 + row) * 128 + cc * 8));
            *(LAS u32x4*)(kl + row * 256 + ((cc ^ (row & 15)) << 4)) = v;
        }
        __syncthreads();
        const int tok = tb * 256 + c.wid * 32 + r32;
        float T0[16], T1[16];
#pragma unroll
        for (int p = 0; p < 2; ++p) {
            bf16x8 bq[8];
            const bf16_t* qrow = Qb + (size_t)tok * PQ + h * 256 + p * 128 + hh * 8;
#pragma unroll
            for (int ks = 0; ks < 8; ++ks) bq[ks] = *(const bf16x8*)(qrow + 16 * ks);
            f32x16 acc[4];
#pragma unroll
            for (int kt = 0; kt < 4; ++kt)
#pragma unroll
                for (int r = 0; r < 16; ++r) acc[kt][r] = 0.f;
#pragma unroll
            for (int ks = 0; ks < 8; ++ks) {
                const int swz = ((2 * ks + hh) ^ (r32 & 15)) << 4;
#pragma unroll
                for (int kt = 0; kt < 4; ++kt) {
                    const bf16x8 a = *(const LAS bf16x8*)(kl + (p * 128 + 32 * kt + r32) * 256 + swz);
                    acc[kt] = __builtin_amdgcn_mfma_f32_32x32x16_bf16(a, bq[ks], acc[kt], 0, 0, 0);
                }
            }
            float sc[4][16], loc[16], pr[16];
#pragma unroll
            for (int kt = 0; kt < 4; ++kt)
#pragma unroll
                for (int r = 0; r < 16; ++r) sc[kt][r] = acc[kt][r];
            tk_local_top16(sc, hh, loc);
#pragma unroll
            for (int i = 0; i < 16; ++i) pr[i] = __shfl_xor(loc[i], 32);
            top16_merge(loc, pr);
            if (hh == p) {
#pragma unroll
                for (int i = 0; i < 16; ++i) scr[r32 * 32 + p * 16 + i] = 127 - (int)(tk_f2u(loc[i]) & 127u);
            }
#pragma unroll
            for (int i = 0; i < 16; ++i) { if (p == 0) T0[i] = loc[i]; else T1[i] = loc[i]; }
        }
        float cv[32], F[16], pr[16];
        tk_candidates(T0, T1, hh, cv);
#pragma unroll
        for (int i = 0; i < 16; ++i) { F[i] = cv[i]; pr[i] = __shfl_xor(cv[i], 32); }
        top16_merge(F, pr);
        WAVE_LDS_SYNC();
        const float m = tk_u2f(tk_f2u(F[0]) & ~255u);
        float e[16], sum = 0.f;
#pragma unroll
        for (int i = 0; i < 16; ++i) { e[i] = __expf(tk_u2f(tk_f2u(F[i]) & ~255u) - m); sum += e[i]; }
        const float inv = 1.f / sum;
        int ids[8]; float gs[8];
#pragma unroll
        for (int r = 0; r < 8; ++r) {
            const float fv = hh ? F[8 + r] : F[r];
            const unsigned pos = 255u - (tk_f2u(fv) & 255u);
            ids[r] = scr[r32 * 32 + (int)(pos >> 4)] * NKEYS + scr[r32 * 32 + 16 + (int)(pos & 15u)];
            gs[r] = (hh ? e[8 + r] : e[r]) * inv;
        }
        int* ep = eidx + ((size_t)tok * 8 + h) * 16 + 8 * hh; float* gp = gate + ((size_t)tok * 8 + h) * 16 + 8 * hh;
        *(int4*)ep = make_int4(ids[0], ids[1], ids[2], ids[3]); *(int4*)(ep + 4) = make_int4(ids[4], ids[5], ids[6], ids[7]);
        *(f32x4*)gp = (f32x4){gs[0], gs[1], gs[2], gs[3]}; *(f32x4*)(gp + 4) = (f32x4){gs[4], gs[5], gs[6], gs[7]};
        WAVE_LDS_SYNC();
    }
}

__device__ __forceinline__ float gelu_erf(float v) {
    const float av = fabsf(v), t = __builtin_amdgcn_rcpf(av * 0.2316418882f + 1.0f);
    float qq = t * 0.5307027145f + (-0.7265760135f); qq = qq * t + 0.7107068705f; qq = qq * t + (-0.142248368f); qq = qq * t + 0.127414796f; qq = qq * t;
    const float e = __builtin_amdgcn_exp2f((v * v) * (-0.72134752044f));
    const float m = v * (qq * e);
    return v < 0.f ? m : v - m;
}
#define SB() __builtin_amdgcn_sched_barrier(0)
__device__ __forceinline__ void axpy_row(f32x2 (&acc)[8], const u32x4 w, const float a) {
    const f32x2 aa = {a, a};
#pragma unroll
    for (int k = 0; k < 4; ++k) {
        const f32x2 lo = __builtin_amdgcn_cvt_pk_f32_fp8(w[k], false), hi = __builtin_amdgcn_cvt_pk_f32_fp8(w[k], true);
        acc[2 * k] = __builtin_elementwise_fma(lo, aa, acc[2 * k]); acc[2 * k + 1] = __builtin_elementwise_fma(hi, aa, acc[2 * k + 1]);
    }
}
__device__ __forceinline__ void phase_gather(const Ctx& c, const float* __restrict__ x1, const unsigned char* __restrict__ X8, const int* __restrict__ eidx, const float* __restrict__ gate,
                                             const unsigned char* __restrict__ U8, const unsigned char* __restrict__ V8, const float* __restrict__ g, const float* __restrict__ bta,
                                             float* __restrict__ out, bf16_t* __restrict__ outb) {
    const int gw = c.bid * NWAVES + c.wid, NGW = c.G * NWAVES;
    LAS unsigned char* xl = (LAS unsigned char*)c.lds + c.wid * 2048;
    const int lane = c.lane, q = lane >> 4, l15 = lane & 15;
    const unsigned lo16 = (unsigned)lane * 16u;
    int tok = gw;
    if (tok >= NTOK) return;
    int ev0 = eidx[(size_t)tok * 128 + lane], ev1 = eidx[(size_t)tok * 128 + 64 + lane];
    int en0, en1;
    { const int t1 = (tok + NGW < NTOK) ? tok + NGW : tok; en0 = eidx[(size_t)t1 * 128 + lane]; en1 = eidx[(size_t)t1 * 128 + 64 + lane]; }
    *(LAS u32x4*)(xl + lane * 16) = *(const u32x4*)(X8 + (size_t)tok * D + lo16);
    u32x4 bU0[8], bU1[8], bV0[8], bV1[8];
    {
        const unsigned char* ub = U8 + ((unsigned)__shfl(ev0, l15) * (unsigned)D + (unsigned)q * 16u);
#pragma unroll
        for (int t = 0; t < 8; ++t) bU0[t] = *(const u32x4*)(ub + 64 * t);
        SB();
#pragma unroll
        for (int t = 0; t < 8; ++t) bU1[t] = *(const u32x4*)(ub + 512 + 64 * t);
        SB();
#pragma unroll
        for (int i = 0; i < 8; ++i) { const int e = __builtin_amdgcn_readlane(ev0, i); bV0[i] = *(const u32x4*)(V8 + (size_t)e * D + lo16); }
        SB();
    }
    int slot = 0;
#pragma unroll 1
    for (; tok < NTOK; tok += NGW, slot ^= 1) {
        const int tokn = (tok + NGW < NTOK) ? tok + NGW : tok, tok2 = (tok + 2 * NGW < NTOK) ? tok + 2 * NGW : tok;
        const int nn0 = eidx[(size_t)tok2 * 128 + lane], nn1 = eidx[(size_t)tok2 * 128 + 64 + lane];
        const u32x4 xn = *(const u32x4*)(X8 + (size_t)tokn * D + lo16);
        const LAS unsigned char* xc = xl + slot * 1024 + q * 16;
        f32x2 acc[8];
#pragma unroll
        for (int k = 0; k < 8; ++k) acc[k] = (f32x2){0.f, 0.f};
        SB();
#pragma unroll 1
        for (int h = 0; h < 8; ++h) {
            const int evh = (h < 4) ? ev0 : ev1, lb = (h & 3) * 16;
            const bool last = (h == 7);
            const int evn = last ? en0 : ((h + 1 < 4) ? ev0 : ev1), lbn = last ? 0 : ((h + 1) & 3) * 16;
            const f32x4 gq = *(const f32x4*)(gate + (size_t)tok * 128 + h * 16 + 4 * q);
            SB();
#pragma unroll
            for (int i = 0; i < 8; ++i) { const int e = __builtin_amdgcn_readlane(evh, lb + 8 + i); bV1[i] = *(const u32x4*)(V8 + (size_t)e * D + lo16); }
            SB();
            f32x4 h4 = {0.f, 0.f, 0.f, 0.f};
#pragma unroll
            for (int t = 0; t < 8; ++t) {
                const u32x4 xb = *(const LAS u32x4*)(xc + 64 * t);
                const long alo = (long)(((unsigned long long)bU0[t][1] << 32) | bU0[t][0]), ahi = (long)(((unsigned long long)bU0[t][3] << 32) | bU0[t][2]);
                const long xlo = (long)(((unsigned long long)xb[1] << 32) | xb[0]), xhi = (long)(((unsigned long long)xb[3] << 32) | xb[2]);
                h4 = __builtin_amdgcn_mfma_f32_16x16x32_fp8_fp8(alo, xlo, h4, 0, 0, 0);
                h4 = __builtin_amdgcn_mfma_f32_16x16x32_fp8_fp8(ahi, xhi, h4, 0, 0, 0);
                if ((t & 3) == 3) SB();
            }
            const unsigned char* ubn = U8 + ((unsigned)__shfl(evn, lbn + l15) * (unsigned)D + (unsigned)q * 16u);
#pragma unroll
            for (int t = 0; t < 8; ++t) bU0[t] = *(const u32x4*)(ubn + 64 * t);
            SB();
#pragma unroll
            for (int t = 0; t < 8; ++t) {
                const u32x4 xb = *(const LAS u32x4*)(xc + 512 + 64 * t);
                const long alo = (long)(((unsigned long long)bU1[t][1] << 32) | bU1[t][0]), ahi = (long)(((unsigned long long)bU1[t][3] << 32) | bU1[t][2]);
                const long xlo = (long)(((unsigned long long)xb[1] << 32) | xb[0]), xhi = (long)(((unsigned long long)xb[3] << 32) | xb[2]);
                h4 = __builtin_amdgcn_mfma_f32_16x16x32_fp8_fp8(alo, xlo, h4, 0, 0, 0);
                h4 = __builtin_amdgcn_mfma_f32_16x16x32_fp8_fp8(ahi, xhi, h4, 0, 0, 0);
                if ((t & 3) == 3) SB();
            }
            int a4[4];
#pragma unroll
            for (int r = 0; r < 4; ++r) a4[r] = __builtin_bit_cast(int, gelu_erf(h4[r] * (1.f / (XS * US))) * gq[r] * (1.f / VS));
            SB();
#pragma unroll
            for (int t = 0; t < 8; ++t) bU1[t] = *(const u32x4*)(ubn + 512 + 64 * t);
            SB();
#pragma unroll
            for (int i = 0; i < 8; ++i) { axpy_row(acc, bV0[i], __builtin_bit_cast(float, __builtin_amdgcn_readlane(a4[i & 3], 16 * (i >> 2)))); if (i & 1) SB(); }
#pragma unroll
            for (int i = 0; i < 8; ++i) { const int e = __builtin_amdgcn_readlane(evn, lbn + i); bV0[i] = *(const u32x4*)(V8 + (size_t)e * D + lo16); }
            SB();
#pragma unroll
            for (int i = 0; i < 8; ++i) { axpy_row(acc, bV1[i], __builtin_bit_cast(float, __builtin_amdgcn_readlane(a4[i & 3], 32 + 16 * (i >> 2)))); if (i & 1) SB(); }
        }
        *(LAS u32x4*)(xl + (slot ^ 1) * 1024 + lane * 16) = xn;
        const f32x4* xr = (const f32x4*)(x1 + (size_t)tok * D) + 4 * lane;
        float sm = 0.f;
#pragma unroll
        for (int w = 0; w < 4; ++w) { const f32x4 xv = xr[w];
            acc[2 * w][0] += ALPHA * xv[0]; acc[2 * w][1] += ALPHA * xv[1]; acc[2 * w + 1][0] += ALPHA * xv[2]; acc[2 * w + 1][1] += ALPHA * xv[3];
            sm += (acc[2 * w][0] + acc[2 * w][1]) + (acc[2 * w + 1][0] + acc[2 * w + 1][1]); }
        const float mean = wave_sum(sm) * (1.f / D); float s2 = 0.f;
#pragma unroll
        for (int k = 0; k < 8; ++k) { acc[k] = acc[k] - mean; s2 += acc[k][0] * acc[k][0] + acc[k][1] * acc[k][1]; }
        const float rstd = rsqrtf(wave_sum(s2) * (1.f / D) + LN_EPS);
#pragma unroll
        for (int w = 0; w < 4; ++w) {
            const f32x4 gg = ((const f32x4*)g)[4 * lane + w], be = ((const f32x4*)bta)[4 * lane + w];
            f32x4 o;
            o[0] = acc[2 * w][0] * rstd * gg[0] + be[0]; o[1] = acc[2 * w][1] * rstd * gg[1] + be[1];
            o[2] = acc[2 * w + 1][0] * rstd * gg[2] + be[2]; o[3] = acc[2 * w + 1][1] * rstd * gg[3] + be[3];
            ((f32x4*)(out + (size_t)tok * D))[4 * lane + w] = o;
            uint2 ob; ob.x = f2bf(o[0]) | ((unsigned)f2bf(o[1]) << 16); ob.y = f2bf(o[2]) | ((unsigned)f2bf(o[3]) << 16);
            ((uint2*)(outb + (size_t)tok * D))[4 * lane + w] = ob;
        }
        ev0 = en0; ev1 = en1; en0 = nn0; en1 = nn1;
        SB();
    }
}


#define GAS __attribute__((address_space(1)))
#define XB_TMO      128
#define XB_XCNT(j)  (256  + 64 * (j))
#define XB_XSUB(j)  (1280 + 64 * (j))
#define XB_XGEN(j)  (2304 + 64 * (j))
#define XB_TOP      3328
#define XB_TOPGEN   3392
#define XCD_BAR_WORDS 3456
#define XB_SPIN_CAP (1u << 18)

__device__ __forceinline__ unsigned xb_ld(unsigned* p)              { return __hip_atomic_load(p, __ATOMIC_RELAXED, __HIP_MEMORY_SCOPE_AGENT); }
__device__ __forceinline__ unsigned xb_add(unsigned* p, unsigned v) { return __hip_atomic_fetch_add(p, v, __ATOMIC_RELAXED, __HIP_MEMORY_SCOPE_AGENT); }
__device__ __forceinline__ unsigned xb_xcc_id() { return (unsigned)__builtin_amdgcn_s_getreg((3 << 11) | 20) & 0xFu; }
#define XB_SPIN(cond, bar) do { unsigned _sp = 0; while (cond) { __builtin_amdgcn_s_sleep(1); \
    if ((++_sp & 255u) == 0u) { if (xb_ld(&(bar)[XB_TMO])) break; if (_sp > XB_SPIN_CAP) { atomicAdd(&(bar)[XB_TMO], 1u); break; } } } } while (0)

struct XcdBarrier {
    unsigned* bar; unsigned x;
    volatile LAS unsigned* st;
};

__device__ __forceinline__ XcdBarrier xcd_barrier_post(unsigned* bar, volatile LAS unsigned* st) {
    XcdBarrier b; b.bar = bar; b.x = xb_xcc_id(); b.st = st;
    if (threadIdx.x == 0) (void)xb_add(&bar[XB_XCNT(b.x)], 1u);
    return b;
}
__device__ __forceinline__ void xcd_barrier_complete(unsigned* bar, unsigned x, unsigned& nloc, unsigned& nx) {
    const unsigned G = gridDim.x * gridDim.y * gridDim.z;
    unsigned sum, cnt, mine, sp = 0u;
    for (;;) {
        sum = 0u; cnt = 0u; mine = 0u;
#pragma unroll
        for (unsigned j = 0; j < 16; ++j) { const unsigned c = xb_ld(&bar[XB_XCNT(j)]); sum += c; cnt += (c > 0u) ? 1u : 0u; mine = (j == x) ? c : mine; }
        if (sum == G) break;
        __builtin_amdgcn_s_sleep(1);
        if ((++sp & 255u) == 0u) { if (xb_ld(&bar[XB_TMO])) break; if (sp > XB_SPIN_CAP) { atomicAdd(&bar[XB_TMO], 1u); break; } }
    }
    nloc = mine > 0u ? mine : 1u; nx = cnt > 0u ? cnt : 1u;
}

__device__ __forceinline__ void xcd_barrier(const XcdBarrier& b) {
    asm volatile("s_waitcnt vmcnt(0)" ::: "memory");
    __syncthreads();
    if (threadIdx.x == 0) {
        unsigned* bar = b.bar;
        __builtin_amdgcn_s_waitcnt(0);
        unsigned nloc = b.st[0], nx = b.st[1];
        if (nloc == 0u) { xcd_barrier_complete(bar, b.x, nloc, nx); b.st[0] = nloc; b.st[1] = nx; }
        const unsigned old = xb_add(&bar[XB_XSUB(b.x)], 1u);
        const unsigned gen = old / nloc;
        if (old + 1u == (gen + 1u) * nloc) {
            __builtin_amdgcn_fence(__ATOMIC_RELEASE, "agent");
            asm volatile("s_waitcnt vmcnt(0)" ::: "memory");
            const unsigned og = xb_add(&bar[XB_TOP], 1u);
            const unsigned tg = og / nx;
            if (og + 1u == (tg + 1u) * nx) xb_add(&bar[XB_TOPGEN], 1u);
            else XB_SPIN(xb_ld(&bar[XB_TOPGEN]) == tg, bar);
            __builtin_amdgcn_fence(__ATOMIC_ACQUIRE, "agent");
            xb_add(&bar[XB_XGEN(b.x)], 1u);
            asm volatile("s_waitcnt vmcnt(0)" ::: "memory");
        } else {
            XB_SPIN(xb_ld(&bar[XB_XGEN(b.x)]) == gen, bar);
            __builtin_amdgcn_fence(__ATOMIC_ACQUIRE, "agent");
            asm volatile("s_waitcnt vmcnt(0)" ::: "memory");
        }
    }
    __syncthreads();
}

constexpr size_t MiB = 1u << 20;
constexpr size_t WS_WIN = 0;
constexpr size_t WS_WO = 20 * MiB;
constexpr size_t WS_WQ = 28 * MiB;
constexpr size_t WS_XB = 48 * MiB;
constexpr size_t WS_XA = 112 * MiB;
constexpr size_t WS_X1 = 240 * MiB;
constexpr size_t WS_H = 368 * MiB;
constexpr size_t WS_Y = 512 * MiB;
constexpr size_t WS_Z = 576 * MiB;
constexpr size_t WS_QP = 368 * MiB;
constexpr size_t WS_KB = 44 * MiB;
constexpr size_t WS_EI = 704 * MiB;
constexpr size_t WS_GT = 720 * MiB;
constexpr size_t WS_U8 = 736 * MiB;
constexpr size_t WS_V8 = 800 * MiB;
constexpr size_t WS_X8 = 864 * MiB;
constexpr size_t WS_CTL = 896 * MiB;
constexpr size_t CTL_BYTES = 16384;
constexpr size_t WS_END = 897 * MiB;

struct Params { const float* in[16]; float* out; unsigned char* ws; };

__global__ void __launch_bounds__(NTHREADS, 2) mega_fwd(Params P) {
    extern __shared__ __attribute__((aligned(16))) unsigned char lds[];
    cg::grid_group grid = cg::this_grid();
    const float* x = P.in[0]; const float* w_in = P.in[1]; const float* w_o = P.in[2]; const float* sink = P.in[3]; const float* rpb = P.in[4]; const float* t5 = P.in[5];
    const float* ga = P.in[6]; const float* gb = P.in[7]; const float* l1g = P.in[8]; const float* l1b = P.in[9]; const float* l2g = P.in[10]; const float* l2b = P.in[11];
    const float* wq = P.in[12]; const float* keys = P.in[13]; const float* pu = P.in[14]; const float* pv = P.in[15];
    unsigned char* ws = P.ws;
    bf16_t* WinT = (bf16_t*)(ws + WS_WIN); bf16_t* WoT = (bf16_t*)(ws + WS_WO); bf16_t* WqT = (bf16_t*)(ws + WS_WQ);
    bf16_t* Xb = (bf16_t*)(ws + WS_XB); float* XA = (float*)(ws + WS_XA); float* X1 = (float*)(ws + WS_X1);
    bf16_t* H = (bf16_t*)(ws + WS_H); bf16_t* Y = (bf16_t*)(ws + WS_Y); float* Z = (float*)(ws + WS_Z); bf16_t* Qb = (bf16_t*)(ws + WS_QP); bf16_t* Kb = (bf16_t*)(ws + WS_KB);
    int* EI = (int*)(ws + WS_EI); float* GT = (float*)(ws + WS_GT);
    unsigned char* U8 = ws + WS_U8; unsigned char* V8 = ws + WS_V8; unsigned char* X8 = ws + WS_X8;

    volatile LAS unsigned* MISC = (volatile LAS unsigned*)((LAS unsigned char*)lds + (LDS_BYTES - 256));
    if (threadIdx.x < 4) MISC[threadIdx.x] = 0u;
    __syncthreads();
    const XcdBarrier bar = xcd_barrier_post((unsigned*)(ws + WS_CTL), MISC);
#define GRID_BAR() xcd_barrier(bar)
    phase_convert(make_ctx(lds), w_in, w_o, wq, x, pu, pv, WinT, WoT, WqT, Xb, U8, V8, keys, Kb);
    grid.sync();
#pragma unroll 1
    for (int l = 0; l < DEPTH; ++l) {
        const float* xin = (l == 0) ? x : XA;
        float* xout = (l == DEPTH - 1) ? P.out : XA;
        phase_gemm<pg8::EpiBf16<0>, true>(lds, Xb, WinT + (size_t)l * PROJ * D, PROJ, pg8::EpiBf16<0>{H, PROJ, nullptr, 0, 0, 1.f});
        GRID_BAR();
        phase_attn(make_ctx(lds), H, sink + l * 8, t5, rpb + (size_t)l * 8 * 15 * 31, Z);
        GRID_BAR();
        phase_rmsnorm(make_ctx(lds), Z, ga + l * 512, gb + l * 512, Y);
        GRID_BAR();
        phase_gemm<EpiZf32, true>(lds, Y, WoT + (size_t)l * D * D, D, EpiZf32{xin, Z});
        GRID_BAR();
        phase_ln(make_ctx(lds), Z, l1g + l * D, l1b + l * D, X1, Xb, X8);
        GRID_BAR();
        phase_gemm<pg8::EpiBf16<0>, true>(lds, Xb, WqT + (size_t)l * PQ * D, PQ, pg8::EpiBf16<0>{Qb, PQ, nullptr, 0, 0, 1.f});
        GRID_BAR();
        phase_topk(make_ctx(lds), Qb, Kb + (size_t)l * 8 * 2 * NKEYS * 128, EI, GT);
        GRID_BAR();
        phase_gather(make_ctx(lds), X1, X8, EI, GT, U8 + (size_t)l * NEXP * D, V8 + (size_t)l * NEXP * D, l2g + l * D, l2b + l * D, xout, Xb);
        if (l < DEPTH - 1) GRID_BAR();
    }
}

extern "C" void kernel_launch(void* const* d_in, const int* in_sizes, int n_in, void* d_out, int out_size, void* d_ws, size_t ws_size, hipStream_t stream) {
    static int grid = 0;
    if (grid == 0) {
        if (n_in != 16 || ws_size < WS_END || out_size != NTOK * D) { fprintf(stderr, "kernel_launch: unexpected shapes\n"); grid = -1; return; }
        int dev = 0, cus = 0, per_cu = 0;
        hipGetDevice(&dev);
        hipDeviceGetAttribute(&cus, hipDeviceAttributeMultiprocessorCount, dev);
        hipFuncSetAttribute((const void*)mega_fwd, hipFuncAttributeMaxDynamicSharedMemorySize, LDS_BYTES);
        hipOccupancyMaxActiveBlocksPerMultiprocessor(&per_cu, (const void*)mega_fwd, NTHREADS, LDS_BYTES);
        if (per_cu < 1) { fprintf(stderr, "kernel_launch: occupancy query says %d blocks/CU\n", per_cu); grid = -1; return; }
        grid = cus;
    }
    if (grid < 0) return;
    if (hipMemsetAsync((char*)d_ws + WS_CTL, 0, CTL_BYTES, stream) != hipSuccess) { fprintf(stderr, "kernel_launch: memset of the barrier words failed\n"); return; }
    Params P{};
    for (int i = 0; i < 16; ++i) P.in[i] = (const float*)d_in[i];
    P.out = (float*)d_out; P.ws = (unsigned char*)d_ws;
    void* args[] = {&P};
    hipError_t e = hipLaunchCooperativeKernel((const void*)mega_fwd, dim3(grid), dim3(NTHREADS), args, LDS_BYTES, stream);
    if (e != hipSuccess) fprintf(stderr, "cooperative launch failed: %s (grid %d)\n", hipGetErrorString(e), grid);
}
```

```cpp
#include <hip/hip_runtime.h>
#include <hip/hip_cooperative_groups.h>
#include <stdint.h>
#include <cstdio>
namespace cg = cooperative_groups;

typedef unsigned short bf16_t;
typedef short bf16x8 __attribute__((ext_vector_type(8)));
typedef float f32x4 __attribute__((ext_vector_type(4)));

constexpr int D = 1024, BATCH = 8, SEQ = 4096, DEPTH = 4, NTOK = BATCH * SEQ;
constexpr int HD = 64, PROJ = 2304;
constexpr int O1 = 512, O2 = 640, O3 = 768, O4 = 1280, O5 = 1792;
constexpr int PQ = 2048, NKEYS = 128, NEXP = 16384, TOPK = 16;
constexpr float LN_EPS = 1e-5f;
constexpr float NEGF = -1e30f;
constexpr float ALPHA = 1.6817928305074290f;

__device__ __forceinline__ bf16_t f2bf(float f) { unsigned u = __float_as_uint(f); return (bf16_t)((u + 0x7fffu + ((u >> 16) & 1u)) >> 16); }
__device__ __forceinline__ float bf2f(bf16_t h) { return __uint_as_float(((unsigned)h) << 16); }
__device__ __forceinline__ float wave_sum(float v) {
#pragma unroll
    for (int o = 1; o < 64; o <<= 1) v += __shfl_xor(v, o);
    return v;
}
__device__ __forceinline__ float wave_max(float v) {
#pragma unroll
    for (int o = 1; o < 64; o <<= 1) v = fmaxf(v, __shfl_xor(v, o));
    return v;
}


#define LAS __attribute__((address_space(3)))
typedef float f32x2 __attribute__((ext_vector_type(2)));
typedef unsigned u32x4 __attribute__((ext_vector_type(4)));
typedef unsigned u32x2 __attribute__((ext_vector_type(2)));
typedef float f32x16 __attribute__((ext_vector_type(16)));
constexpr float XS = 8.f, US = 64.f, VS = 16.f;
__device__ __forceinline__ unsigned pack4_fp8(f32x4 v, float sc) {
    v = v * sc;
#pragma unroll
    for (int i = 0; i < 4; ++i) v[i] = fminf(fmaxf(v[i], -448.f), 448.f);
    unsigned p = 0;
    p = __builtin_amdgcn_cvt_pk_fp8_f32(v[0], v[1], p, false);
    p = __builtin_amdgcn_cvt_pk_fp8_f32(v[2], v[3], p, true);
    return p;
}
constexpr int NTHREADS = 512, NWAVES = 8;
constexpr int LDS_BYTES = 147456;

struct Ctx { int tid, lane, wid, bid, G; unsigned char* lds; };
__device__ __forceinline__ Ctx make_ctx(unsigned char* lds) {
    Ctx c; int t = threadIdx.x; asm volatile("" : "+v"(t));
    c.tid = t; c.lane = t & 63; c.wid = __builtin_amdgcn_readfirstlane(t >> 6); c.bid = blockIdx.x; c.G = gridDim.x; c.lds = lds; return c;
}

__device__ __forceinline__ void transpose_item(const float* __restrict__ W, int K, int N, bf16_t* __restrict__ WT, float* scr, int item, int lane) {
    const int nblk = N / 32, kb = item / nblk, nb = item % nblk, k0 = 64 * kb, n0 = 32 * nb;
#pragma unroll 8
    for (int i = 0; i < 32; ++i) { const int kk = 2 * i + (lane >> 5); scr[kk * 33 + (lane & 31)] = W[(size_t)(k0 + kk) * N + n0 + (lane & 31)]; }
    __builtin_amdgcn_fence(__ATOMIC_RELEASE, "wavefront"); __builtin_amdgcn_wave_barrier(); __builtin_amdgcn_fence(__ATOMIC_ACQUIRE, "wavefront");
    const int c = lane & 7;
#pragma unroll
    for (int j = 0; j < 4; ++j) {
        const int n = (lane >> 3) + 8 * j; const float* sp = scr + (8 * c) * 33 + n;
        uint4 o;
        o.x = f2bf(sp[0 * 33]) | ((unsigned)f2bf(sp[1 * 33]) << 16); o.y = f2bf(sp[2 * 33]) | ((unsigned)f2bf(sp[3 * 33]) << 16);
        o.z = f2bf(sp[4 * 33]) | ((unsigned)f2bf(sp[5 * 33]) << 16); o.w = f2bf(sp[6 * 33]) | ((unsigned)f2bf(sp[7 * 33]) << 16);
        *(uint4*)(WT + (size_t)(n0 + n) * K + k0 + 8 * c) = o;
    }
    __builtin_amdgcn_fence(__ATOMIC_RELEASE, "wavefront"); __builtin_amdgcn_wave_barrier(); __builtin_amdgcn_fence(__ATOMIC_ACQUIRE, "wavefront");
}
__device__ __forceinline__ void phase_convert(const Ctx& c, const float* w_in, const float* w_o, const float* wq, const float* x, const float* pu, const float* pv,
                                              bf16_t* WinT, bf16_t* WoT, bf16_t* WqT, bf16_t* Xb, unsigned char* U8, unsigned char* V8, const float* keys, bf16_t* Kb) {
    float* scr = (float*)(c.lds + c.wid * 16384);
    const int gw = c.bid * NWAVES + c.wid, NGW = c.G * NWAVES;
    constexpr int I_IN = (D / 64) * (PROJ / 32), I_O = (D / 64) * (D / 32), I_Q = (D / 64) * (PQ / 32);
    constexpr int NIT = DEPTH * (I_IN + I_O + I_Q);
    for (int it = gw; it < NIT; it += NGW) {
        const int l = it / (I_IN + I_O + I_Q); int r = it % (I_IN + I_O + I_Q);
        if (r < I_IN) { transpose_item(w_in + (size_t)l * D * PROJ, D, PROJ, WinT + (size_t)l * PROJ * D, scr, r, c.lane); continue; } r -= I_IN;
        if (r < I_O) { transpose_item(w_o + (size_t)l * D * D, D, D, WoT + (size_t)l * D * D, scr, r, c.lane); continue; } r -= I_O;
        transpose_item(wq + (size_t)l * D * PQ, D, PQ, WqT + (size_t)l * PQ * D, scr, r, c.lane);
    }
    const size_t n4 = (size_t)NTOK * D / 4;
    for (size_t i = (size_t)c.bid * NTHREADS + c.tid; i < n4; i += (size_t)c.G * NTHREADS) {
        const f32x4 v = ((const f32x4*)x)[i];
        uint2 o; o.x = f2bf(v[0]) | ((unsigned)f2bf(v[1]) << 16); o.y = f2bf(v[2]) | ((unsigned)f2bf(v[3]) << 16);
        ((uint2*)Xb)[i] = o;
    }
    {
        const size_t k4 = (size_t)DEPTH * 8 * 2 * NKEYS * 128 / 4;
        for (size_t i = (size_t)c.bid * NTHREADS + c.tid; i < k4; i += (size_t)c.G * NTHREADS) {
            const f32x4 v = ((const f32x4*)keys)[i];
            uint2 o; o.x = f2bf(v[0]) | ((unsigned)f2bf(v[1]) << 16); o.y = f2bf(v[2]) | ((unsigned)f2bf(v[3]) << 16);
            ((uint2*)Kb)[i] = o;
        }
    }
    const size_t n32 = (size_t)DEPTH * NEXP * D / 32;
    for (size_t i = (size_t)c.bid * NTHREADS + c.tid; i < n32; i += (size_t)c.G * NTHREADS) {
        const f32x4* pa = (const f32x4*)pu + 8 * i; const f32x4* pb = (const f32x4*)pv + 8 * i;
        uint4 oa, ob0, ob1;
        unsigned wa[4];
#pragma unroll
        for (int k = 0; k < 4; ++k) {
            f32x4 a0 = pa[2 * k] * US, a1 = pa[2 * k + 1] * US;
#pragma unroll
            for (int e = 0; e < 4; ++e) { a0[e] = fminf(fmaxf(a0[e], -6.f), 6.f); a1[e] = fminf(fmaxf(a1[e], -6.f), 6.f); }
            unsigned p = 0;
            p = __builtin_amdgcn_cvt_scalef32_pk_fp4_f32(p, a0[0], a0[1], 1.0f, 0);
            p = __builtin_amdgcn_cvt_scalef32_pk_fp4_f32(p, a0[2], a0[3], 1.0f, 1);
            p = __builtin_amdgcn_cvt_scalef32_pk_fp4_f32(p, a1[0], a1[1], 1.0f, 2);
            p = __builtin_amdgcn_cvt_scalef32_pk_fp4_f32(p, a1[2], a1[3], 1.0f, 3);
            wa[k] = p;
        }
        oa.x = wa[0]; oa.y = wa[1]; oa.z = wa[2]; oa.w = wa[3];
        ob0.x = pack4_fp8(pb[0], VS); ob0.y = pack4_fp8(pb[1], VS); ob0.z = pack4_fp8(pb[2], VS); ob0.w = pack4_fp8(pb[3], VS);
        ob1.x = pack4_fp8(pb[4], VS); ob1.y = pack4_fp8(pb[5], VS); ob1.z = pack4_fp8(pb[6], VS); ob1.w = pack4_fp8(pb[7], VS);
        ((uint4*)U8)[i] = oa; ((uint4*)V8)[2 * i] = ob0; ((uint4*)V8)[2 * i + 1] = ob1;
    }
}


namespace pg8 {
#define PG8_LAS __attribute__((address_space(3)))
typedef unsigned short bf16_t;
typedef short bf16x8 __attribute__((ext_vector_type(8)));
typedef float f32x4 __attribute__((ext_vector_type(4)));
typedef unsigned u32x4 __attribute__((ext_vector_type(4)));
constexpr int BM = 256, BK = 64, HALF = 128, HTB = HALF * BK * 2  , STAGE_BYTES = 8 * HTB, NXCD = 8, WGM = 8;

__host__ __device__ __forceinline__ int lds_byte(int r, int c) { const int st = (r >> 4) * 2 + (c >> 5), rr = r & 15, cc = c & 31, ob = rr * 64 + cc * 2; return st * 1024 + (ob ^ (((ob >> 9) & 1) << 5)); }
__host__ __device__ __forceinline__ void stage_rc(int b, int& R, int& C) { const int st = b / 1024, sb = b % 1024, swz = sb ^ (((sb >> 9) & 1) << 5); R = (st >> 1) * 16 + swz / 64; C = (st & 1) * 32 + (swz % 64) / 2; }
__host__ __device__ __forceinline__ int perm32(int rho) { const int n = rho >> 4, i = rho & 15; return 8 * (i >> 2) + 4 * n + (i & 3); }

struct Unit { int pm, pn; };
struct Gemm { const bf16_t* A; const bf16_t* Bt; int M, N, K; };

struct StaticOrder {
    int nM, nN, nwg, G, c;
    __host__ __device__ void init(int M, int N, int G_, int c_) { nM = M / BM; nN = N / BM; nwg = nM * nN; G = G_; c = c_; }
    __host__ __device__ bool next(int i, Unit& u) const {
        const long L = (long)i * G + c; if (L >= nwg) return false;
        int wgid = (int)L; { const int q = nwg / NXCD, r = nwg % NXCD, xcd = wgid % NXCD, off = wgid / NXCD; wgid = (xcd < r ? xcd * (q + 1) : r * (q + 1) + (xcd - r) * q) + off; }
        const int nig = WGM * nN, gid = wgid / nig, fm = gid * WGM, gsz = (nM - fm) < WGM ? (nM - fm) : WGM;
        u.pm = fm + ((wgid % nig) % gsz); u.pn = (wgid % nig) / gsz; return true;
    }
    __device__ __forceinline__ void a_ready(const Unit&) const {}
    __device__ __forceinline__ void done(const Unit&) const {}
};

__device__ __forceinline__ unsigned cvt_pk_bf16(float lo, float hi) { unsigned r; asm volatile("v_cvt_pk_bf16_f32 %0, %1, %2" : "=v"(r) : "v"(lo), "v"(hi)); return r; }
typedef float f32x2 __attribute__((ext_vector_type(2)));
__device__ __forceinline__ f32x2 gelu_pk(f32x2 v) {
    const f32x2 av = __builtin_elementwise_abs(v), d = av * 0.2316418882f + 1.0f;
    f32x2 t; t.x = __builtin_amdgcn_rcpf(d.x); t.y = __builtin_amdgcn_rcpf(d.y);
    f32x2 q = t * 0.5307027145f + (-0.7265760135f); q = q * t + 0.7107068705f; q = q * t + (-0.142248368f); q = q * t + 0.127414796f; q = q * t;
    const f32x2 s = (v * v) * (-0.72134752044f);
    f32x2 e; e.x = __builtin_amdgcn_exp2f(s.x); e.y = __builtin_amdgcn_exp2f(s.y);
    const f32x2 m = v * (q * e), r = v - m;
    f32x2 o; o.x = v.x < 0.f ? m.x : r.x; o.y = v.y < 0.f ? m.y : r.y; return o;
}

template <int ACT  > struct EpiBf16 {
    static constexpr bool PERM = true, AFTER_DRAIN = false; static_assert(ACT == 0 || ACT == 1, "EpiBf16: ACT is 0 (none) or 1 (gelu_pk)");
    bf16_t* O; int ldc; const float* bias; int split_cols; size_t split_stride; float scale0;
    __device__ __forceinline__ void operator()(const f32x4 (&acc)[2][2][4][2], const Unit& u, int wr, int wc, int fr, int fq) const {
        const int row0 = u.pm * BM + wr * 64 + fr; int colt = u.pn * BM; bf16_t* base = O;
        float sc = 1.f; if (split_cols) { const int t = colt / split_cols; base += (size_t)t * split_stride; colt -= t * split_cols; if (t == 0) sc = scale0; }
        const int col0 = colt + wc * 32 + 8 * fq, bcol0 = u.pn * BM + wc * 32 + 8 * fq;
        f32x4 bv[2][2];
#pragma unroll
        for (int bj = 0; bj < 2; ++bj)
#pragma unroll
            for (int n = 0; n < 2; ++n) bv[bj][n] = bias ? *(const f32x4*)(bias + bcol0 + bj * HALF + 4 * n) : (f32x4){0.f, 0.f, 0.f, 0.f};
#pragma unroll
        for (int ai = 0; ai < 2; ++ai)
#pragma unroll
            for (int m = 0; m < 4; ++m) { bf16_t* rowp = base + (size_t)(row0 + ai * HALF + m * 16) * ldc + col0;
#pragma unroll
                for (int bj = 0; bj < 2; ++bj) { f32x4 v0 = acc[ai][bj][m][0] + bv[bj][0], v1 = acc[ai][bj][m][1] + bv[bj][1];
                    if (ACT == 1) { f32x2 a = gelu_pk((f32x2){v0[0], v0[1]}), b = gelu_pk((f32x2){v0[2], v0[3]}), c = gelu_pk((f32x2){v1[0], v1[1]}), d = gelu_pk((f32x2){v1[2], v1[3]});
                        v0 = (f32x4){a.x, a.y, b.x, b.y}; v1 = (f32x4){c.x, c.y, d.x, d.y}; }
                    v0 = v0 * sc; v1 = v1 * sc; u32x4 w; w.x = cvt_pk_bf16(v0[0], v0[1]); w.y = cvt_pk_bf16(v0[2], v0[3]); w.z = cvt_pk_bf16(v1[0], v1[1]); w.w = cvt_pk_bf16(v1[2], v1[3]);
                    *(u32x4*)(rowp + bj * HALF) = w; } }
    }
};

template <class Epi, class Sched, bool ALIGN_EPI = false, bool SP2 = false>
__device__ __forceinline__ void gemm_phase(PG8_LAS unsigned char* lds, const Gemm g, const Sched& S, const Epi& E) {
    int tid = threadIdx.x; asm volatile("" : "+v"(tid));
    const int wid = __builtin_amdgcn_readfirstlane(tid >> 6), lane = tid & 63, wr = wid >> 2, wc = wid & 3, fr = lane & 15, fq = lane >> 4;
    const int K = g.K, nt = K / BK;
    unsigned voffA[2], voffB[2];
#pragma unroll
    for (int i = 0; i < 2; ++i) { int R, C; stage_rc(tid * 16 + i * 8192, R, C); const int Rb = Epi::PERM ? ((R & ~31) + perm32(R & 31)) : R;
        voffA[i] = (unsigned)(R * K + C) * 2u; voffB[i] = (unsigned)(Rb * K + C) * 2u; }
    const size_t kstep = (size_t)(BK * 2);
    const size_t hstep = (size_t)HALF * K * 2;
    const size_t tstep = 2 * hstep;
    const unsigned ldsw = (unsigned)wid * 1024u;
    const int aoff = lds_byte(wr * 64 + fr, fq * 8), boff = lds_byte(wc * 32 + fr, fq * 8);
#define PG8_SA(b, h) (((b) * 2 + (h)) * HTB)
#define PG8_SB(b, h) ((4 + (b) * 2 + (h)) * HTB)
#define PG8_STAGE(bufoff, gbase, voff) do { _Pragma("unroll") for (int _i = 0; _i < 2; ++_i) \
        __builtin_amdgcn_global_load_lds((const unsigned*)((const char*)(gbase) + (voff)[_i]), (PG8_LAS unsigned*)(lds + (bufoff) + ldsw + _i * 8192), 16, 0, 0); } while (0)
#define PG8_LDA(dst, b, h) do { _Pragma("unroll") for (int m = 0; m < 4; ++m) _Pragma("unroll") for (int k = 0; k < 2; ++k) dst[m][k] = *(const PG8_LAS bf16x8*)(lds + PG8_SA(b, h) + aoff + m * 2048 + k * 1024); } while (0)
#define PG8_LDB(dst, b, h) do { _Pragma("unroll") for (int n = 0; n < 2; ++n) _Pragma("unroll") for (int k = 0; k < 2; ++k) dst[n][k] = *(const PG8_LAS bf16x8*)(lds + PG8_SB(b, h) + boff + n * 2048 + k * 1024); } while (0)
#define PG8_MMA(ai, bj, At, Bt) do { __builtin_amdgcn_s_setprio(1); _Pragma("unroll") for (int m = 0; m < 4; ++m) _Pragma("unroll") for (int n = 0; n < 2; ++n) _Pragma("unroll") for (int k = 0; k < 2; ++k) \
        acc[ai][bj][m][n] = __builtin_amdgcn_mfma_f32_16x16x32_bf16(Bt[n][k], At[m][k], acc[ai][bj][m][n], 0, 0, 0); __builtin_amdgcn_s_setprio(0); } while (0)
#define PG8_WAIT_V(n) asm volatile("s_waitcnt vmcnt(" #n ")" ::: "memory")
#define PG8_WAIT_L(n) asm volatile("s_waitcnt lgkmcnt(" #n ")" ::: "memory")
#define PG8_BAR __builtin_amdgcn_s_barrier()
#define PG8_SCHED __builtin_amdgcn_sched_barrier(0)
    Unit cur, nxt; int ui = 0;
    if (!S.next(0, cur)) return;
    f32x4 acc[2][2][4][2];
#pragma unroll
    for (int a = 0; a < 2; ++a)
#pragma unroll
        for (int b = 0; b < 2; ++b)
#pragma unroll
            for (int m = 0; m < 4; ++m)
#pragma unroll
                for (int n = 0; n < 2; ++n) acc[a][b][m][n] = (f32x4){0.f, 0.f, 0.f, 0.f};
    bf16x8 At[4][2], B0[2][2], B1[2][2];
    const char* cA = (const char*)g.A + (size_t)cur.pm * tstep; const char* cB = (const char*)g.Bt + (size_t)cur.pn * tstep;
    S.a_ready(cur);
    if constexpr (SP2) {
        PG8_STAGE(PG8_SB(0, 0), cB, voffB); PG8_STAGE(PG8_SB(0, 1), cB + hstep, voffB); PG8_STAGE(PG8_SA(0, 0), cA, voffA); PG8_STAGE(PG8_SA(0, 1), cA + hstep, voffA);
        if (wr == 1) PG8_BAR;
        PG8_WAIT_V(2); PG8_BAR;
        PG8_STAGE(PG8_SB(1, 0), cB + kstep, voffB); PG8_STAGE(PG8_SA(1, 0), cA + kstep, voffA); PG8_STAGE(PG8_SB(1, 1), cB + hstep + kstep, voffB);
        PG8_WAIT_V(6); PG8_BAR;
    } else {
        PG8_STAGE(PG8_SB(0, 0), cB, voffB); PG8_STAGE(PG8_SA(0, 0), cA, voffA); PG8_STAGE(PG8_SB(0, 1), cB + hstep, voffB); PG8_STAGE(PG8_SA(0, 1), cA + hstep, voffA);
        if (wr == 1) PG8_BAR;
        PG8_WAIT_V(4); PG8_BAR;
        PG8_STAGE(PG8_SB(1, 0), cB + kstep, voffB); PG8_STAGE(PG8_SA(1, 0), cA + kstep, voffA); PG8_STAGE(PG8_SB(1, 1), cB + hstep + kstep, voffB);
        PG8_WAIT_V(6); PG8_BAR;
    }
    for (;;) {
        const bool has_next = S.next(ui + 1, nxt);
        const char* nA = has_next ? (const char*)g.A + (size_t)nxt.pm * tstep : cA; const char* nB = has_next ? (const char*)g.Bt + (size_t)nxt.pn * tstep : cB;
        for (int t = 0; t < nt; t += 2) {
            const bool last = (t == nt - 2);
            const char* a1 = cA + (size_t)(t + 1) * kstep;
            const char* a2 = last ? nA : cA + (size_t)(t + 2) * kstep; const char* b2 = last ? nB : cB + (size_t)(t + 2) * kstep;
            const char* a3 = a2 + kstep; const char* b3 = b2 + kstep;
            if (last && has_next) S.a_ready(nxt);
            if constexpr (SP2) {
            PG8_LDB(B0, 0, 0); PG8_LDB(B1, 0, 1); PG8_SCHED; PG8_LDA(At, 0, 0); PG8_STAGE(PG8_SA(1, 1), a1 + hstep, voffA);
            PG8_WAIT_V(8); PG8_WAIT_L(0); PG8_BAR; PG8_MMA(0, 0, At, B0); PG8_MMA(0, 1, At, B1); PG8_BAR; PG8_SCHED;
            PG8_LDA(At, 0, 1); PG8_STAGE(PG8_SB(0, 0), b2, voffB); PG8_STAGE(PG8_SB(0, 1), b2 + hstep, voffB); PG8_STAGE(PG8_SA(0, 0), a2, voffA);
            PG8_WAIT_V(8); PG8_WAIT_L(0); PG8_BAR; PG8_MMA(1, 0, At, B0); PG8_MMA(1, 1, At, B1); PG8_BAR; PG8_SCHED;
            PG8_LDB(B0, 1, 0); PG8_LDB(B1, 1, 1); PG8_SCHED; PG8_LDA(At, 1, 0); PG8_STAGE(PG8_SA(0, 1), a2 + hstep, voffA);
            PG8_WAIT_V(8); PG8_WAIT_L(0); PG8_BAR; PG8_MMA(0, 0, At, B0); PG8_MMA(0, 1, At, B1); PG8_BAR; PG8_SCHED;
            PG8_LDA(At, 1, 1); PG8_STAGE(PG8_SB(1, 0), b3, voffB); PG8_STAGE(PG8_SB(1, 1), b3 + hstep, voffB); PG8_STAGE(PG8_SA(1, 0), a3, voffA);
            PG8_WAIT_V(8); PG8_WAIT_L(0); PG8_BAR; PG8_MMA(1, 0, At, B0); PG8_MMA(1, 1, At, B1); PG8_BAR; PG8_SCHED;
            } else {
            PG8_LDB(B0, 0, 0); PG8_SCHED; PG8_LDA(At, 0, 0); PG8_STAGE(PG8_SA(1, 1), a1 + hstep, voffA);
            PG8_WAIT_L(8); PG8_BAR; PG8_WAIT_L(0); PG8_MMA(0, 0, At, B0); PG8_BAR; PG8_SCHED;
            PG8_LDB(B1, 0, 1); PG8_STAGE(PG8_SB(0, 0), b2, voffB);
            PG8_BAR; PG8_WAIT_L(0); PG8_MMA(0, 1, At, B1); PG8_BAR;
            PG8_LDA(At, 0, 1); PG8_STAGE(PG8_SA(0, 0), a2, voffA);
            PG8_BAR; PG8_WAIT_L(0); PG8_MMA(1, 0, At, B0); PG8_BAR; PG8_SCHED;
            PG8_STAGE(PG8_SB(0, 1), b2 + hstep, voffB);
            PG8_WAIT_V(6); PG8_BAR; PG8_MMA(1, 1, At, B1); PG8_BAR;
            PG8_LDB(B0, 1, 0); PG8_SCHED; PG8_LDA(At, 1, 0); PG8_STAGE(PG8_SA(0, 1), a2 + hstep, voffA);
            PG8_WAIT_L(8); PG8_BAR; PG8_WAIT_L(0); PG8_MMA(0, 0, At, B0); PG8_BAR; PG8_SCHED;
            PG8_LDB(B1, 1, 1); PG8_STAGE(PG8_SB(1, 0), b3, voffB);
            PG8_BAR; PG8_WAIT_L(0); PG8_MMA(0, 1, At, B1); PG8_BAR;
            PG8_LDA(At, 1, 1); PG8_STAGE(PG8_SA(1, 0), a3, voffA);
            PG8_BAR; PG8_WAIT_L(0); PG8_MMA(1, 0, At, B0); PG8_BAR; PG8_SCHED;
            PG8_STAGE(PG8_SB(1, 1), b3 + hstep, voffB);
            PG8_WAIT_V(6); PG8_BAR; PG8_MMA(1, 1, At, B1); PG8_BAR;
            }
        }
        if constexpr (ALIGN_EPI) { if (wr == 0) PG8_BAR; }
        if constexpr (!Epi::AFTER_DRAIN) { E(acc, cur, wr, wc, fr, fq); S.done(cur); }
        if (!has_next) break;
#pragma unroll
        for (int a = 0; a < 2; ++a)
#pragma unroll
            for (int b = 0; b < 2; ++b)
#pragma unroll
                for (int m = 0; m < 4; ++m)
#pragma unroll
                    for (int n = 0; n < 2; ++n) acc[a][b][m][n] = (f32x4){0.f, 0.f, 0.f, 0.f};
        cur = nxt; cA = nA; cB = nB; ++ui;
        if constexpr (ALIGN_EPI) { if (wr == 1) PG8_BAR; }
    }
    PG8_WAIT_V(0);
    if constexpr (!ALIGN_EPI) { if (wr == 0) PG8_BAR; }
    PG8_BAR;
    if constexpr (Epi::AFTER_DRAIN) { E.fused(acc, cur, wr, wc, fr, fq, lds, wid, lane); S.done(cur); }
#undef PG8_SA
#undef PG8_SB
#undef PG8_STAGE
#undef PG8_LDA
#undef PG8_LDB
#undef PG8_MMA
#undef PG8_WAIT_V
#undef PG8_WAIT_L
#undef PG8_BAR
#undef PG8_SCHED
}
}
struct EpiZf32 {
    static constexpr bool PERM = false, AFTER_DRAIN = false;
    const float* x; float* Z;
    __device__ __forceinline__ void operator()(const pg8::f32x4 (&acc)[2][2][4][2], const pg8::Unit& u, int wr, int wc, int fr, int fq) const {
#pragma unroll
        for (int ai = 0; ai < 2; ++ai)
#pragma unroll
            for (int m = 0; m < 4; ++m) {
                const size_t rowoff = (size_t)(u.pm * 256 + ai * 128 + wr * 64 + m * 16 + fr) * D + u.pn * 256 + wc * 32 + 4 * fq;
#pragma unroll
                for (int bj = 0; bj < 2; ++bj)
#pragma unroll
                    for (int n = 0; n < 2; ++n) {
                        const size_t i = rowoff + bj * 128 + n * 16;
                        const pg8::f32x4 xv = *(const pg8::f32x4*)(x + i);
                        *(pg8::f32x4*)(Z + i) = xv * ALPHA + acc[ai][bj][m][n];
                    }
            }
    }
};
template <class Epi, bool ALIGN>
__device__ __forceinline__ void phase_gemm(unsigned char* lds, const bf16_t* A, const bf16_t* Bt, int N, const Epi& E) {
    pg8::Gemm g{A, Bt, NTOK, N, D};
    pg8::StaticOrder S; S.init(NTOK, N, (int)gridDim.x, (int)blockIdx.x);
    pg8::gemm_phase<Epi, pg8::StaticOrder, ALIGN, true>((PG8_LAS unsigned char*)lds, g, S, E);
}

struct EpiH { bf16_t* H; __device__ void operator()(int r, int c, float v) const { H[(size_t)r * PROJ + c] = f2bf(v); } };
struct EpiZ { const float* x; float* Z; __device__ void operator()(int r, int c, float v) const { size_t i = (size_t)r * D + c; Z[i] = ALPHA * x[i] + v; } };
struct EpiQ { bf16_t* Q; __device__ void operator()(int r, int c, float v) const { Q[(size_t)r * PQ + c] = f2bf(v); } };

template <class Epi, int N, int K>
__device__ __forceinline__ void phase_gemm_simple(const Ctx& c, const bf16_t* __restrict__ A, const bf16_t* __restrict__ Bt, Epi epi) {
    const int half = c.tid >> 8, tid = c.tid & 255, lane = c.lane, wid = tid >> 6, wm = wid >> 1, wn = wid & 1;
    bf16_t* sA = (bf16_t*)(c.lds + half * 20480);
    bf16_t* sB = sA + 128 * 40;
    constexpr int nN = N / 128, NT = (NTOK / 128) * nN;
    for (int t0 = c.bid * 2; t0 < NT; t0 += c.G * 2) {
        const int t = t0 + half; const bool live = t < NT;
        const int bm = (t / nN) * 128, bn = (t % nN) * 128;
        f32x4 acc[4][4];
#pragma unroll
        for (int i = 0; i < 4; ++i)
#pragma unroll
            for (int j = 0; j < 4; ++j) acc[i][j] = (f32x4){0.f, 0.f, 0.f, 0.f};
        for (int k0 = 0; k0 < K; k0 += 32) {
            if (live) {
#pragma unroll
                for (int i = 0; i < 2; ++i) {
                    const int ch = tid + i * 256, r = ch >> 2, cc = (ch & 3) * 8;
                    *(uint4*)&sA[r * 40 + cc] = *(const uint4*)&A[(size_t)(bm + r) * K + k0 + cc];
                    *(uint4*)&sB[r * 40 + cc] = *(const uint4*)&Bt[(size_t)(bn + r) * K + k0 + cc];
                }
            }
            __syncthreads();
            bf16x8 a[4], b[4];
#pragma unroll
            for (int i = 0; i < 4; ++i) {
                a[i] = *(const bf16x8*)&sA[(wm * 64 + i * 16 + (lane & 15)) * 40 + (lane >> 4) * 8];
                b[i] = *(const bf16x8*)&sB[(wn * 64 + i * 16 + (lane & 15)) * 40 + (lane >> 4) * 8];
            }
#pragma unroll
            for (int i = 0; i < 4; ++i)
#pragma unroll
                for (int j = 0; j < 4; ++j) acc[i][j] = __builtin_amdgcn_mfma_f32_16x16x32_bf16(a[i], b[j], acc[i][j], 0, 0, 0);
            __syncthreads();
        }
        if (live) {
#pragma unroll
            for (int i = 0; i < 4; ++i)
#pragma unroll
                for (int j = 0; j < 4; ++j)
#pragma unroll
                    for (int r = 0; r < 4; ++r) epi(bm + wm * 64 + i * 16 + (lane >> 4) * 4 + r, bn + wn * 64 + j * 16 + (lane & 15), acc[i][j][r]);
        }
    }
}

__device__ __forceinline__ int t5_bucket(int rel) {
    const int n = rel < 0 ? -rel : rel;
    int v;
    if (n < 8) v = n;
    else { int k = 0; k += (n >= 12); k += (n >= 16); k += (n >= 23); k += (n >= 32); k += (n >= 46); k += (n >= 64); k += (n >= 91); v = 8 + k; }
    return (rel > 0 ? 16 : 0) + v;
}
__device__ __forceinline__ float dot64_bf16(const float* qs, const bf16_t* krow) {
    float s = 0.f;
#pragma unroll
    for (int c = 0; c < 8; ++c) {
        const uint4 w = ((const uint4*)krow)[c];
        const unsigned ww[4] = {w.x, w.y, w.z, w.w};
#pragma unroll
        for (int e = 0; e < 4; ++e) { s += qs[c * 8 + 2 * e] * __uint_as_float(ww[e] << 16); s += qs[c * 8 + 2 * e + 1] * __uint_as_float(ww[e] & 0xffff0000u); }
    }
    return s;
}
#define WAVE_LDS_SYNC() do { __builtin_amdgcn_fence(__ATOMIC_RELEASE, "wavefront"); __builtin_amdgcn_wave_barrier(); __builtin_amdgcn_fence(__ATOMIC_ACQUIRE, "wavefront"); } while (0)

__device__ __forceinline__ void phase_attn_naive(const Ctx& c, const bf16_t* __restrict__ H, const float* __restrict__ sink, const float* __restrict__ t5, const float* __restrict__ rpb, float* __restrict__ Yraw) {
    float* qsh = (float*)(c.lds + c.wid * 256);
    const int lane = c.lane;
    const int gw = c.bid * NWAVES + c.wid, NGW = c.G * NWAVES;
    for (int item = gw; item < NTOK * 16; item += NGW) {
        const int tok = item >> 4, hh = item & 15;
        const int b = tok / SEQ, tt = tok % SEQ;
        if (hh < 8) {
            const int hq = hh, kvh = hq >> 2;
            qsh[lane] = bf2f(H[(size_t)tok * PROJ + hq * HD + lane]);
            WAVE_LDS_SYNC();
            float s[5];
#pragma unroll
            for (int i = 0; i < 5; ++i) {
                const int j = lane + 64 * i, rel = j - 128, kp = tt + rel;
                const bool valid = (rel <= 128) && kp >= 0 && kp < SEQ;
                float v = NEGF;
                if (valid) {
                    const bf16_t* krow = H + (size_t)(b * SEQ + kp) * PROJ + O1 + kvh * HD;
                    v = dot64_bf16(qsh, krow) * 0.125f + t5[t5_bucket(rel) * 8 + hq];
                }
                s[i] = v;
            }
            const float sk = sink[hq];
            float m = fmaxf(fmaxf(fmaxf(s[0], s[1]), fmaxf(s[2], s[3])), s[4]);
            m = fmaxf(wave_max(m), sk);
            float p[5], sum = 0.f;
#pragma unroll
            for (int i = 0; i < 5; ++i) { p[i] = expf(s[i] - m); sum += p[i]; }
            sum = wave_sum(sum) + expf(sk - m);
            const float inv = 1.f / sum;
            float acc = 0.f;
#pragma unroll
            for (int i = 0; i < 5; ++i) {
                for (int jj = 0; jj < 64; ++jj) {
                    const float pj = __shfl(p[i], jj);
                    const int rel = jj + 64 * i - 128; const int kp = tt + rel;
                    if (rel > 128 || kp < 0 || kp >= SEQ) continue;
                    acc += pj * bf2f(H[(size_t)(b * SEQ + kp) * PROJ + O2 + kvh * HD + lane]);
                }
            }
            Yraw[(size_t)tok * D + hq * HD + lane] = acc * inv;
        } else {
            const int hb = hh - 8, r = tt >> 6, cc = tt & 63;
            int rs = r - 4; rs = rs < 0 ? 0 : (rs > 56 ? 56 : rs);
            int cs = cc - 8; cs = cs < 0 ? 0 : (cs > 48 ? 48 : cs);
            qsh[lane] = bf2f(H[(size_t)tok * PROJ + O3 + hb * HD + lane]);
            WAVE_LDS_SYNC();
            float s[2];
#pragma unroll
            for (int i = 0; i < 2; ++i) {
                const int j = lane + 64 * i, kr = rs + (j >> 4), kc = cs + (j & 15);
                const bf16_t* krow = H + (size_t)(b * SEQ + kr * 64 + kc) * PROJ + O4 + hb * HD;
                const int dr = kr - r + 7; int dc = kc - cc; dc = dc < -15 ? -15 : (dc > 15 ? 15 : dc); dc += 15;
                s[i] = dot64_bf16(qsh, krow) * 0.125f + rpb[(hb * 15 + dr) * 31 + dc];
            }
            const float m = wave_max(fmaxf(s[0], s[1]));
            float p[2]; p[0] = expf(s[0] - m); p[1] = expf(s[1] - m);
            const float inv = 1.f / wave_sum(p[0] + p[1]);
            float acc = 0.f;
#pragma unroll
            for (int i = 0; i < 2; ++i)
                for (int jj = 0; jj < 64; ++jj) {
                    const float pj = __shfl(p[i], jj);
                    const int j = jj + 64 * i, kr = rs + (j >> 4), kc = cs + (j & 15);
                    acc += pj * bf2f(H[(size_t)(b * SEQ + kr * 64 + kc) * PROJ + O5 + hb * HD + lane]);
                }
            Yraw[(size_t)tok * D + 512 + hb * HD + lane] = acc * inv;
        }
        WAVE_LDS_SYNC();
    }
}


struct AttnState { float m, l; f32x16 o0, o1; };
__device__ __forceinline__ void attn_state_init(AttnState& st) {
    st.m = -1e30f; st.l = 0.f;
#pragma unroll
    for (int r = 0; r < 16; ++r) { st.o0[r] = 0.f; st.o1[r] = 0.f; }
}
__device__ __forceinline__ void attn_stage_kv(const Ctx& c, LAS unsigned char* Ks, LAS unsigned char* VT, const bf16_t* __restrict__ H, int b, int tok0, int koff, int voff) {
#pragma unroll
    for (int i = 0; i < 6; ++i) {
        const int ch = c.tid + NTHREADS * i, row = ch >> 3, cc = ch & 7;
        int t = tok0 + row; t = t < 0 ? 0 : (t > SEQ - 1 ? SEQ - 1 : t);
        const bf16_t* src = H + (size_t)(b * SEQ + t) * PROJ;
        const u32x4 kv = *(const u32x4*)(src + koff + cc * 8);
        const u32x4 vv = *(const u32x4*)(src + voff + cc * 8);
        *(LAS u32x4*)(Ks + row * 128 + ((cc ^ (row & 7)) << 4)) = kv;
        LAS bf16_t* vt = (LAS bf16_t*)VT + (cc * 8) * 388 + row;
#pragma unroll
        for (int k = 0; k < 4; ++k) { vt[(2 * k) * 388] = (bf16_t)(vv[k] & 0xffffu); vt[(2 * k + 1) * 388] = (bf16_t)(vv[k] >> 16); }
    }
}
__device__ __forceinline__ void attn_qk(f32x16& s, const bf16x8 (&qf)[4], const LAS unsigned char* Ks, int kt, int r32, int hh) {
#pragma unroll
    for (int r = 0; r < 16; ++r) s[r] = 0.f;
#pragma unroll
    for (int ks = 0; ks < 4; ++ks) {
        const bf16x8 a = *(const LAS bf16x8*)(Ks + (32 * kt + r32) * 128 + (((2 * ks + hh) ^ (r32 & 7)) << 4));
        s = __builtin_amdgcn_mfma_f32_32x32x16_bf16(a, qf[ks], s, 0, 0, 0);
    }
}
__device__ __forceinline__ void attn_softmax_pv(AttnState& st, f32x16& s, const LAS unsigned char* VT, int kt, int r32, int hh) {
    float tmax = s[0];
#pragma unroll
    for (int r = 1; r < 16; ++r) tmax = fmaxf(tmax, s[r]);
    tmax = fmaxf(tmax, __shfl_xor(tmax, 32));
    const float mn = fmaxf(st.m, tmax), alpha = __expf(st.m - mn);
    st.m = mn;
    float psum = 0.f;
#pragma unroll
    for (int r = 0; r < 16; ++r) { s[r] = __expf(s[r] - mn); psum += s[r]; }
    st.l = st.l * alpha + psum;
#pragma unroll
    for (int r = 0; r < 16; ++r) { st.o0[r] *= alpha; st.o1[r] *= alpha; }
    bf16x8 pb[2];
#pragma unroll
    for (int s2 = 0; s2 < 2; ++s2)
#pragma unroll
        for (int j = 0; j < 8; ++j) pb[s2][j] = (short)f2bf(s[8 * s2 + j]);
#pragma unroll
    for (int s2 = 0; s2 < 2; ++s2) {
        const LAS unsigned char* vp0 = VT + (r32 * 388 + 32 * kt + 16 * s2 + 4 * hh) * 2;
        const LAS unsigned char* vp1 = vp0 + 32 * 388 * 2;
        const u32x2 a0 = *(const LAS u32x2*)vp0, a1 = *(const LAS u32x2*)(vp0 + 16);
        const u32x2 b0 = *(const LAS u32x2*)vp1, b1 = *(const LAS u32x2*)(vp1 + 16);
        const u32x4 fa = {a0[0], a0[1], a1[0], a1[1]}, fb = {b0[0], b0[1], b1[0], b1[1]};
        st.o0 = __builtin_amdgcn_mfma_f32_32x32x16_bf16(__builtin_bit_cast(bf16x8, fa), pb[s2], st.o0, 0, 0, 0);
        st.o1 = __builtin_amdgcn_mfma_f32_32x32x16_bf16(__builtin_bit_cast(bf16x8, fb), pb[s2], st.o1, 0, 0, 0);
    }
}
__device__ __forceinline__ void attn_store(const AttnState& st, float scale, float* __restrict__ yrow  , int hh) {
#pragma unroll
    for (int g4 = 0; g4 < 4; ++g4) {
        f32x4 a, b;
#pragma unroll
        for (int e = 0; e < 4; ++e) { a[e] = st.o0[4 * g4 + e] * scale; b[e] = st.o1[4 * g4 + e] * scale; }
        *(f32x4*)(yrow + 8 * g4 + 4 * hh) = a;
        *(f32x4*)(yrow + 32 + 8 * g4 + 4 * hh) = b;
    }
}
__device__ __forceinline__ void phase_attn(const Ctx& c, const bf16_t* __restrict__ H, const float* __restrict__ sink, const float* __restrict__ t5, const float* __restrict__ rpb, float* __restrict__ Yraw) {
    LAS unsigned char* Ks = (LAS unsigned char*)c.lds;
    LAS unsigned char* VT = Ks + 49152;
    LAS float* TB = (LAS float*)(Ks + 98816);
    const int lane = c.lane, r32 = lane & 31, hh = lane >> 5, w = c.wid;
    constexpr int NWIN = BATCH * 2 * (SEQ / 128), NNA = BATCH * 8 * 16;
    for (int u = c.bid; u < NWIN + NNA; u += c.G) {
        __syncthreads();
        if (u < NWIN) {
            const int b = u / (2 * (SEQ / 128)), kvh = (u / (SEQ / 128)) & 1, n = u % (SEQ / 128);
            attn_stage_kv(c, Ks, VT, H, b, 128 * (n - 1), O1 + kvh * HD, O2 + kvh * HD);
            for (int i = c.tid; i < 511 * 4; i += NTHREADS) {
                const int rel = (i >> 2) - 255, g = i & 3;
                TB[i] = (rel >= -128 && rel <= 128) ? t5[t5_bucket(rel) * 8 + kvh * 4 + g] : -INFINITY;
            }
            __syncthreads();
            const int g = w >> 1, hq = kvh * 4 + g;
            const float sk = sink[hq];
#pragma unroll 1
            for (int qi = 0; qi < 2; ++qi) {
                const int qt = 2 * (w & 1) + qi, i0 = 32 * qt;
                const int tok = b * SEQ + 128 * n + i0 + r32;
                bf16x8 qf[4];
#pragma unroll
                for (int ks = 0; ks < 4; ++ks) qf[ks] = *(const bf16x8*)(H + (size_t)tok * PROJ + hq * HD + 16 * ks + 8 * hh);
                AttnState st; attn_state_init(st);
                int kt0 = qt, kt1 = qt + 8;
                if (n == 0 && kt0 < 4) kt0 = 4;
                if (n == SEQ / 128 - 1 && kt1 > 7) kt1 = 7;
#pragma unroll 1
                for (int kt = kt0; kt <= kt1; ++kt) {
                    f32x16 s; attn_qk(s, qf, Ks, kt, r32, hh);
                    const LAS float* tb = TB + (32 * kt + 4 * hh - (i0 + r32) + 127) * 4 + g;
#pragma unroll
                    for (int r = 0; r < 16; ++r) s[r] = s[r] * 0.125f + tb[((r & 3) + 8 * (r >> 2)) * 4];
                    attn_softmax_pv(st, s, VT, kt, r32, hh);
                }
                const float l = st.l + __shfl_xor(st.l, 32);
                const float mf = fmaxf(st.m, sk), ef = __expf(st.m - mf);
                const float scale = ef / (l * ef + __expf(sk - mf));
                attn_store(st, scale, Yraw + (size_t)tok * D + hq * HD, hh);
            }
        } else {
            const int v = u - NWIN, b = v / (8 * 16), hb = (v / 16) & 7, R0 = 4 * (v & 15);
            int kr0 = R0 - 4; kr0 = kr0 < 0 ? 0 : (kr0 > 56 ? 56 : kr0);
            const int r = R0 + (w >> 1), cq = 32 * (w & 1) + r32;
            int rs = r - 4; rs = rs < 0 ? 0 : (rs > 56 ? 56 : rs);
            int cs = cq - 8; cs = cs < 0 ? 0 : (cs > 48 ? 48 : cs);
            const int tok = b * SEQ + r * 64 + cq;
            bf16x8 qf[4];
#pragma unroll
            for (int ks = 0; ks < 4; ++ks) qf[ks] = *(const bf16x8*)(H + (size_t)tok * PROJ + O3 + hb * HD + 16 * ks + 8 * hh);
            AttnState st; attn_state_init(st);
#pragma unroll 1
            for (int pass = 0; pass < 2; ++pass) {
                if (pass) __syncthreads();
                attn_stage_kv(c, Ks, VT, H, b, (kr0 + 6 * pass) * 64, O4 + hb * HD, O5 + hb * HD);
                if (pass == 0) for (int i = c.tid; i < 15 * 31; i += NTHREADS) TB[i] = rpb[hb * 15 * 31 + i];
                __syncthreads();
#pragma unroll 1
                for (int kt = 0; kt < 12; ++kt) {
                    const int kr = kr0 + 6 * pass + (kt >> 1);
                    if (kr < rs || kr >= rs + 8) continue;
                    f32x16 s; attn_qk(s, qf, Ks, kt, r32, hh);
                    const LAS float* tb = TB + (kr - r + 7) * 31 + 15;
                    const int kc0 = 32 * (kt & 1) + 4 * hh;
#pragma unroll
                    for (int rr = 0; rr < 16; ++rr) {
                        const int kc = kc0 + (rr & 3) + 8 * (rr >> 2);
                        int dc = kc - cq; dc = dc < -15 ? -15 : (dc > 15 ? 15 : dc);
                        const bool ok = (kc >= cs) && (kc < cs + 16);
                        s[rr] = ok ? s[rr] * 0.125f + tb[dc] : -INFINITY;
                    }
                    attn_softmax_pv(st, s, VT, kt, r32, hh);
                }
            }
            const float l = st.l + __shfl_xor(st.l, 32);
            attn_store(st, 1.f / l, Yraw + (size_t)tok * D + 512 + hb * HD, hh);
        }
    }
}

__device__ __forceinline__ void phase_rmsnorm(const Ctx& c, const float* __restrict__ Yraw, const float* __restrict__ ga, const float* __restrict__ gb, bf16_t* __restrict__ Y) {
    const int lane = c.lane, gw = c.bid * NWAVES + c.wid, NGW = c.G * NWAVES;
    for (int tok = gw; tok < NTOK; tok += NGW) {
        const float* row = Yraw + (size_t)tok * D;
        float a[8], bb[8], sa = 0.f, sb = 0.f;
#pragma unroll
        for (int i = 0; i < 8; ++i) { a[i] = row[lane + 64 * i]; bb[i] = row[512 + lane + 64 * i]; sa += a[i] * a[i]; sb += bb[i] * bb[i]; }
        const float ra = rsqrtf(wave_sum(sa) * (1.f / 512.f) + LN_EPS), rb = rsqrtf(wave_sum(sb) * (1.f / 512.f) + LN_EPS);
#pragma unroll
        for (int i = 0; i < 8; ++i) {
            Y[(size_t)tok * D + lane + 64 * i] = f2bf(a[i] * ra * ga[lane + 64 * i]);
            Y[(size_t)tok * D + 512 + lane + 64 * i] = f2bf(bb[i] * rb * gb[lane + 64 * i]);
        }
    }
}

__device__ __forceinline__ void ln_store_row(f32x4 (&v)[4], int lane, const float* __restrict__ g, const float* __restrict__ bta, float* __restrict__ orow, bf16_t* __restrict__ obrow, unsigned char* __restrict__ o8row) {
    float s = 0.f;
#pragma unroll
    for (int j = 0; j < 4; ++j) s += (v[j][0] + v[j][1]) + (v[j][2] + v[j][3]);
    const float mean = wave_sum(s) * (1.f / D); float s2 = 0.f;
#pragma unroll
    for (int j = 0; j < 4; ++j) { v[j] = v[j] - mean; s2 += (v[j][0] * v[j][0] + v[j][1] * v[j][1]) + (v[j][2] * v[j][2] + v[j][3] * v[j][3]); }
    const float rstd = rsqrtf(wave_sum(s2) * (1.f / D) + LN_EPS);
#pragma unroll
    for (int j = 0; j < 4; ++j) {
        const f32x4 gg = ((const f32x4*)g)[lane + 64 * j], be = ((const f32x4*)bta)[lane + 64 * j];
        const f32x4 o = v[j] * rstd * gg + be;
        ((f32x4*)orow)[lane + 64 * j] = o;
        uint2 ob; ob.x = f2bf(o[0]) | ((unsigned)f2bf(o[1]) << 16); ob.y = f2bf(o[2]) | ((unsigned)f2bf(o[3]) << 16);
        ((uint2*)obrow)[lane + 64 * j] = ob;
        if (o8row) ((unsigned*)o8row)[lane + 64 * j] = pack4_fp8(o, XS);
    }
}
__device__ __forceinline__ void phase_ln(const Ctx& c, const float* __restrict__ Z, const float* __restrict__ g, const float* __restrict__ bta, float* __restrict__ out, bf16_t* __restrict__ outb, unsigned char* __restrict__ out8) {
    const int lane = c.lane, gw = c.bid * NWAVES + c.wid, NGW = c.G * NWAVES;
    for (int tok = gw; tok < NTOK; tok += NGW) {
        const f32x4* zr = (const f32x4*)(Z + (size_t)tok * D);
        f32x4 v[4];
#pragma unroll
        for (int j = 0; j < 4; ++j) v[j] = zr[lane + 64 * j];
        ln_store_row(v, lane, g, bta, out + (size_t)tok * D, outb + (size_t)tok * D, out8 + (size_t)tok * D);
    }
}


#ifndef HD
#define HD __host__ __device__ __forceinline__
#endif
HD unsigned tk_f2u(float f) { return __builtin_bit_cast(unsigned, f); }
HD float tk_u2f(unsigned u) { return __builtin_bit_cast(float, u); }
template <int N> HD void bitonic_sort_desc(float (&v)[N]) {
#pragma unroll
    for (int k = 2; k <= N; k <<= 1)
#pragma unroll
        for (int j = k >> 1; j > 0; j >>= 1)
#pragma unroll
            for (int i = 0; i < N; ++i) {
                const int l = i ^ j;
                if (l > i) {
                    const bool desc = ((i & k) == 0);
                    const float a = v[i], b = v[l];
                    const float mx = __builtin_fmaxf(a, b), mn = __builtin_fminf(a, b);
                    v[i] = desc ? mx : mn; v[l] = desc ? mn : mx;
                }
            }
}
template <int N> HD void bitonic_merge_desc(float (&v)[N]) {
#pragma unroll
    for (int j = N >> 1; j > 0; j >>= 1)
#pragma unroll
        for (int i = 0; i < N; ++i) {
            const int l = i ^ j;
            if (l > i) { const float a = v[i], b = v[l]; v[i] = __builtin_fmaxf(a, b); v[l] = __builtin_fminf(a, b); }
        }
}
HD void top16_merge(float (&a)[16], const float (&b)[16]) {
#pragma unroll
    for (int i = 0; i < 16; ++i) a[i] = __builtin_fmaxf(a[i], b[15 - i]);
    bitonic_merge_desc<16>(a);
}
HD void tk_local_top16(const float (&sc)[4][16], int hh, float (&out)[16]) {
    float g[4][16];
#pragma unroll
    for (int kt = 0; kt < 4; ++kt) {
#pragma unroll
        for (int reg = 0; reg < 16; ++reg) { const int key = 32 * kt + (reg & 3) + 8 * (reg >> 2) + 4 * hh; g[kt][reg] = tk_u2f((tk_f2u(sc[kt][reg]) & ~127u) | (unsigned)(127 - key)); }
        bitonic_sort_desc<16>(g[kt]);
    }
    top16_merge(g[0], g[1]); top16_merge(g[2], g[3]); top16_merge(g[0], g[2]);
#pragma unroll
    for (int i = 0; i < 16; ++i) out[i] = g[0][i];
}
constexpr int CA0[25] = {0,0,0,0,0,0,0,0,0,0,0,0,0,0,0,0,1,1,1,1,1,1,1,1,2};
constexpr int CB0[25] = {0,1,2,3,4,5,6,7,8,9,10,11,12,13,14,15,0,1,2,3,4,5,6,7,0};
constexpr int CA1[25] = {2,2,2,2,3,3,3,3,4,4,4,5,5,6,6,7,7,8,9,10,11,12,13,14,15};
constexpr int CB1[25] = {1,2,3,4,0,1,2,3,0,1,2,0,1,0,1,0,1,0,0,0,0,0,0,0,0};
HD void tk_candidates(const float (&T0)[16], const float (&T1)[16], int hh, float (&cv)[32]) {
    float t0[16], t1[16];
#pragma unroll
    for (int i = 0; i < 16; ++i) { t0[i] = tk_u2f(tk_f2u(T0[i]) & ~127u); t1[i] = tk_u2f(tk_f2u(T1[i]) & ~127u); }
#pragma unroll
    for (int j = 0; j < 25; ++j) {
        const float s0 = t0[CA0[j]] + t1[CB0[j]], s1 = t0[CA1[j]] + t1[CB1[j]];
        const unsigned c0 = 255u - (unsigned)(16 * CA0[j] + CB0[j]), c1 = 255u - (unsigned)(16 * CA1[j] + CB1[j]);
        cv[j] = tk_u2f((tk_f2u(hh ? s1 : s0) & ~255u) | (hh ? c1 : c0));
    }
#pragma unroll
    for (int j = 25; j < 32; ++j) cv[j] = -__builtin_inff();
    bitonic_sort_desc<32>(cv);
}

__device__ __forceinline__ void wave_argmax(float& v, int& i) {
#pragma unroll
    for (int o = 32; o >= 1; o >>= 1) {
        const float ov = __shfl_xor(v, o); const int oi = __shfl_xor(i, o);
        if (ov > v || (ov == v && oi < i)) { v = ov; i = oi; }
    }
}
__device__ __forceinline__ void phase_topk_naive(const Ctx& c, const float* __restrict__ Qp, const float* __restrict__ keys, int* __restrict__ eidx, float* __restrict__ gate) {
    float* qsh = (float*)(c.lds + c.wid * 1024);
    float* tv = qsh + 128;
    int* ti = (int*)(tv + 32);
    const int lane = c.lane, gw = c.bid * NWAVES + c.wid, NGW = c.G * NWAVES;
    for (int item = gw; item < NTOK * 8; item += NGW) {
        const int tok = item >> 3, h = item & 7;
        for (int p = 0; p < 2; ++p) {
            const float* q = Qp + (size_t)tok * PQ + h * 256 + p * 128;
            qsh[lane] = q[lane]; qsh[lane + 64] = q[lane + 64];
            WAVE_LDS_SYNC();
            float s[2];
#pragma unroll
            for (int i = 0; i < 2; ++i) {
                const f32x4* kr = (const f32x4*)(keys + ((size_t)(h * 2 + p) * NKEYS + lane + 64 * i) * 128);
                float a = 0.f;
                for (int cc = 0; cc < 32; ++cc) { const f32x4 kk = kr[cc]; a += qsh[4 * cc] * kk[0]; a += qsh[4 * cc + 1] * kk[1]; a += qsh[4 * cc + 2] * kk[2]; a += qsh[4 * cc + 3] * kk[3]; }
                s[i] = a;
            }
            for (int r = 0; r < 16; ++r) {
                float bv; int bi;
                if (s[0] >= s[1]) { bv = s[0]; bi = lane; } else { bv = s[1]; bi = lane + 64; }
                wave_argmax(bv, bi);
                if (bi == lane) s[0] = -INFINITY;
                if (bi == lane + 64) s[1] = -INFINITY;
                if (lane == 0) { tv[p * 16 + r] = bv; ti[p * 16 + r] = bi; }
            }
            WAVE_LDS_SYNC();
        }
        float cv[4];
#pragma unroll
        for (int j = 0; j < 4; ++j) { const int f = lane * 4 + j; cv[j] = tv[f >> 4] + tv[16 + (f & 15)]; }
        float fs = 0.f; int fp = 0;
        for (int r = 0; r < 16; ++r) {
            float bv = cv[0]; int bi = lane * 4;
#pragma unroll
            for (int j = 1; j < 4; ++j) if (cv[j] > bv) { bv = cv[j]; bi = lane * 4 + j; }
            wave_argmax(bv, bi);
#pragma unroll
            for (int j = 0; j < 4; ++j) if (bi == lane * 4 + j) cv[j] = -INFINITY;
            if (lane == r) { fs = bv; fp = bi; }
        }
        const float m = wave_max(lane < 16 ? fs : -INFINITY);
        const float e = lane < 16 ? expf(fs - m) : 0.f;
        const float sum = wave_sum(e);
        if (lane < 16) {
            const int id = ti[fp >> 4] * NKEYS + ti[16 + (fp & 15)];
            eidx[(size_t)item * 16 + lane] = id;
            gate[(size_t)item * 16 + lane] = e / sum;
        }
        WAVE_LDS_SYNC();
    }
}

__device__ __forceinline__ void phase_gather_naive(const Ctx& c, const float* __restrict__ x1, const int* __restrict__ eidx, const float* __restrict__ gate,
                                                   const float* __restrict__ U, const float* __restrict__ V, const float* __restrict__ g, const float* __restrict__ bta,
                                                   float* __restrict__ out, bf16_t* __restrict__ outb) {
    const int lane = c.lane, gw = c.bid * NWAVES + c.wid, NGW = c.G * NWAVES;
    for (int tok = gw; tok < NTOK; tok += NGW) {
        const f32x4* xr = (const f32x4*)(x1 + (size_t)tok * D);
        f32x4 xv[4], acc[4];
#pragma unroll
        for (int j = 0; j < 4; ++j) { xv[j] = xr[lane + 64 * j]; acc[j] = (f32x4){0.f, 0.f, 0.f, 0.f}; }
        for (int k = 0; k < 128; ++k) {
            const int e = eidx[(size_t)tok * 128 + k];
            const float gk = gate[(size_t)tok * 128 + k];
            const f32x4* ur = (const f32x4*)(U + (size_t)e * D);
            const f32x4* vr = (const f32x4*)(V + (size_t)e * D);
            float d = 0.f;
#pragma unroll
            for (int j = 0; j < 4; ++j) { const f32x4 uu = ur[lane + 64 * j]; d += (xv[j][0] * uu[0] + xv[j][1] * uu[1]) + (xv[j][2] * uu[2] + xv[j][3] * uu[3]); }
            d = wave_sum(d);
            const float a = 0.5f * d * (1.f + erff(d * 0.70710678118654752f)) * gk;
#pragma unroll
            for (int j = 0; j < 4; ++j) acc[j] += a * vr[lane + 64 * j];
        }
#pragma unroll
        for (int j = 0; j < 4; ++j) acc[j] = ALPHA * xv[j] + acc[j];
        ln_store_row(acc, lane, g, bta, out + (size_t)tok * D, outb + (size_t)tok * D, nullptr);
    }
}


__device__ __forceinline__ void phase_topk(const Ctx& c, const bf16_t* __restrict__ Qb, const bf16_t* __restrict__ Kb, int* __restrict__ eidx, float* __restrict__ gate) {
    LAS unsigned char* kl = (LAS unsigned char*)c.lds;
    LAS int* scr = (LAS int*)(c.lds + 65536) + c.wid * 1024;
    const int lane = c.lane, r32 = lane & 31, hh = lane >> 5;
    for (int task = c.bid; task < 8 * (NTOK / 256); task += c.G) {
        const int h = task / (NTOK / 256), tb = task % (NTOK / 256);
        __syncthreads();
#pragma unroll
        for (int i = 0; i < 8; ++i) {
            const int ch = c.tid + NTHREADS * i, row = ch >> 4, cc = ch & 15;
            const u32x4 v = *(const u32x4*)(Kb + ((size_t)(h * 256 + row) * 128 + cc * 8));
            *(LAS u32x4*)(kl + row * 256 + ((cc ^ (row & 15)) << 4)) = v;
        }
        __syncthreads();
        const int tok = tb * 256 + c.wid * 32 + r32;
        float T0[16], T1[16];
#pragma unroll
        for (int p = 0; p < 2; ++p) {
            bf16x8 bq[8];
            const bf16_t* qrow = Qb + (size_t)tok * PQ + h * 256 + p * 128 + hh * 8;
#pragma unroll
            for (int ks = 0; ks < 8; ++ks) bq[ks] = *(const bf16x8*)(qrow + 16 * ks);
            f32x16 acc[4];
#pragma unroll
            for (int kt = 0; kt < 4; ++kt)
#pragma unroll
                for (int r = 0; r < 16; ++r) acc[kt][r] = 0.f;
#pragma unroll
            for (int ks = 0; ks < 8; ++ks) {
                const int swz = ((2 * ks + hh) ^ (r32 & 15)) << 4;
#pragma unroll
                for (int kt = 0; kt < 4; ++kt) {
                    const bf16x8 a = *(const LAS bf16x8*)(kl + (p * 128 + 32 * kt + r32) * 256 + swz);
                    acc[kt] = __builtin_amdgcn_mfma_f32_32x32x16_bf16(a, bq[ks], acc[kt], 0, 0, 0);
                }
            }
            float sc[4][16], loc[16], pr[16];
#pragma unroll
            for (int kt = 0; kt < 4; ++kt)
#pragma unroll
                for (int r = 0; r < 16; ++r) sc[kt][r] = acc[kt][r];
            tk_local_top16(sc, hh, loc);
#pragma unroll
            for (int i = 0; i < 16; ++i) pr[i] = __shfl_xor(loc[i], 32);
            top16_merge(loc, pr);
            if (hh == p) {
#pragma unroll
                for (int i = 0; i < 16; ++i) scr[r32 * 32 + p * 16 + i] = 127 - (int)(tk_f2u(loc[i]) & 127u);
            }
#pragma unroll
            for (int i = 0; i < 16; ++i) { if (p == 0) T0[i] = loc[i]; else T1[i] = loc[i]; }
        }
        float cv[32], F[16], pr[16];
        tk_candidates(T0, T1, hh, cv);
#pragma unroll
        for (int i = 0; i < 16; ++i) { F[i] = cv[i]; pr[i] = __shfl_xor(cv[i], 32); }
        top16_merge(F, pr);
        WAVE_LDS_SYNC();
        const float m = tk_u2f(tk_f2u(F[0]) & ~255u);
        float e[16], sum = 0.f;
#pragma unroll
        for (int i = 0; i < 16; ++i) { e[i] = __expf(tk_u2f(tk_f2u(F[i]) & ~255u) - m); sum += e[i]; }
        const float inv = 1.f / sum;
        int ids[8]; float gs[8];
#pragma unroll
        for (int r = 0; r < 8; ++r) {
            const float fv = hh ? F[8 + r] : F[r];
            const unsigned pos = 255u - (tk_f2u(fv) & 255u);
            ids[r] = scr[r32 * 32 + (int)(pos >> 4)] * NKEYS + scr[r32 * 32 + 16 + (int)(pos & 15u)];
            gs[r] = (hh ? e[8 + r] : e[r]) * inv;
        }
        int* ep = eidx + ((size_t)tok * 8 + h) * 16 + 8 * hh; float* gp = gate + ((size_t)tok * 8 + h) * 16 + 8 * hh;
        *(int4*)ep = make_int4(ids[0], ids[1], ids[2], ids[3]); *(int4*)(ep + 4) = make_int4(ids[4], ids[5], ids[6], ids[7]);
        *(f32x4*)gp = (f32x4){gs[0], gs[1], gs[2], gs[3]}; *(f32x4*)(gp + 4) = (f32x4){gs[4], gs[5], gs[6], gs[7]};
        WAVE_LDS_SYNC();
    }
}

__device__ __forceinline__ float gelu_erf(float v) {
    const float av = fabsf(v), t = __builtin_amdgcn_rcpf(av * 0.2316418882f + 1.0f);
    float qq = t * 0.5307027145f + (-0.7265760135f); qq = qq * t + 0.7107068705f; qq = qq * t + (-0.142248368f); qq = qq * t + 0.127414796f; qq = qq * t;
    const float e = __builtin_amdgcn_exp2f((v * v) * (-0.72134752044f));
    const float m = v * (qq * e);
    return v < 0.f ? m : v - m;
}
#define SB() __builtin_amdgcn_sched_barrier(0)
__device__ __forceinline__ void axpy_row(f32x2 (&acc)[8], const u32x4 w, const float a) {
    const f32x2 aa = {a, a};
#pragma unroll
    for (int k = 0; k < 4; ++k) {
        const f32x2 lo = __builtin_amdgcn_cvt_pk_f32_fp8(w[k], false), hi = __builtin_amdgcn_cvt_pk_f32_fp8(w[k], true);
        acc[2 * k] = __builtin_elementwise_fma(lo, aa, acc[2 * k]); acc[2 * k + 1] = __builtin_elementwise_fma(hi, aa, acc[2 * k + 1]);
    }
}
__device__ __forceinline__ void phase_gather(const Ctx& c, const float* __restrict__ x1, const unsigned char* __restrict__ X8, const int* __restrict__ eidx, const float* __restrict__ gate,
                                             const unsigned char* __restrict__ U4, const unsigned char* __restrict__ V8, const float* __restrict__ g, const float* __restrict__ bta,
                                             float* __restrict__ out, bf16_t* __restrict__ outb) {
    typedef int i32x8 __attribute__((ext_vector_type(8)));
    const int gw = c.bid * NWAVES + c.wid, NGW = c.G * NWAVES;
    LAS unsigned char* xl = (LAS unsigned char*)c.lds + c.wid * 2048;
    const int lane = c.lane, q = lane >> 4, l15 = lane & 15;
    const unsigned lo16 = (unsigned)lane * 16u;
    constexpr int UROW = D / 2;
    int tok = gw;
    if (tok >= NTOK) return;
    int ev0 = eidx[(size_t)tok * 128 + lane], ev1 = eidx[(size_t)tok * 128 + 64 + lane];
    int en0, en1;
    { const int t1 = (tok + NGW < NTOK) ? tok + NGW : tok; en0 = eidx[(size_t)t1 * 128 + lane]; en1 = eidx[(size_t)t1 * 128 + 64 + lane]; }
    *(LAS u32x4*)(xl + lane * 16) = *(const u32x4*)(X8 + (size_t)tok * D + lo16);
    u32x4 bU[8], bV0[8], bV1[8];
    {
        const unsigned char* ub = U4 + ((unsigned)__shfl(ev0, l15) * (unsigned)UROW + (unsigned)q * 16u);
#pragma unroll
        for (int t = 0; t < 8; ++t) bU[t] = *(const u32x4*)(ub + 64 * t);
        SB();
#pragma unroll
        for (int i = 0; i < 8; ++i) { const int e = __builtin_amdgcn_readlane(ev0, i); bV0[i] = *(const u32x4*)(V8 + (size_t)e * D + lo16); }
        SB();
    }
    int slot = 0;
#pragma unroll 1
    for (; tok < NTOK; tok += NGW, slot ^= 1) {
        const int tokn = (tok + NGW < NTOK) ? tok + NGW : tok, tok2 = (tok + 2 * NGW < NTOK) ? tok + 2 * NGW : tok;
        const int nn0 = eidx[(size_t)tok2 * 128 + lane], nn1 = eidx[(size_t)tok2 * 128 + 64 + lane];
        const u32x4 xn = *(const u32x4*)(X8 + (size_t)tokn * D + lo16);
        const LAS unsigned char* xc = xl + slot * 1024 + q * 16;
        f32x2 acc[8];
#pragma unroll
        for (int k = 0; k < 8; ++k) acc[k] = (f32x2){0.f, 0.f};
        SB();
#pragma unroll 1
        for (int h = 0; h < 8; ++h) {
            const int evh = (h < 4) ? ev0 : ev1, lb = (h & 3) * 16;
            const bool last = (h == 7);
            const int evn = last ? en0 : ((h + 1 < 4) ? ev0 : ev1), lbn = last ? 0 : ((h + 1) & 3) * 16;
            const f32x4 gq = *(const f32x4*)(gate + (size_t)tok * 128 + h * 16 + 4 * q);
            SB();
#pragma unroll
            for (int i = 0; i < 8; ++i) { const int e = __builtin_amdgcn_readlane(evh, lb + 8 + i); bV1[i] = *(const u32x4*)(V8 + (size_t)e * D + lo16); }
            SB();
            f32x4 h4 = {0.f, 0.f, 0.f, 0.f};
#pragma unroll
            for (int t = 0; t < 8; ++t) {
                const u32x4 x0 = *(const LAS u32x4*)(xc + 128 * t), x1v = *(const LAS u32x4*)(xc + 128 * t + 64);
                const i32x8 av = {(int)bU[t][0], (int)bU[t][1], (int)bU[t][2], (int)bU[t][3], 0, 0, 0, 0};
                const i32x8 bv = {(int)x0[0], (int)x0[1], (int)x0[2], (int)x0[3], (int)x1v[0], (int)x1v[1], (int)x1v[2], (int)x1v[3]};
                h4 = __builtin_amdgcn_mfma_scale_f32_16x16x128_f8f6f4(av, bv, h4, 4, 0, 0, 0, 0, 0);
                if ((t & 1) == 1) SB();
            }
            int a4[4];
#pragma unroll
            for (int r = 0; r < 4; ++r) a4[r] = __builtin_bit_cast(int, gelu_erf(h4[r] * (1.f / (XS * US))) * gq[r] * (1.f / VS));
            SB();
            {
                const unsigned char* ubn = U4 + ((unsigned)__shfl(evn, lbn + l15) * (unsigned)UROW + (unsigned)q * 16u);
#pragma unroll
                for (int t = 0; t < 8; ++t) bU[t] = *(const u32x4*)(ubn + 64 * t);
            }
            SB();
#pragma unroll
            for (int i = 0; i < 8; ++i) { axpy_row(acc, bV0[i], __builtin_bit_cast(float, __builtin_amdgcn_readlane(a4[i & 3], 16 * (i >> 2)))); if (i & 1) SB(); }
#pragma unroll
            for (int i = 0; i < 8; ++i) { const int e = __builtin_amdgcn_readlane(evn, lbn + i); bV0[i] = *(const u32x4*)(V8 + (size_t)e * D + lo16); }
            SB();
#pragma unroll
            for (int i = 0; i < 8; ++i) { axpy_row(acc, bV1[i], __builtin_bit_cast(float, __builtin_amdgcn_readlane(a4[i & 3], 32 + 16 * (i >> 2)))); if (i & 1) SB(); }
        }
        *(LAS u32x4*)(xl + (slot ^ 1) * 1024 + lane * 16) = xn;
        const f32x4* xr = (const f32x4*)(x1 + (size_t)tok * D) + 4 * lane;
        float sm = 0.f;
#pragma unroll
        for (int w = 0; w < 4; ++w) { const f32x4 xv = xr[w];
            acc[2 * w][0] += ALPHA * xv[0]; acc[2 * w][1] += ALPHA * xv[1]; acc[2 * w + 1][0] += ALPHA * xv[2]; acc[2 * w + 1][1] += ALPHA * xv[3];
            sm += (acc[2 * w][0] + acc[2 * w][1]) + (acc[2 * w + 1][0] + acc[2 * w + 1][1]); }
        const float mean = wave_sum(sm) * (1.f / D); float s2 = 0.f;
#pragma unroll
        for (int k = 0; k < 8; ++k) { acc[k] = acc[k] - mean; s2 += acc[k][0] * acc[k][0] + acc[k][1] * acc[k][1]; }
        const float rstd = rsqrtf(wave_sum(s2) * (1.f / D) + LN_EPS);
#pragma unroll
        for (int w = 0; w < 4; ++w) {
            const f32x4 gg = ((const f32x4*)g)[4 * lane + w], be = ((const f32x4*)bta)[4 * lane + w];
            f32x4 o;
            o[0] = acc[2 * w][0] * rstd * gg[0] + be[0]; o[1] = acc[2 * w][1] * rstd * gg[1] + be[1];
            o[2] = acc[2 * w + 1][0] * rstd * gg[2] + be[2]; o[3] = acc[2 * w + 1][1] * rstd * gg[3] + be[3];
            ((f32x4*)(out + (size_t)tok * D))[4 * lane + w] = o;
            uint2 ob; ob.x = f2bf(o[0]) | ((unsigned)f2bf(o[1]) << 16); ob.y = f2bf(o[2]) | ((unsigned)f2bf(o[3]) << 16);
            ((uint2*)(outb + (size_t)tok * D))[4 * lane + w] = ob;
        }
        ev0 = en0; ev1 = en1; en0 = nn0; en1 = nn1;
        SB();
    }
}


#define GAS __attribute__((address_space(1)))
#define XB_TMO      128
#define XB_XCNT(j)  (256  + 64 * (j))
#define XB_XSUB(j)  (1280 + 64 * (j))
#define XB_XGEN(j)  (2304 + 64 * (j))
#define XB_TOP      3328
#define XB_TOPGEN   3392
#define XCD_BAR_WORDS 3456
#define XB_SPIN_CAP (1u << 18)

__device__ __forceinline__ unsigned xb_ld(unsigned* p)              { return __hip_atomic_load(p, __ATOMIC_RELAXED, __HIP_MEMORY_SCOPE_AGENT); }
__device__ __forceinline__ unsigned xb_add(unsigned* p, unsigned v) { return __hip_atomic_fetch_add(p, v, __ATOMIC_RELAXED, __HIP_MEMORY_SCOPE_AGENT); }
__device__ __forceinline__ unsigned xb_xcc_id() { return (unsigned)__builtin_amdgcn_s_getreg((3 << 11) | 20) & 0xFu; }
#define XB_SPIN(cond, bar) do { unsigned _sp = 0; while (cond) { __builtin_amdgcn_s_sleep(1); \
    if ((++_sp & 255u) == 0u) { if (xb_ld(&(bar)[XB_TMO])) break; if (_sp > XB_SPIN_CAP) { atomicAdd(&(bar)[XB_TMO], 1u); break; } } } } while (0)

struct XcdBarrier {
    unsigned* bar; unsigned x;
    volatile LAS unsigned* st;
};

__device__ __forceinline__ XcdBarrier xcd_barrier_post(unsigned* bar, volatile LAS unsigned* st) {
    XcdBarrier b; b.bar = bar; b.x = xb_xcc_id(); b.st = st;
    if (threadIdx.x == 0) (void)xb_add(&bar[XB_XCNT(b.x)], 1u);
    return b;
}
__device__ __forceinline__ void xcd_barrier_complete(unsigned* bar, unsigned x, unsigned& nloc, unsigned& nx) {
    const unsigned G = gridDim.x * gridDim.y * gridDim.z;
    unsigned sum, cnt, mine, sp = 0u;
    for (;;) {
        sum = 0u; cnt = 0u; mine = 0u;
#pragma unroll
        for (unsigned j = 0; j < 16; ++j) { const unsigned c = xb_ld(&bar[XB_XCNT(j)]); sum += c; cnt += (c > 0u) ? 1u : 0u; mine = (j == x) ? c : mine; }
        if (sum == G) break;
        __builtin_amdgcn_s_sleep(1);
        if ((++sp & 255u) == 0u) { if (xb_ld(&bar[XB_TMO])) break; if (sp > XB_SPIN_CAP) { atomicAdd(&bar[XB_TMO], 1u); break; } }
    }
    nloc = mine > 0u ? mine : 1u; nx = cnt > 0u ? cnt : 1u;
}

__device__ __forceinline__ void xcd_barrier(const XcdBarrier& b) {
    asm volatile("s_waitcnt vmcnt(0)" ::: "memory");
    __syncthreads();
    if (threadIdx.x == 0) {
        unsigned* bar = b.bar;
        __builtin_amdgcn_s_waitcnt(0);
        unsigned nloc = b.st[0], nx = b.st[1];
        if (nloc == 0u) { xcd_barrier_complete(bar, b.x, nloc, nx); b.st[0] = nloc; b.st[1] = nx; }
        const unsigned old = xb_add(&bar[XB_XSUB(b.x)], 1u);
        const unsigned gen = old / nloc;
        if (old + 1u == (gen + 1u) * nloc) {
            __builtin_amdgcn_fence(__ATOMIC_RELEASE, "agent");
            asm volatile("s_waitcnt vmcnt(0)" ::: "memory");
            const unsigned og = xb_add(&bar[XB_TOP], 1u);
            const unsigned tg = og / nx;
            if (og + 1u == (tg + 1u) * nx) xb_add(&bar[XB_TOPGEN], 1u);
            else XB_SPIN(xb_ld(&bar[XB_TOPGEN]) == tg, bar);
            __builtin_amdgcn_fence(__ATOMIC_ACQUIRE, "agent");
            xb_add(&bar[XB_XGEN(b.x)], 1u);
            asm volatile("s_waitcnt vmcnt(0)" ::: "memory");
        } else {
            XB_SPIN(xb_ld(&bar[XB_XGEN(b.x)]) == gen, bar);
            __builtin_amdgcn_fence(__ATOMIC_ACQUIRE, "agent");
            asm volatile("s_waitcnt vmcnt(0)" ::: "memory");
        }
    }
    __syncthreads();
}

constexpr size_t MiB = 1u << 20;
constexpr size_t WS_WIN = 0;
constexpr size_t WS_WO = 20 * MiB;
constexpr size_t WS_WQ = 28 * MiB;
constexpr size_t WS_XB = 48 * MiB;
constexpr size_t WS_XA = 112 * MiB;
constexpr size_t WS_X1 = 240 * MiB;
constexpr size_t WS_H = 368 * MiB;
constexpr size_t WS_Y = 512 * MiB;
constexpr size_t WS_Z = 576 * MiB;
constexpr size_t WS_QP = 368 * MiB;
constexpr size_t WS_KB = 44 * MiB;
constexpr size_t WS_EI = 704 * MiB;
constexpr size_t WS_GT = 720 * MiB;
constexpr size_t WS_U8 = 736 * MiB;
constexpr size_t WS_V8 = 800 * MiB;
constexpr size_t WS_X8 = 864 * MiB;
constexpr size_t WS_CTL = 896 * MiB;
constexpr size_t CTL_BYTES = 16384;
constexpr size_t WS_END = 897 * MiB;

struct Params { const float* in[16]; float* out; unsigned char* ws; };

__global__ void __launch_bounds__(NTHREADS, 2) mega_fwd(Params P) {
    extern __shared__ __attribute__((aligned(16))) unsigned char lds[];
    cg::grid_group grid = cg::this_grid();
    const float* x = P.in[0]; const float* w_in = P.in[1]; const float* w_o = P.in[2]; const float* sink = P.in[3]; const float* rpb = P.in[4]; const float* t5 = P.in[5];
    const float* ga = P.in[6]; const float* gb = P.in[7]; const float* l1g = P.in[8]; const float* l1b = P.in[9]; const float* l2g = P.in[10]; const float* l2b = P.in[11];
    const float* wq = P.in[12]; const float* keys = P.in[13]; const float* pu = P.in[14]; const float* pv = P.in[15];
    unsigned char* ws = P.ws;
    bf16_t* WinT = (bf16_t*)(ws + WS_WIN); bf16_t* WoT = (bf16_t*)(ws + WS_WO); bf16_t* WqT = (bf16_t*)(ws + WS_WQ);
    bf16_t* Xb = (bf16_t*)(ws + WS_XB); float* XA = (float*)(ws + WS_XA); float* X1 = (float*)(ws + WS_X1);
    bf16_t* H = (bf16_t*)(ws + WS_H); bf16_t* Y = (bf16_t*)(ws + WS_Y); float* Z = (float*)(ws + WS_Z); bf16_t* Qb = (bf16_t*)(ws + WS_QP); bf16_t* Kb = (bf16_t*)(ws + WS_KB);
    int* EI = (int*)(ws + WS_EI); float* GT = (float*)(ws + WS_GT);
    unsigned char* U8 = ws + WS_U8; unsigned char* V8 = ws + WS_V8; unsigned char* X8 = ws + WS_X8;

    volatile LAS unsigned* MISC = (volatile LAS unsigned*)((LAS unsigned char*)lds + (LDS_BYTES - 256));
    if (threadIdx.x < 4) MISC[threadIdx.x] = 0u;
    __syncthreads();
    const XcdBarrier bar = xcd_barrier_post((unsigned*)(ws + WS_CTL), MISC);
#define GRID_BAR() xcd_barrier(bar)
    phase_convert(make_ctx(lds), w_in, w_o, wq, x, pu, pv, WinT, WoT, WqT, Xb, U8, V8, keys, Kb);
    grid.sync();
#pragma unroll 1
    for (int l = 0; l < DEPTH; ++l) {
        const float* xin = (l == 0) ? x : XA;
        float* xout = (l == DEPTH - 1) ? P.out : XA;
        phase_gemm<pg8::EpiBf16<0>, true>(lds, Xb, WinT + (size_t)l * PROJ * D, PROJ, pg8::EpiBf16<0>{H, PROJ, nullptr, 0, 0, 1.f});
        GRID_BAR();
        phase_attn(make_ctx(lds), H, sink + l * 8, t5, rpb + (size_t)l * 8 * 15 * 31, Z);
        GRID_BAR();
        phase_rmsnorm(make_ctx(lds), Z, ga + l * 512, gb + l * 512, Y);
        GRID_BAR();
        phase_gemm<EpiZf32, true>(lds, Y, WoT + (size_t)l * D * D, D, EpiZf32{xin, Z});
        GRID_BAR();
        phase_ln(make_ctx(lds), Z, l1g + l * D, l1b + l * D, X1, Xb, X8);
        GRID_BAR();
        phase_gemm<pg8::EpiBf16<0>, true>(lds, Xb, WqT + (size_t)l * PQ * D, PQ, pg8::EpiBf16<0>{Qb, PQ, nullptr, 0, 0, 1.f});
        GRID_BAR();
        phase_topk(make_ctx(lds), Qb, Kb + (size_t)l * 8 * 2 * NKEYS * 128, EI, GT);
        GRID_BAR();
        phase_gather(make_ctx(lds), X1, X8, EI, GT, U8 + (size_t)l * NEXP * (D / 2), V8 + (size_t)l * NEXP * D, l2g + l * D, l2b + l * D, xout, Xb);
        if (l < DEPTH - 1) GRID_BAR();
    }
}

extern "C" void kernel_launch(void* const* d_in, const int* in_sizes, int n_in, void* d_out, int out_size, void* d_ws, size_t ws_size, hipStream_t stream) {
    static int grid = 0;
    if (grid == 0) {
        if (n_in != 16 || ws_size < WS_END || out_size != NTOK * D) { fprintf(stderr, "kernel_launch: unexpected shapes\n"); grid = -1; return; }
        int dev = 0, cus = 0, per_cu = 0;
        hipGetDevice(&dev);
        hipDeviceGetAttribute(&cus, hipDeviceAttributeMultiprocessorCount, dev);
        hipFuncSetAttribute((const void*)mega_fwd, hipFuncAttributeMaxDynamicSharedMemorySize, LDS_BYTES);
        hipOccupancyMaxActiveBlocksPerMultiprocessor(&per_cu, (const void*)mega_fwd, NTHREADS, LDS_BYTES);
        if (per_cu < 1) { fprintf(stderr, "kernel_launch: occupancy query says %d blocks/CU\n", per_cu); grid = -1; return; }
        grid = cus;
    }
    if (grid < 0) return;
    if (hipMemsetAsync((char*)d_ws + WS_CTL, 0, CTL_BYTES, stream) != hipSuccess) { fprintf(stderr, "kernel_launch: memset of the barrier words failed\n"); return; }
    Params P{};
    for (int i = 0; i < 16; ++i) P.in[i] = (const float*)d_in[i];
    P.out = (float*)d_out; P.ws = (unsigned char*)d_ws;
    void* args[] = {&P};
    hipError_t e = hipLaunchCooperativeKernel((const void*)mega_fwd, dim3(grid), dim3(NTHREADS), args, LDS_BYTES, stream);
    if (e != hipSuccess) fprintf(stderr, "cooperative launch failed: %s (grid %d)\n", hipGetErrorString(e), grid);
}
```

```cpp
#include <hip/hip_runtime.h>
#include <hip/hip_cooperative_groups.h>
#include <stdint.h>
#include <cstdio>
namespace cg = cooperative_groups;

typedef unsigned short bf16_t;
typedef short bf16x8 __attribute__((ext_vector_type(8)));
typedef float f32x4 __attribute__((ext_vector_type(4)));

constexpr int D = 1024, BATCH = 8, SEQ = 4096, DEPTH = 4, NTOK = BATCH * SEQ;
constexpr int HD = 64, PROJ = 2304;
constexpr int O1 = 512, O2 = 640, O3 = 768, O4 = 1280, O5 = 1792;
constexpr int PQ = 2048, NKEYS = 128, NEXP = 16384, TOPK = 16;
constexpr float LN_EPS = 1e-5f;
constexpr float NEGF = -1e30f;
constexpr float ALPHA = 1.6817928305074290f;

__device__ __forceinline__ bf16_t f2bf(float f) { unsigned u = __float_as_uint(f); return (bf16_t)((u + 0x7fffu + ((u >> 16) & 1u)) >> 16); }
__device__ __forceinline__ float bf2f(bf16_t h) { return __uint_as_float(((unsigned)h) << 16); }
__device__ __forceinline__ float wave_sum(float v) {
#pragma unroll
    for (int o = 1; o < 64; o <<= 1) v += __shfl_xor(v, o);
    return v;
}
__device__ __forceinline__ float wave_max(float v) {
#pragma unroll
    for (int o = 1; o < 64; o <<= 1) v = fmaxf(v, __shfl_xor(v, o));
    return v;
}


#define LAS __attribute__((address_space(3)))
typedef float f32x2 __attribute__((ext_vector_type(2)));
typedef unsigned u32x4 __attribute__((ext_vector_type(4)));
typedef unsigned u32x2 __attribute__((ext_vector_type(2)));
typedef float f32x16 __attribute__((ext_vector_type(16)));
constexpr float XS = 8.f, US = 64.f, VS = 16.f;
__device__ __forceinline__ unsigned pack4_fp8(f32x4 v, float sc) {
    v = v * sc;
#pragma unroll
    for (int i = 0; i < 4; ++i) v[i] = fminf(fmaxf(v[i], -448.f), 448.f);
    unsigned p = 0;
    p = __builtin_amdgcn_cvt_pk_fp8_f32(v[0], v[1], p, false);
    p = __builtin_amdgcn_cvt_pk_fp8_f32(v[2], v[3], p, true);
    return p;
}
constexpr int NTHREADS = 512, NWAVES = 8;
constexpr int LDS_BYTES = 147456;

struct Ctx { int tid, lane, wid, bid, G; unsigned char* lds; };
__device__ __forceinline__ Ctx make_ctx(unsigned char* lds) {
    Ctx c; int t = threadIdx.x; asm volatile("" : "+v"(t));
    c.tid = t; c.lane = t & 63; c.wid = __builtin_amdgcn_readfirstlane(t >> 6); c.bid = blockIdx.x; c.G = gridDim.x; c.lds = lds; return c;
}

__device__ __forceinline__ void transpose_item(const float* __restrict__ W, int K, int N, bf16_t* __restrict__ WT, float* scr, int item, int lane) {
    const int nblk = N / 32, kb = item / nblk, nb = item % nblk, k0 = 64 * kb, n0 = 32 * nb;
#pragma unroll 8
    for (int i = 0; i < 32; ++i) { const int kk = 2 * i + (lane >> 5); scr[kk * 33 + (lane & 31)] = W[(size_t)(k0 + kk) * N + n0 + (lane & 31)]; }
    __builtin_amdgcn_fence(__ATOMIC_RELEASE, "wavefront"); __builtin_amdgcn_wave_barrier(); __builtin_amdgcn_fence(__ATOMIC_ACQUIRE, "wavefront");
    const int c = lane & 7;
#pragma unroll
    for (int j = 0; j < 4; ++j) {
        const int n = (lane >> 3) + 8 * j; const float* sp = scr + (8 * c) * 33 + n;
        uint4 o;
        o.x = f2bf(sp[0 * 33]) | ((unsigned)f2bf(sp[1 * 33]) << 16); o.y = f2bf(sp[2 * 33]) | ((unsigned)f2bf(sp[3 * 33]) << 16);
        o.z = f2bf(sp[4 * 33]) | ((unsigned)f2bf(sp[5 * 33]) << 16); o.w = f2bf(sp[6 * 33]) | ((unsigned)f2bf(sp[7 * 33]) << 16);
        *(uint4*)(WT + (size_t)(n0 + n) * K + k0 + 8 * c) = o;
    }
    __builtin_amdgcn_fence(__ATOMIC_RELEASE, "wavefront"); __builtin_amdgcn_wave_barrier(); __builtin_amdgcn_fence(__ATOMIC_ACQUIRE, "wavefront");
}
__device__ __forceinline__ void phase_convert(const Ctx& c, const float* w_in, const float* w_o, const float* wq, const float* x, const float* pu, const float* pv,
                                              bf16_t* WinT, bf16_t* WoT, bf16_t* WqT, bf16_t* Xb, unsigned char* U8, unsigned char* V8, const float* keys, bf16_t* Kb) {
    float* scr = (float*)(c.lds + c.wid * 16384);
    const int gw = c.bid * NWAVES + c.wid, NGW = c.G * NWAVES;
    constexpr int I_IN = (D / 64) * (PROJ / 32), I_O = (D / 64) * (D / 32), I_Q = (D / 64) * (PQ / 32);
    constexpr int NIT = DEPTH * (I_IN + I_O + I_Q);
    for (int it = gw; it < NIT; it += NGW) {
        const int l = it / (I_IN + I_O + I_Q); int r = it % (I_IN + I_O + I_Q);
        if (r < I_IN) { transpose_item(w_in + (size_t)l * D * PROJ, D, PROJ, WinT + (size_t)l * PROJ * D, scr, r, c.lane); continue; } r -= I_IN;
        if (r < I_O) { transpose_item(w_o + (size_t)l * D * D, D, D, WoT + (size_t)l * D * D, scr, r, c.lane); continue; } r -= I_O;
        transpose_item(wq + (size_t)l * D * PQ, D, PQ, WqT + (size_t)l * PQ * D, scr, r, c.lane);
    }
    const size_t n4 = (size_t)NTOK * D / 4;
    for (size_t i = (size_t)c.bid * NTHREADS + c.tid; i < n4; i += (size_t)c.G * NTHREADS) {
        const f32x4 v = ((const f32x4*)x)[i];
        uint2 o; o.x = f2bf(v[0]) | ((unsigned)f2bf(v[1]) << 16); o.y = f2bf(v[2]) | ((unsigned)f2bf(v[3]) << 16);
        ((uint2*)Xb)[i] = o;
    }
    {
        const size_t k4 = (size_t)DEPTH * 8 * 2 * NKEYS * 128 / 4;
        for (size_t i = (size_t)c.bid * NTHREADS + c.tid; i < k4; i += (size_t)c.G * NTHREADS) {
            const f32x4 v = ((const f32x4*)keys)[i];
            uint2 o; o.x = f2bf(v[0]) | ((unsigned)f2bf(v[1]) << 16); o.y = f2bf(v[2]) | ((unsigned)f2bf(v[3]) << 16);
            ((uint2*)Kb)[i] = o;
        }
    }
    const size_t n32 = (size_t)DEPTH * NEXP * D / 32;
    for (size_t i = (size_t)c.bid * NTHREADS + c.tid; i < n32; i += (size_t)c.G * NTHREADS) {
        const f32x4* pa = (const f32x4*)pu + 8 * i; const f32x4* pb = (const f32x4*)pv + 8 * i;
        unsigned wa[4], wb[4];
#pragma unroll
        for (int k = 0; k < 4; ++k) {
            f32x4 a0 = pa[2 * k] * US, a1 = pa[2 * k + 1] * US, b0 = pb[2 * k] * VS, b1 = pb[2 * k + 1] * VS;
#pragma unroll
            for (int e = 0; e < 4; ++e) { a0[e] = fminf(fmaxf(a0[e], -6.f), 6.f); a1[e] = fminf(fmaxf(a1[e], -6.f), 6.f); b0[e] = fminf(fmaxf(b0[e], -6.f), 6.f); b1[e] = fminf(fmaxf(b1[e], -6.f), 6.f); }
            unsigned p = 0, r = 0;
            p = __builtin_amdgcn_cvt_scalef32_pk_fp4_f32(p, a0[0], a0[1], 1.0f, 0);
            p = __builtin_amdgcn_cvt_scalef32_pk_fp4_f32(p, a0[2], a0[3], 1.0f, 1);
            p = __builtin_amdgcn_cvt_scalef32_pk_fp4_f32(p, a1[0], a1[1], 1.0f, 2);
            p = __builtin_amdgcn_cvt_scalef32_pk_fp4_f32(p, a1[2], a1[3], 1.0f, 3);
            r = __builtin_amdgcn_cvt_scalef32_pk_fp4_f32(r, b0[0], b0[1], 1.0f, 0);
            r = __builtin_amdgcn_cvt_scalef32_pk_fp4_f32(r, b0[2], b0[3], 1.0f, 1);
            r = __builtin_amdgcn_cvt_scalef32_pk_fp4_f32(r, b1[0], b1[1], 1.0f, 2);
            r = __builtin_amdgcn_cvt_scalef32_pk_fp4_f32(r, b1[2], b1[3], 1.0f, 3);
            wa[k] = p; wb[k] = r;
        }
        uint4 oa, ob;
        oa.x = wa[0]; oa.y = wa[1]; oa.z = wa[2]; oa.w = wa[3]; ob.x = wb[0]; ob.y = wb[1]; ob.z = wb[2]; ob.w = wb[3];
        ((uint4*)U8)[i] = oa; ((uint4*)V8)[i] = ob;
    }
}


namespace pg8 {
#define PG8_LAS __attribute__((address_space(3)))
typedef unsigned short bf16_t;
typedef short bf16x8 __attribute__((ext_vector_type(8)));
typedef float f32x4 __attribute__((ext_vector_type(4)));
typedef unsigned u32x4 __attribute__((ext_vector_type(4)));
constexpr int BM = 256, BK = 64, HALF = 128, HTB = HALF * BK * 2  , STAGE_BYTES = 8 * HTB, NXCD = 8, WGM = 8;

__host__ __device__ __forceinline__ int lds_byte(int r, int c) { const int st = (r >> 4) * 2 + (c >> 5), rr = r & 15, cc = c & 31, ob = rr * 64 + cc * 2; return st * 1024 + (ob ^ (((ob >> 9) & 1) << 5)); }
__host__ __device__ __forceinline__ void stage_rc(int b, int& R, int& C) { const int st = b / 1024, sb = b % 1024, swz = sb ^ (((sb >> 9) & 1) << 5); R = (st >> 1) * 16 + swz / 64; C = (st & 1) * 32 + (swz % 64) / 2; }
__host__ __device__ __forceinline__ int perm32(int rho) { const int n = rho >> 4, i = rho & 15; return 8 * (i >> 2) + 4 * n + (i & 3); }

struct Unit { int pm, pn; };
struct Gemm { const bf16_t* A; const bf16_t* Bt; int M, N, K; };

struct StaticOrder {
    int nM, nN, nwg, G, c;
    __host__ __device__ void init(int M, int N, int G_, int c_) { nM = M / BM; nN = N / BM; nwg = nM * nN; G = G_; c = c_; }
    __host__ __device__ bool next(int i, Unit& u) const {
        const long L = (long)i * G + c; if (L >= nwg) return false;
        int wgid = (int)L; { const int q = nwg / NXCD, r = nwg % NXCD, xcd = wgid % NXCD, off = wgid / NXCD; wgid = (xcd < r ? xcd * (q + 1) : r * (q + 1) + (xcd - r) * q) + off; }
        const int nig = WGM * nN, gid = wgid / nig, fm = gid * WGM, gsz = (nM - fm) < WGM ? (nM - fm) : WGM;
        u.pm = fm + ((wgid % nig) % gsz); u.pn = (wgid % nig) / gsz; return true;
    }
    __device__ __forceinline__ void a_ready(const Unit&) const {}
    __device__ __forceinline__ void done(const Unit&) const {}
};

__device__ __forceinline__ unsigned cvt_pk_bf16(float lo, float hi) { unsigned r; asm volatile("v_cvt_pk_bf16_f32 %0, %1, %2" : "=v"(r) : "v"(lo), "v"(hi)); return r; }
typedef float f32x2 __attribute__((ext_vector_type(2)));
__device__ __forceinline__ f32x2 gelu_pk(f32x2 v) {
    const f32x2 av = __builtin_elementwise_abs(v), d = av * 0.2316418882f + 1.0f;
    f32x2 t; t.x = __builtin_amdgcn_rcpf(d.x); t.y = __builtin_amdgcn_rcpf(d.y);
    f32x2 q = t * 0.5307027145f + (-0.7265760135f); q = q * t + 0.7107068705f; q = q * t + (-0.142248368f); q = q * t + 0.127414796f; q = q * t;
    const f32x2 s = (v * v) * (-0.72134752044f);
    f32x2 e; e.x = __builtin_amdgcn_exp2f(s.x); e.y = __builtin_amdgcn_exp2f(s.y);
    const f32x2 m = v * (q * e), r = v - m;
    f32x2 o; o.x = v.x < 0.f ? m.x : r.x; o.y = v.y < 0.f ? m.y : r.y; return o;
}

template <int ACT  > struct EpiBf16 {
    static constexpr bool PERM = true, AFTER_DRAIN = false; static_assert(ACT == 0 || ACT == 1, "EpiBf16: ACT is 0 (none) or 1 (gelu_pk)");
    bf16_t* O; int ldc; const float* bias; int split_cols; size_t split_stride; float scale0;
    __device__ __forceinline__ void operator()(const f32x4 (&acc)[2][2][4][2], const Unit& u, int wr, int wc, int fr, int fq) const {
        const int row0 = u.pm * BM + wr * 64 + fr; int colt = u.pn * BM; bf16_t* base = O;
        float sc = 1.f; if (split_cols) { const int t = colt / split_cols; base += (size_t)t * split_stride; colt -= t * split_cols; if (t == 0) sc = scale0; }
        const int col0 = colt + wc * 32 + 8 * fq, bcol0 = u.pn * BM + wc * 32 + 8 * fq;
        f32x4 bv[2][2];
#pragma unroll
        for (int bj = 0; bj < 2; ++bj)
#pragma unroll
            for (int n = 0; n < 2; ++n) bv[bj][n] = bias ? *(const f32x4*)(bias + bcol0 + bj * HALF + 4 * n) : (f32x4){0.f, 0.f, 0.f, 0.f};
#pragma unroll
        for (int ai = 0; ai < 2; ++ai)
#pragma unroll
            for (int m = 0; m < 4; ++m) { bf16_t* rowp = base + (size_t)(row0 + ai * HALF + m * 16) * ldc + col0;
#pragma unroll
                for (int bj = 0; bj < 2; ++bj) { f32x4 v0 = acc[ai][bj][m][0] + bv[bj][0], v1 = acc[ai][bj][m][1] + bv[bj][1];
                    if (ACT == 1) { f32x2 a = gelu_pk((f32x2){v0[0], v0[1]}), b = gelu_pk((f32x2){v0[2], v0[3]}), c = gelu_pk((f32x2){v1[0], v1[1]}), d = gelu_pk((f32x2){v1[2], v1[3]});
                        v0 = (f32x4){a.x, a.y, b.x, b.y}; v1 = (f32x4){c.x, c.y, d.x, d.y}; }
                    v0 = v0 * sc; v1 = v1 * sc; u32x4 w; w.x = cvt_pk_bf16(v0[0], v0[1]); w.y = cvt_pk_bf16(v0[2], v0[3]); w.z = cvt_pk_bf16(v1[0], v1[1]); w.w = cvt_pk_bf16(v1[2], v1[3]);
                    *(u32x4*)(rowp + bj * HALF) = w; } }
    }
};

template <class Epi, class Sched, bool ALIGN_EPI = false, bool SP2 = false>
__device__ __forceinline__ void gemm_phase(PG8_LAS unsigned char* lds, const Gemm g, const Sched& S, const Epi& E) {
    int tid = threadIdx.x; asm volatile("" : "+v"(tid));
    const int wid = __builtin_amdgcn_readfirstlane(tid >> 6), lane = tid & 63, wr = wid >> 2, wc = wid & 3, fr = lane & 15, fq = lane >> 4;
    const int K = g.K, nt = K / BK;
    unsigned voffA[2], voffB[2];
#pragma unroll
    for (int i = 0; i < 2; ++i) { int R, C; stage_rc(tid * 16 + i * 8192, R, C); const int Rb = Epi::PERM ? ((R & ~31) + perm32(R & 31)) : R;
        voffA[i] = (unsigned)(R * K + C) * 2u; voffB[i] = (unsigned)(Rb * K + C) * 2u; }
    const size_t kstep = (size_t)(BK * 2);
    const size_t hstep = (size_t)HALF * K * 2;
    const size_t tstep = 2 * hstep;
    const unsigned ldsw = (unsigned)wid * 1024u;
    const int aoff = lds_byte(wr * 64 + fr, fq * 8), boff = lds_byte(wc * 32 + fr, fq * 8);
#define PG8_SA(b, h) (((b) * 2 + (h)) * HTB)
#define PG8_SB(b, h) ((4 + (b) * 2 + (h)) * HTB)
#define PG8_STAGE(bufoff, gbase, voff) do { _Pragma("unroll") for (int _i = 0; _i < 2; ++_i) \
        __builtin_amdgcn_global_load_lds((const unsigned*)((const char*)(gbase) + (voff)[_i]), (PG8_LAS unsigned*)(lds + (bufoff) + ldsw + _i * 8192), 16, 0, 0); } while (0)
#define PG8_LDA(dst, b, h) do { _Pragma("unroll") for (int m = 0; m < 4; ++m) _Pragma("unroll") for (int k = 0; k < 2; ++k) dst[m][k] = *(const PG8_LAS bf16x8*)(lds + PG8_SA(b, h) + aoff + m * 2048 + k * 1024); } while (0)
#define PG8_LDB(dst, b, h) do { _Pragma("unroll") for (int n = 0; n < 2; ++n) _Pragma("unroll") for (int k = 0; k < 2; ++k) dst[n][k] = *(const PG8_LAS bf16x8*)(lds + PG8_SB(b, h) + boff + n * 2048 + k * 1024); } while (0)
#define PG8_MMA(ai, bj, At, Bt) do { __builtin_amdgcn_s_setprio(1); _Pragma("unroll") for (int m = 0; m < 4; ++m) _Pragma("unroll") for (int n = 0; n < 2; ++n) _Pragma("unroll") for (int k = 0; k < 2; ++k) \
        acc[ai][bj][m][n] = __builtin_amdgcn_mfma_f32_16x16x32_bf16(Bt[n][k], At[m][k], acc[ai][bj][m][n], 0, 0, 0); __builtin_amdgcn_s_setprio(0); } while (0)
#define PG8_WAIT_V(n) asm volatile("s_waitcnt vmcnt(" #n ")" ::: "memory")
#define PG8_WAIT_L(n) asm volatile("s_waitcnt lgkmcnt(" #n ")" ::: "memory")
#define PG8_BAR __builtin_amdgcn_s_barrier()
#define PG8_SCHED __builtin_amdgcn_sched_barrier(0)
    Unit cur, nxt; int ui = 0;
    if (!S.next(0, cur)) return;
    f32x4 acc[2][2][4][2];
#pragma unroll
    for (int a = 0; a < 2; ++a)
#pragma unroll
        for (int b = 0; b < 2; ++b)
#pragma unroll
            for (int m = 0; m < 4; ++m)
#pragma unroll
                for (int n = 0; n < 2; ++n) acc[a][b][m][n] = (f32x4){0.f, 0.f, 0.f, 0.f};
    bf16x8 At[4][2], B0[2][2], B1[2][2];
    const char* cA = (const char*)g.A + (size_t)cur.pm * tstep; const char* cB = (const char*)g.Bt + (size_t)cur.pn * tstep;
    S.a_ready(cur);
    if constexpr (SP2) {
        PG8_STAGE(PG8_SB(0, 0), cB, voffB); PG8_STAGE(PG8_SB(0, 1), cB + hstep, voffB); PG8_STAGE(PG8_SA(0, 0), cA, voffA); PG8_STAGE(PG8_SA(0, 1), cA + hstep, voffA);
        if (wr == 1) PG8_BAR;
        PG8_WAIT_V(2); PG8_BAR;
        PG8_STAGE(PG8_SB(1, 0), cB + kstep, voffB); PG8_STAGE(PG8_SA(1, 0), cA + kstep, voffA); PG8_STAGE(PG8_SB(1, 1), cB + hstep + kstep, voffB);
        PG8_WAIT_V(6); PG8_BAR;
    } else {
        PG8_STAGE(PG8_SB(0, 0), cB, voffB); PG8_STAGE(PG8_SA(0, 0), cA, voffA); PG8_STAGE(PG8_SB(0, 1), cB + hstep, voffB); PG8_STAGE(PG8_SA(0, 1), cA + hstep, voffA);
        if (wr == 1) PG8_BAR;
        PG8_WAIT_V(4); PG8_BAR;
        PG8_STAGE(PG8_SB(1, 0), cB + kstep, voffB); PG8_STAGE(PG8_SA(1, 0), cA + kstep, voffA); PG8_STAGE(PG8_SB(1, 1), cB + hstep + kstep, voffB);
        PG8_WAIT_V(6); PG8_BAR;
    }
    for (;;) {
        const bool has_next = S.next(ui + 1, nxt);
        const char* nA = has_next ? (const char*)g.A + (size_t)nxt.pm * tstep : cA; const char* nB = has_next ? (const char*)g.Bt + (size_t)nxt.pn * tstep : cB;
        for (int t = 0; t < nt; t += 2) {
            const bool last = (t == nt - 2);
            const char* a1 = cA + (size_t)(t + 1) * kstep;
            const char* a2 = last ? nA : cA + (size_t)(t + 2) * kstep; const char* b2 = last ? nB : cB + (size_t)(t + 2) * kstep;
            const char* a3 = a2 + kstep; const char* b3 = b2 + kstep;
            if (last && has_next) S.a_ready(nxt);
            if constexpr (SP2) {
            PG8_LDB(B0, 0, 0); PG8_LDB(B1, 0, 1); PG8_SCHED; PG8_LDA(At, 0, 0); PG8_STAGE(PG8_SA(1, 1), a1 + hstep, voffA);
            PG8_WAIT_V(8); PG8_WAIT_L(0); PG8_BAR; PG8_MMA(0, 0, At, B0); PG8_MMA(0, 1, At, B1); PG8_BAR; PG8_SCHED;
            PG8_LDA(At, 0, 1); PG8_STAGE(PG8_SB(0, 0), b2, voffB); PG8_STAGE(PG8_SB(0, 1), b2 + hstep, voffB); PG8_STAGE(PG8_SA(0, 0), a2, voffA);
            PG8_WAIT_V(8); PG8_WAIT_L(0); PG8_BAR; PG8_MMA(1, 0, At, B0); PG8_MMA(1, 1, At, B1); PG8_BAR; PG8_SCHED;
            PG8_LDB(B0, 1, 0); PG8_LDB(B1, 1, 1); PG8_SCHED; PG8_LDA(At, 1, 0); PG8_STAGE(PG8_SA(0, 1), a2 + hstep, voffA);
            PG8_WAIT_V(8); PG8_WAIT_L(0); PG8_BAR; PG8_MMA(0, 0, At, B0); PG8_MMA(0, 1, At, B1); PG8_BAR; PG8_SCHED;
            PG8_LDA(At, 1, 1); PG8_STAGE(PG8_SB(1, 0), b3, voffB); PG8_STAGE(PG8_SB(1, 1), b3 + hstep, voffB); PG8_STAGE(PG8_SA(1, 0), a3, voffA);
            PG8_WAIT_V(8); PG8_WAIT_L(0); PG8_BAR; PG8_MMA(1, 0, At, B0); PG8_MMA(1, 1, At, B1); PG8_BAR; PG8_SCHED;
            } else {
            PG8_LDB(B0, 0, 0); PG8_SCHED; PG8_LDA(At, 0, 0); PG8_STAGE(PG8_SA(1, 1), a1 + hstep, voffA);
            PG8_WAIT_L(8); PG8_BAR; PG8_WAIT_L(0); PG8_MMA(0, 0, At, B0); PG8_BAR; PG8_SCHED;
            PG8_LDB(B1, 0, 1); PG8_STAGE(PG8_SB(0, 0), b2, voffB);
            PG8_BAR; PG8_WAIT_L(0); PG8_MMA(0, 1, At, B1); PG8_BAR;
            PG8_LDA(At, 0, 1); PG8_STAGE(PG8_SA(0, 0), a2, voffA);
            PG8_BAR; PG8_WAIT_L(0); PG8_MMA(1, 0, At, B0); PG8_BAR; PG8_SCHED;
            PG8_STAGE(PG8_SB(0, 1), b2 + hstep, voffB);
            PG8_WAIT_V(6); PG8_BAR; PG8_MMA(1, 1, At, B1); PG8_BAR;
            PG8_LDB(B0, 1, 0); PG8_SCHED; PG8_LDA(At, 1, 0); PG8_STAGE(PG8_SA(0, 1), a2 + hstep, voffA);
            PG8_WAIT_L(8); PG8_BAR; PG8_WAIT_L(0); PG8_MMA(0, 0, At, B0); PG8_BAR; PG8_SCHED;
            PG8_LDB(B1, 1, 1); PG8_STAGE(PG8_SB(1, 0), b3, voffB);
            PG8_BAR; PG8_WAIT_L(0); PG8_MMA(0, 1, At, B1); PG8_BAR;
            PG8_LDA(At, 1, 1); PG8_STAGE(PG8_SA(1, 0), a3, voffA);
            PG8_BAR; PG8_WAIT_L(0); PG8_MMA(1, 0, At, B0); PG8_BAR; PG8_SCHED;
            PG8_STAGE(PG8_SB(1, 1), b3 + hstep, voffB);
            PG8_WAIT_V(6); PG8_BAR; PG8_MMA(1, 1, At, B1); PG8_BAR;
            }
        }
        if constexpr (ALIGN_EPI) { if (wr == 0) PG8_BAR; }
        if constexpr (!Epi::AFTER_DRAIN) { E(acc, cur, wr, wc, fr, fq); S.done(cur); }
        if (!has_next) break;
#pragma unroll
        for (int a = 0; a < 2; ++a)
#pragma unroll
            for (int b = 0; b < 2; ++b)
#pragma unroll
                for (int m = 0; m < 4; ++m)
#pragma unroll
                    for (int n = 0; n < 2; ++n) acc[a][b][m][n] = (f32x4){0.f, 0.f, 0.f, 0.f};
        cur = nxt; cA = nA; cB = nB; ++ui;
        if constexpr (ALIGN_EPI) { if (wr == 1) PG8_BAR; }
    }
    PG8_WAIT_V(0);
    if constexpr (!ALIGN_EPI) { if (wr == 0) PG8_BAR; }
    PG8_BAR;
    if constexpr (Epi::AFTER_DRAIN) { E.fused(acc, cur, wr, wc, fr, fq, lds, wid, lane); S.done(cur); }
#undef PG8_SA
#undef PG8_SB
#undef PG8_STAGE
#undef PG8_LDA
#undef PG8_LDB
#undef PG8_MMA
#undef PG8_WAIT_V
#undef PG8_WAIT_L
#undef PG8_BAR
#undef PG8_SCHED
}
}
struct EpiZf32 {
    static constexpr bool PERM = false, AFTER_DRAIN = false;
    const float* x; float* Z;
    __device__ __forceinline__ void operator()(const pg8::f32x4 (&acc)[2][2][4][2], const pg8::Unit& u, int wr, int wc, int fr, int fq) const {
#pragma unroll
        for (int ai = 0; ai < 2; ++ai)
#pragma unroll
            for (int m = 0; m < 4; ++m) {
                const size_t rowoff = (size_t)(u.pm * 256 + ai * 128 + wr * 64 + m * 16 + fr) * D + u.pn * 256 + wc * 32 + 4 * fq;
#pragma unroll
                for (int bj = 0; bj < 2; ++bj)
#pragma unroll
                    for (int n = 0; n < 2; ++n) {
                        const size_t i = rowoff + bj * 128 + n * 16;
                        const pg8::f32x4 xv = *(const pg8::f32x4*)(x + i);
                        *(pg8::f32x4*)(Z + i) = xv * ALPHA + acc[ai][bj][m][n];
                    }
            }
    }
};
template <class Epi, bool ALIGN>
__device__ __forceinline__ void phase_gemm(unsigned char* lds, const bf16_t* A, const bf16_t* Bt, int N, const Epi& E) {
    pg8::Gemm g{A, Bt, NTOK, N, D};
    pg8::StaticOrder S; S.init(NTOK, N, (int)gridDim.x, (int)blockIdx.x);
    pg8::gemm_phase<Epi, pg8::StaticOrder, ALIGN, true>((PG8_LAS unsigned char*)lds, g, S, E);
}

struct EpiH { bf16_t* H; __device__ void operator()(int r, int c, float v) const { H[(size_t)r * PROJ + c] = f2bf(v); } };
struct EpiZ { const float* x; float* Z; __device__ void operator()(int r, int c, float v) const { size_t i = (size_t)r * D + c; Z[i] = ALPHA * x[i] + v; } };
struct EpiQ { bf16_t* Q; __device__ void operator()(int r, int c, float v) const { Q[(size_t)r * PQ + c] = f2bf(v); } };

template <class Epi, int N, int K>
__device__ __forceinline__ void phase_gemm_simple(const Ctx& c, const bf16_t* __restrict__ A, const bf16_t* __restrict__ Bt, Epi epi) {
    const int half = c.tid >> 8, tid = c.tid & 255, lane = c.lane, wid = tid >> 6, wm = wid >> 1, wn = wid & 1;
    bf16_t* sA = (bf16_t*)(c.lds + half * 20480);
    bf16_t* sB = sA + 128 * 40;
    constexpr int nN = N / 128, NT = (NTOK / 128) * nN;
    for (int t0 = c.bid * 2; t0 < NT; t0 += c.G * 2) {
        const int t = t0 + half; const bool live = t < NT;
        const int bm = (t / nN) * 128, bn = (t % nN) * 128;
        f32x4 acc[4][4];
#pragma unroll
        for (int i = 0; i < 4; ++i)
#pragma unroll
            for (int j = 0; j < 4; ++j) acc[i][j] = (f32x4){0.f, 0.f, 0.f, 0.f};
        for (int k0 = 0; k0 < K; k0 += 32) {
            if (live) {
#pragma unroll
                for (int i = 0; i < 2; ++i) {
                    const int ch = tid + i * 256, r = ch >> 2, cc = (ch & 3) * 8;
                    *(uint4*)&sA[r * 40 + cc] = *(const uint4*)&A[(size_t)(bm + r) * K + k0 + cc];
                    *(uint4*)&sB[r * 40 + cc] = *(const uint4*)&Bt[(size_t)(bn + r) * K + k0 + cc];
                }
            }
            __syncthreads();
            bf16x8 a[4], b[4];
#pragma unroll
            for (int i = 0; i < 4; ++i) {
                a[i] = *(const bf16x8*)&sA[(wm * 64 + i * 16 + (lane & 15)) * 40 + (lane >> 4) * 8];
                b[i] = *(const bf16x8*)&sB[(wn * 64 + i * 16 + (lane & 15)) * 40 + (lane >> 4) * 8];
            }
#pragma unroll
            for (int i = 0; i < 4; ++i)
#pragma unroll
                for (int j = 0; j < 4; ++j) acc[i][j] = __builtin_amdgcn_mfma_f32_16x16x32_bf16(a[i], b[j], acc[i][j], 0, 0, 0);
            __syncthreads();
        }
        if (live) {
#pragma unroll
            for (int i = 0; i < 4; ++i)
#pragma unroll
                for (int j = 0; j < 4; ++j)
#pragma unroll
                    for (int r = 0; r < 4; ++r) epi(bm + wm * 64 + i * 16 + (lane >> 4) * 4 + r, bn + wn * 64 + j * 16 + (lane & 15), acc[i][j][r]);
        }
    }
}

__device__ __forceinline__ int t5_bucket(int rel) {
    const int n = rel < 0 ? -rel : rel;
    int v;
    if (n < 8) v = n;
    else { int k = 0; k += (n >= 12); k += (n >= 16); k += (n >= 23); k += (n >= 32); k += (n >= 46); k += (n >= 64); k += (n >= 91); v = 8 + k; }
    return (rel > 0 ? 16 : 0) + v;
}
__device__ __forceinline__ float dot64_bf16(const float* qs, const bf16_t* krow) {
    float s = 0.f;
#pragma unroll
    for (int c = 0; c < 8; ++c) {
        const uint4 w = ((const uint4*)krow)[c];
        const unsigned ww[4] = {w.x, w.y, w.z, w.w};
#pragma unroll
        for (int e = 0; e < 4; ++e) { s += qs[c * 8 + 2 * e] * __uint_as_float(ww[e] << 16); s += qs[c * 8 + 2 * e + 1] * __uint_as_float(ww[e] & 0xffff0000u); }
    }
    return s;
}
#define WAVE_LDS_SYNC() do { __builtin_amdgcn_fence(__ATOMIC_RELEASE, "wavefront"); __builtin_amdgcn_wave_barrier(); __builtin_amdgcn_fence(__ATOMIC_ACQUIRE, "wavefront"); } while (0)

__device__ __forceinline__ void phase_attn_naive(const Ctx& c, const bf16_t* __restrict__ H, const float* __restrict__ sink, const float* __restrict__ t5, const float* __restrict__ rpb, float* __restrict__ Yraw) {
    float* qsh = (float*)(c.lds + c.wid * 256);
    const int lane = c.lane;
    const int gw = c.bid * NWAVES + c.wid, NGW = c.G * NWAVES;
    for (int item = gw; item < NTOK * 16; item += NGW) {
        const int tok = item >> 4, hh = item & 15;
        const int b = tok / SEQ, tt = tok % SEQ;
        if (hh < 8) {
            const int hq = hh, kvh = hq >> 2;
            qsh[lane] = bf2f(H[(size_t)tok * PROJ + hq * HD + lane]);
            WAVE_LDS_SYNC();
            float s[5];
#pragma unroll
            for (int i = 0; i < 5; ++i) {
                const int j = lane + 64 * i, rel = j - 128, kp = tt + rel;
                const bool valid = (rel <= 128) && kp >= 0 && kp < SEQ;
                float v = NEGF;
                if (valid) {
                    const bf16_t* krow = H + (size_t)(b * SEQ + kp) * PROJ + O1 + kvh * HD;
                    v = dot64_bf16(qsh, krow) * 0.125f + t5[t5_bucket(rel) * 8 + hq];
                }
                s[i] = v;
            }
            const float sk = sink[hq];
            float m = fmaxf(fmaxf(fmaxf(s[0], s[1]), fmaxf(s[2], s[3])), s[4]);
            m = fmaxf(wave_max(m), sk);
            float p[5], sum = 0.f;
#pragma unroll
            for (int i = 0; i < 5; ++i) { p[i] = expf(s[i] - m); sum += p[i]; }
            sum = wave_sum(sum) + expf(sk - m);
            const float inv = 1.f / sum;
            float acc = 0.f;
#pragma unroll
            for (int i = 0; i < 5; ++i) {
                for (int jj = 0; jj < 64; ++jj) {
                    const float pj = __shfl(p[i], jj);
                    const int rel = jj + 64 * i - 128; const int kp = tt + rel;
                    if (rel > 128 || kp < 0 || kp >= SEQ) continue;
                    acc += pj * bf2f(H[(size_t)(b * SEQ + kp) * PROJ + O2 + kvh * HD + lane]);
                }
            }
            Yraw[(size_t)tok * D + hq * HD + lane] = acc * inv;
        } else {
            const int hb = hh - 8, r = tt >> 6, cc = tt & 63;
            int rs = r - 4; rs = rs < 0 ? 0 : (rs > 56 ? 56 : rs);
            int cs = cc - 8; cs = cs < 0 ? 0 : (cs > 48 ? 48 : cs);
            qsh[lane] = bf2f(H[(size_t)tok * PROJ + O3 + hb * HD + lane]);
            WAVE_LDS_SYNC();
            float s[2];
#pragma unroll
            for (int i = 0; i < 2; ++i) {
                const int j = lane + 64 * i, kr = rs + (j >> 4), kc = cs + (j & 15);
                const bf16_t* krow = H + (size_t)(b * SEQ + kr * 64 + kc) * PROJ + O4 + hb * HD;
                const int dr = kr - r + 7; int dc = kc - cc; dc = dc < -15 ? -15 : (dc > 15 ? 15 : dc); dc += 15;
                s[i] = dot64_bf16(qsh, krow) * 0.125f + rpb[(hb * 15 + dr) * 31 + dc];
            }
            const float m = wave_max(fmaxf(s[0], s[1]));
            float p[2]; p[0] = expf(s[0] - m); p[1] = expf(s[1] - m);
            const float inv = 1.f / wave_sum(p[0] + p[1]);
            float acc = 0.f;
#pragma unroll
            for (int i = 0; i < 2; ++i)
                for (int jj = 0; jj < 64; ++jj) {
                    const float pj = __shfl(p[i], jj);
                    const int j = jj + 64 * i, kr = rs + (j >> 4), kc = cs + (j & 15);
                    acc += pj * bf2f(H[(size_t)(b * SEQ + kr * 64 + kc) * PROJ + O5 + hb * HD + lane]);
                }
            Yraw[(size_t)tok * D + 512 + hb * HD + lane] = acc * inv;
        }
        WAVE_LDS_SYNC();
    }
}


struct AttnState { float m, l; f32x16 o0, o1; };
__device__ __forceinline__ void attn_state_init(AttnState& st) {
    st.m = -1e30f; st.l = 0.f;
#pragma unroll
    for (int r = 0; r < 16; ++r) { st.o0[r] = 0.f; st.o1[r] = 0.f; }
}
__device__ __forceinline__ void attn_stage_kv(const Ctx& c, LAS unsigned char* Ks, LAS unsigned char* VT, const bf16_t* __restrict__ H, int b, int tok0, int koff, int voff) {
#pragma unroll
    for (int i = 0; i < 6; ++i) {
        const int ch = c.tid + NTHREADS * i, row = ch >> 3, cc = ch & 7;
        int t = tok0 + row; t = t < 0 ? 0 : (t > SEQ - 1 ? SEQ - 1 : t);
        const bf16_t* src = H + (size_t)(b * SEQ + t) * PROJ;
        const u32x4 kv = *(const u32x4*)(src + koff + cc * 8);
        const u32x4 vv = *(const u32x4*)(src + voff + cc * 8);
        *(LAS u32x4*)(Ks + row * 128 + ((cc ^ (row & 7)) << 4)) = kv;
        LAS bf16_t* vt = (LAS bf16_t*)VT + (cc * 8) * 388 + row;
#pragma unroll
        for (int k = 0; k < 4; ++k) { vt[(2 * k) * 388] = (bf16_t)(vv[k] & 0xffffu); vt[(2 * k + 1) * 388] = (bf16_t)(vv[k] >> 16); }
    }
}
__device__ __forceinline__ void attn_qk(f32x16& s, const bf16x8 (&qf)[4], const LAS unsigned char* Ks, int kt, int r32, int hh) {
#pragma unroll
    for (int r = 0; r < 16; ++r) s[r] = 0.f;
#pragma unroll
    for (int ks = 0; ks < 4; ++ks) {
        const bf16x8 a = *(const LAS bf16x8*)(Ks + (32 * kt + r32) * 128 + (((2 * ks + hh) ^ (r32 & 7)) << 4));
        s = __builtin_amdgcn_mfma_f32_32x32x16_bf16(a, qf[ks], s, 0, 0, 0);
    }
}
__device__ __forceinline__ void attn_softmax_pv(AttnState& st, f32x16& s, const LAS unsigned char* VT, int kt, int r32, int hh) {
    float tmax = s[0];
#pragma unroll
    for (int r = 1; r < 16; ++r) tmax = fmaxf(tmax, s[r]);
    tmax = fmaxf(tmax, __shfl_xor(tmax, 32));
    const float mn = fmaxf(st.m, tmax), alpha = __expf(st.m - mn);
    st.m = mn;
    float psum = 0.f;
#pragma unroll
    for (int r = 0; r < 16; ++r) { s[r] = __expf(s[r] - mn); psum += s[r]; }
    st.l = st.l * alpha + psum;
#pragma unroll
    for (int r = 0; r < 16; ++r) { st.o0[r] *= alpha; st.o1[r] *= alpha; }
    bf16x8 pb[2];
#pragma unroll
    for (int s2 = 0; s2 < 2; ++s2)
#pragma unroll
        for (int j = 0; j < 8; ++j) pb[s2][j] = (short)f2bf(s[8 * s2 + j]);
#pragma unroll
    for (int s2 = 0; s2 < 2; ++s2) {
        const LAS unsigned char* vp0 = VT + (r32 * 388 + 32 * kt + 16 * s2 + 4 * hh) * 2;
        const LAS unsigned char* vp1 = vp0 + 32 * 388 * 2;
        const u32x2 a0 = *(const LAS u32x2*)vp0, a1 = *(const LAS u32x2*)(vp0 + 16);
        const u32x2 b0 = *(const LAS u32x2*)vp1, b1 = *(const LAS u32x2*)(vp1 + 16);
        const u32x4 fa = {a0[0], a0[1], a1[0], a1[1]}, fb = {b0[0], b0[1], b1[0], b1[1]};
        st.o0 = __builtin_amdgcn_mfma_f32_32x32x16_bf16(__builtin_bit_cast(bf16x8, fa), pb[s2], st.o0, 0, 0, 0);
        st.o1 = __builtin_amdgcn_mfma_f32_32x32x16_bf16(__builtin_bit_cast(bf16x8, fb), pb[s2], st.o1, 0, 0, 0);
    }
}
__device__ __forceinline__ void attn_store(const AttnState& st, float scale, float* __restrict__ yrow  , int hh) {
#pragma unroll
    for (int g4 = 0; g4 < 4; ++g4) {
        f32x4 a, b;
#pragma unroll
        for (int e = 0; e < 4; ++e) { a[e] = st.o0[4 * g4 + e] * scale; b[e] = st.o1[4 * g4 + e] * scale; }
        *(f32x4*)(yrow + 8 * g4 + 4 * hh) = a;
        *(f32x4*)(yrow + 32 + 8 * g4 + 4 * hh) = b;
    }
}
__device__ __forceinline__ void phase_attn(const Ctx& c, const bf16_t* __restrict__ H, const float* __restrict__ sink, const float* __restrict__ t5, const float* __restrict__ rpb, float* __restrict__ Yraw) {
    LAS unsigned char* Ks = (LAS unsigned char*)c.lds;
    LAS unsigned char* VT = Ks + 49152;
    LAS float* TB = (LAS float*)(Ks + 98816);
    const int lane = c.lane, r32 = lane & 31, hh = lane >> 5, w = c.wid;
    constexpr int NWIN = BATCH * 2 * (SEQ / 128), NNA = BATCH * 8 * 16;
    for (int u = c.bid; u < NWIN + NNA; u += c.G) {
        __syncthreads();
        if (u < NWIN) {
            const int b = u / (2 * (SEQ / 128)), kvh = (u / (SEQ / 128)) & 1, n = u % (SEQ / 128);
            attn_stage_kv(c, Ks, VT, H, b, 128 * (n - 1), O1 + kvh * HD, O2 + kvh * HD);
            for (int i = c.tid; i < 511 * 4; i += NTHREADS) {
                const int rel = (i >> 2) - 255, g = i & 3;
                TB[i] = (rel >= -128 && rel <= 128) ? t5[t5_bucket(rel) * 8 + kvh * 4 + g] : -INFINITY;
            }
            __syncthreads();
            const int g = w >> 1, hq = kvh * 4 + g;
            const float sk = sink[hq];
#pragma unroll 1
            for (int qi = 0; qi < 2; ++qi) {
                const int qt = 2 * (w & 1) + qi, i0 = 32 * qt;
                const int tok = b * SEQ + 128 * n + i0 + r32;
                bf16x8 qf[4];
#pragma unroll
                for (int ks = 0; ks < 4; ++ks) qf[ks] = *(const bf16x8*)(H + (size_t)tok * PROJ + hq * HD + 16 * ks + 8 * hh);
                AttnState st; attn_state_init(st);
                int kt0 = qt, kt1 = qt + 8;
                if (n == 0 && kt0 < 4) kt0 = 4;
                if (n == SEQ / 128 - 1 && kt1 > 7) kt1 = 7;
#pragma unroll 1
                for (int kt = kt0; kt <= kt1; ++kt) {
                    f32x16 s; attn_qk(s, qf, Ks, kt, r32, hh);
                    const LAS float* tb = TB + (32 * kt + 4 * hh - (i0 + r32) + 127) * 4 + g;
#pragma unroll
                    for (int r = 0; r < 16; ++r) s[r] = s[r] * 0.125f + tb[((r & 3) + 8 * (r >> 2)) * 4];
                    attn_softmax_pv(st, s, VT, kt, r32, hh);
                }
                const float l = st.l + __shfl_xor(st.l, 32);
                const float mf = fmaxf(st.m, sk), ef = __expf(st.m - mf);
                const float scale = ef / (l * ef + __expf(sk - mf));
                attn_store(st, scale, Yraw + (size_t)tok * D + hq * HD, hh);
            }
        } else {
            const int v = u - NWIN, b = v / (8 * 16), hb = (v / 16) & 7, R0 = 4 * (v & 15);
            int kr0 = R0 - 4; kr0 = kr0 < 0 ? 0 : (kr0 > 56 ? 56 : kr0);
            const int r = R0 + (w >> 1), cq = 32 * (w & 1) + r32;
            int rs = r - 4; rs = rs < 0 ? 0 : (rs > 56 ? 56 : rs);
            int cs = cq - 8; cs = cs < 0 ? 0 : (cs > 48 ? 48 : cs);
            const int tok = b * SEQ + r * 64 + cq;
            bf16x8 qf[4];
#pragma unroll
            for (int ks = 0; ks < 4; ++ks) qf[ks] = *(const bf16x8*)(H + (size_t)tok * PROJ + O3 + hb * HD + 16 * ks + 8 * hh);
            AttnState st; attn_state_init(st);
#pragma unroll 1
            for (int pass = 0; pass < 2; ++pass) {
                if (pass) __syncthreads();
                attn_stage_kv(c, Ks, VT, H, b, (kr0 + 6 * pass) * 64, O4 + hb * HD, O5 + hb * HD);
                if (pass == 0) for (int i = c.tid; i < 15 * 31; i += NTHREADS) TB[i] = rpb[hb * 15 * 31 + i];
                __syncthreads();
#pragma unroll 1
                for (int kt = 0; kt < 12; ++kt) {
                    const int kr = kr0 + 6 * pass + (kt >> 1);
                    if (kr < rs || kr >= rs + 8) continue;
                    f32x16 s; attn_qk(s, qf, Ks, kt, r32, hh);
                    const LAS float* tb = TB + (kr - r + 7) * 31 + 15;
                    const int kc0 = 32 * (kt & 1) + 4 * hh;
#pragma unroll
                    for (int rr = 0; rr < 16; ++rr) {
                        const int kc = kc0 + (rr & 3) + 8 * (rr >> 2);
                        int dc = kc - cq; dc = dc < -15 ? -15 : (dc > 15 ? 15 : dc);
                        const bool ok = (kc >= cs) && (kc < cs + 16);
                        s[rr] = ok ? s[rr] * 0.125f + tb[dc] : -INFINITY;
                    }
                    attn_softmax_pv(st, s, VT, kt, r32, hh);
                }
            }
            const float l = st.l + __shfl_xor(st.l, 32);
            attn_store(st, 1.f / l, Yraw + (size_t)tok * D + 512 + hb * HD, hh);
        }
    }
}

__device__ __forceinline__ void phase_rmsnorm(const Ctx& c, const float* __restrict__ Yraw, const float* __restrict__ ga, const float* __restrict__ gb, bf16_t* __restrict__ Y) {
    const int lane = c.lane, gw = c.bid * NWAVES + c.wid, NGW = c.G * NWAVES;
    for (int tok = gw; tok < NTOK; tok += NGW) {
        const float* row = Yraw + (size_t)tok * D;
        float a[8], bb[8], sa = 0.f, sb = 0.f;
#pragma unroll
        for (int i = 0; i < 8; ++i) { a[i] = row[lane + 64 * i]; bb[i] = row[512 + lane + 64 * i]; sa += a[i] * a[i]; sb += bb[i] * bb[i]; }
        const float ra = rsqrtf(wave_sum(sa) * (1.f / 512.f) + LN_EPS), rb = rsqrtf(wave_sum(sb) * (1.f / 512.f) + LN_EPS);
#pragma unroll
        for (int i = 0; i < 8; ++i) {
            Y[(size_t)tok * D + lane + 64 * i] = f2bf(a[i] * ra * ga[lane + 64 * i]);
            Y[(size_t)tok * D + 512 + lane + 64 * i] = f2bf(bb[i] * rb * gb[lane + 64 * i]);
        }
    }
}

__device__ __forceinline__ void ln_store_row(f32x4 (&v)[4], int lane, const float* __restrict__ g, const float* __restrict__ bta, float* __restrict__ orow, bf16_t* __restrict__ obrow, unsigned char* __restrict__ o8row) {
    float s = 0.f;
#pragma unroll
    for (int j = 0; j < 4; ++j) s += (v[j][0] + v[j][1]) + (v[j][2] + v[j][3]);
    const float mean = wave_sum(s) * (1.f / D); float s2 = 0.f;
#pragma unroll
    for (int j = 0; j < 4; ++j) { v[j] = v[j] - mean; s2 += (v[j][0] * v[j][0] + v[j][1] * v[j][1]) + (v[j][2] * v[j][2] + v[j][3] * v[j][3]); }
    const float rstd = rsqrtf(wave_sum(s2) * (1.f / D) + LN_EPS);
#pragma unroll
    for (int j = 0; j < 4; ++j) {
        const f32x4 gg = ((const f32x4*)g)[lane + 64 * j], be = ((const f32x4*)bta)[lane + 64 * j];
        const f32x4 o = v[j] * rstd * gg + be;
        ((f32x4*)orow)[lane + 64 * j] = o;
        uint2 ob; ob.x = f2bf(o[0]) | ((unsigned)f2bf(o[1]) << 16); ob.y = f2bf(o[2]) | ((unsigned)f2bf(o[3]) << 16);
        ((uint2*)obrow)[lane + 64 * j] = ob;
        if (o8row) ((unsigned*)o8row)[lane + 64 * j] = pack4_fp8(o, XS);
    }
}
__device__ __forceinline__ void phase_ln(const Ctx& c, const float* __restrict__ Z, const float* __restrict__ g, const float* __restrict__ bta, float* __restrict__ out, bf16_t* __restrict__ outb, unsigned char* __restrict__ out8) {
    const int lane = c.lane, gw = c.bid * NWAVES + c.wid, NGW = c.G * NWAVES;
    for (int tok = gw; tok < NTOK; tok += NGW) {
        const f32x4* zr = (const f32x4*)(Z + (size_t)tok * D);
        f32x4 v[4];
#pragma unroll
        for (int j = 0; j < 4; ++j) v[j] = zr[lane + 64 * j];
        ln_store_row(v, lane, g, bta, out + (size_t)tok * D, outb + (size_t)tok * D, out8 + (size_t)tok * D);
    }
}


#ifndef HD
#define HD __host__ __device__ __forceinline__
#endif
HD unsigned tk_f2u(float f) { return __builtin_bit_cast(unsigned, f); }
HD float tk_u2f(unsigned u) { return __builtin_bit_cast(float, u); }
template <int N> HD void bitonic_sort_desc(float (&v)[N]) {
#pragma unroll
    for (int k = 2; k <= N; k <<= 1)
#pragma unroll
        for (int j = k >> 1; j > 0; j >>= 1)
#pragma unroll
            for (int i = 0; i < N; ++i) {
                const int l = i ^ j;
                if (l > i) {
                    const bool desc = ((i & k) == 0);
                    const float a = v[i], b = v[l];
                    const float mx = __builtin_fmaxf(a, b), mn = __builtin_fminf(a, b);
                    v[i] = desc ? mx : mn; v[l] = desc ? mn : mx;
                }
            }
}
template <int N> HD void bitonic_merge_desc(float (&v)[N]) {
#pragma unroll
    for (int j = N >> 1; j > 0; j >>= 1)
#pragma unroll
        for (int i = 0; i < N; ++i) {
            const int l = i ^ j;
            if (l > i) { const float a = v[i], b = v[l]; v[i] = __builtin_fmaxf(a, b); v[l] = __builtin_fminf(a, b); }
        }
}
HD void top16_merge(float (&a)[16], const float (&b)[16]) {
#pragma unroll
    for (int i = 0; i < 16; ++i) a[i] = __builtin_fmaxf(a[i], b[15 - i]);
    bitonic_merge_desc<16>(a);
}
HD void tk_local_top16(const float (&sc)[4][16], int hh, float (&out)[16]) {
    float g[4][16];
#pragma unroll
    for (int kt = 0; kt < 4; ++kt) {
#pragma unroll
        for (int reg = 0; reg < 16; ++reg) { const int key = 32 * kt + (reg & 3) + 8 * (reg >> 2) + 4 * hh; g[kt][reg] = tk_u2f((tk_f2u(sc[kt][reg]) & ~127u) | (unsigned)(127 - key)); }
        bitonic_sort_desc<16>(g[kt]);
    }
    top16_merge(g[0], g[1]); top16_merge(g[2], g[3]); top16_merge(g[0], g[2]);
#pragma unroll
    for (int i = 0; i < 16; ++i) out[i] = g[0][i];
}
constexpr int CA0[25] = {0,0,0,0,0,0,0,0,0,0,0,0,0,0,0,0,1,1,1,1,1,1,1,1,2};
constexpr int CB0[25] = {0,1,2,3,4,5,6,7,8,9,10,11,12,13,14,15,0,1,2,3,4,5,6,7,0};
constexpr int CA1[25] = {2,2,2,2,3,3,3,3,4,4,4,5,5,6,6,7,7,8,9,10,11,12,13,14,15};
constexpr int CB1[25] = {1,2,3,4,0,1,2,3,0,1,2,0,1,0,1,0,1,0,0,0,0,0,0,0,0};
HD void tk_candidates(const float (&T0)[16], const float (&T1)[16], int hh, float (&cv)[32]) {
    float t0[16], t1[16];
#pragma unroll
    for (int i = 0; i < 16; ++i) { t0[i] = tk_u2f(tk_f2u(T0[i]) & ~127u); t1[i] = tk_u2f(tk_f2u(T1[i]) & ~127u); }
#pragma unroll
    for (int j = 0; j < 25; ++j) {
        const float s0 = t0[CA0[j]] + t1[CB0[j]], s1 = t0[CA1[j]] + t1[CB1[j]];
        const unsigned c0 = 255u - (unsigned)(16 * CA0[j] + CB0[j]), c1 = 255u - (unsigned)(16 * CA1[j] + CB1[j]);
        cv[j] = tk_u2f((tk_f2u(hh ? s1 : s0) & ~255u) | (hh ? c1 : c0));
    }
#pragma unroll
    for (int j = 25; j < 32; ++j) cv[j] = -__builtin_inff();
    bitonic_sort_desc<32>(cv);
}

__device__ __forceinline__ void wave_argmax(float& v, int& i) {
#pragma unroll
    for (int o = 32; o >= 1; o >>= 1) {
        const float ov = __shfl_xor(v, o); const int oi = __shfl_xor(i, o);
        if (ov > v || (ov == v && oi < i)) { v = ov; i = oi; }
    }
}
__device__ __forceinline__ void phase_topk_naive(const Ctx& c, const float* __restrict__ Qp, const float* __restrict__ keys, int* __restrict__ eidx, float* __restrict__ gate) {
    float* qsh = (float*)(c.lds + c.wid * 1024);
    float* tv = qsh + 128;
    int* ti = (int*)(tv + 32);
    const int lane = c.lane, gw = c.bid * NWAVES + c.wid, NGW = c.G * NWAVES;
    for (int item = gw; item < NTOK * 8; item += NGW) {
        const int tok = item >> 3, h = item & 7;
        for (int p = 0; p < 2; ++p) {
            const float* q = Qp + (size_t)tok * PQ + h * 256 + p * 128;
            qsh[lane] = q[lane]; qsh[lane + 64] = q[lane + 64];
            WAVE_LDS_SYNC();
            float s[2];
#pragma unroll
            for (int i = 0; i < 2; ++i) {
                const f32x4* kr = (const f32x4*)(keys + ((size_t)(h * 2 + p) * NKEYS + lane + 64 * i) * 128);
                float a = 0.f;
                for (int cc = 0; cc < 32; ++cc) { const f32x4 kk = kr[cc]; a += qsh[4 * cc] * kk[0]; a += qsh[4 * cc + 1] * kk[1]; a += qsh[4 * cc + 2] * kk[2]; a += qsh[4 * cc + 3] * kk[3]; }
                s[i] = a;
            }
            for (int r = 0; r < 16; ++r) {
                float bv; int bi;
                if (s[0] >= s[1]) { bv = s[0]; bi = lane; } else { bv = s[1]; bi = lane + 64; }
                wave_argmax(bv, bi);
                if (bi == lane) s[0] = -INFINITY;
                if (bi == lane + 64) s[1] = -INFINITY;
                if (lane == 0) { tv[p * 16 + r] = bv; ti[p * 16 + r] = bi; }
            }
            WAVE_LDS_SYNC();
        }
        float cv[4];
#pragma unroll
        for (int j = 0; j < 4; ++j) { const int f = lane * 4 + j; cv[j] = tv[f >> 4] + tv[16 + (f & 15)]; }
        float fs = 0.f; int fp = 0;
        for (int r = 0; r < 16; ++r) {
            float bv = cv[0]; int bi = lane * 4;
#pragma unroll
            for (int j = 1; j < 4; ++j) if (cv[j] > bv) { bv = cv[j]; bi = lane * 4 + j; }
            wave_argmax(bv, bi);
#pragma unroll
            for (int j = 0; j < 4; ++j) if (bi == lane * 4 + j) cv[j] = -INFINITY;
            if (lane == r) { fs = bv; fp = bi; }
        }
        const float m = wave_max(lane < 16 ? fs : -INFINITY);
        const float e = lane < 16 ? expf(fs - m) : 0.f;
        const float sum = wave_sum(e);
        if (lane < 16) {
            const int id = ti[fp >> 4] * NKEYS + ti[16 + (fp & 15)];
            eidx[(size_t)item * 16 + lane] = id;
            gate[(size_t)item * 16 + lane] = e / sum;
        }
        WAVE_LDS_SYNC();
    }
}

__device__ __forceinline__ void phase_gather_naive(const Ctx& c, const float* __restrict__ x1, const int* __restrict__ eidx, const float* __restrict__ gate,
                                                   const float* __restrict__ U, const float* __restrict__ V, const float* __restrict__ g, const float* __restrict__ bta,
                                                   float* __restrict__ out, bf16_t* __restrict__ outb) {
    const int lane = c.lane, gw = c.bid * NWAVES + c.wid, NGW = c.G * NWAVES;
    for (int tok = gw; tok < NTOK; tok += NGW) {
        const f32x4* xr = (const f32x4*)(x1 + (size_t)tok * D);
        f32x4 xv[4], acc[4];
#pragma unroll
        for (int j = 0; j < 4; ++j) { xv[j] = xr[lane + 64 * j]; acc[j] = (f32x4){0.f, 0.f, 0.f, 0.f}; }
        for (int k = 0; k < 128; ++k) {
            const int e = eidx[(size_t)tok * 128 + k];
            const float gk = gate[(size_t)tok * 128 + k];
            const f32x4* ur = (const f32x4*)(U + (size_t)e * D);
            const f32x4* vr = (const f32x4*)(V + (size_t)e * D);
            float d = 0.f;
#pragma unroll
            for (int j = 0; j < 4; ++j) { const f32x4 uu = ur[lane + 64 * j]; d += (xv[j][0] * uu[0] + xv[j][1] * uu[1]) + (xv[j][2] * uu[2] + xv[j][3] * uu[3]); }
            d = wave_sum(d);
            const float a = 0.5f * d * (1.f + erff(d * 0.70710678118654752f)) * gk;
#pragma unroll
            for (int j = 0; j < 4; ++j) acc[j] += a * vr[lane + 64 * j];
        }
#pragma unroll
        for (int j = 0; j < 4; ++j) acc[j] = ALPHA * xv[j] + acc[j];
        ln_store_row(acc, lane, g, bta, out + (size_t)tok * D, outb + (size_t)tok * D, nullptr);
    }
}


__device__ __forceinline__ void phase_topk(const Ctx& c, const bf16_t* __restrict__ Qb, const bf16_t* __restrict__ Kb, int* __restrict__ eidx, float* __restrict__ gate) {
    LAS unsigned char* kl = (LAS unsigned char*)c.lds;
    LAS int* scr = (LAS int*)(c.lds + 65536) + c.wid * 1024;
    const int lane = c.lane, r32 = lane & 31, hh = lane >> 5;
    for (int task = c.bid; task < 8 * (NTOK / 256); task += c.G) {
        const int h = task / (NTOK / 256), tb = task % (NTOK / 256);
        __syncthreads();
#pragma unroll
        for (int i = 0; i < 8; ++i) {
            const int ch = c.tid + NTHREADS * i, row = ch >> 4, cc = ch & 15;
            const u32x4 v = *(const u32x4*)(Kb + ((size_t)(h * 256 + row) * 128 + cc * 8));
            *(LAS u32x4*)(kl + row * 256 + ((cc ^ (row & 15)) << 4)) = v;
        }
        __syncthreads();
        const int tok = tb * 256 + c.wid * 32 + r32;
        float T0[16], T1[16];
#pragma unroll
        for (int p = 0; p < 2; ++p) {
            bf16x8 bq[8];
            const bf16_t* qrow = Qb + (size_t)tok * PQ + h * 256 + p * 128 + hh * 8;
#pragma unroll
            for (int ks = 0; ks < 8; ++ks) bq[ks] = *(const bf16x8*)(qrow + 16 * ks);
            f32x16 acc[4];
#pragma unroll
            for (int kt = 0; kt < 4; ++kt)
#pragma unroll
                for (int r = 0; r < 16; ++r) acc[kt][r] = 0.f;
#pragma unroll
            for (int ks = 0; ks < 8; ++ks) {
                const int swz = ((2 * ks + hh) ^ (r32 & 15)) << 4;
#pragma unroll
                for (int kt = 0; kt < 4; ++kt) {
                    const bf16x8 a = *(const LAS bf16x8*)(kl + (p * 128 + 32 * kt + r32) * 256 + swz);
                    acc[kt] = __builtin_amdgcn_mfma_f32_32x32x16_bf16(a, bq[ks], acc[kt], 0, 0, 0);
                }
            }
            float sc[4][16], loc[16], pr[16];
#pragma unroll
            for (int kt = 0; kt < 4; ++kt)
#pragma unroll
                for (int r = 0; r < 16; ++r) sc[kt][r] = acc[kt][r];
            tk_local_top16(sc, hh, loc);
#pragma unroll
            for (int i = 0; i < 16; ++i) pr[i] = __shfl_xor(loc[i], 32);
            top16_merge(loc, pr);
            if (hh == p) {
#pragma unroll
                for (int i = 0; i < 16; ++i) scr[r32 * 32 + p * 16 + i] = 127 - (int)(tk_f2u(loc[i]) & 127u);
            }
#pragma unroll
            for (int i = 0; i < 16; ++i) { if (p == 0) T0[i] = loc[i]; else T1[i] = loc[i]; }
        }
        float cv[32], F[16], pr[16];
        tk_candidates(T0, T1, hh, cv);
#pragma unroll
        for (int i = 0; i < 16; ++i) { F[i] = cv[i]; pr[i] = __shfl_xor(cv[i], 32); }
        top16_merge(F, pr);
        WAVE_LDS_SYNC();
        const float m = tk_u2f(tk_f2u(F[0]) & ~255u);
        float e[16], sum = 0.f;
#pragma unroll
        for (int i = 0; i < 16; ++i) { e[i] = __expf(tk_u2f(tk_f2u(F[i]) & ~255u) - m); sum += e[i]; }
        const float inv = 1.f / sum;
        int ids[8]; float gs[8];
#pragma unroll
        for (int r = 0; r < 8; ++r) {
            const float fv = hh ? F[8 + r] : F[r];
            const unsigned pos = 255u - (tk_f2u(fv) & 255u);
            ids[r] = scr[r32 * 32 + (int)(pos >> 4)] * NKEYS + scr[r32 * 32 + 16 + (int)(pos & 15u)];
            gs[r] = (hh ? e[8 + r] : e[r]) * inv;
        }
        int* ep = eidx + ((size_t)tok * 8 + h) * 16 + 8 * hh; float* gp = gate + ((size_t)tok * 8 + h) * 16 + 8 * hh;
        *(int4*)ep = make_int4(ids[0], ids[1], ids[2], ids[3]); *(int4*)(ep + 4) = make_int4(ids[4], ids[5], ids[6], ids[7]);
        *(f32x4*)gp = (f32x4){gs[0], gs[1], gs[2], gs[3]}; *(f32x4*)(gp + 4) = (f32x4){gs[4], gs[5], gs[6], gs[7]};
        WAVE_LDS_SYNC();
    }
}

__device__ __forceinline__ float gelu_erf(float v) {
    const float av = fabsf(v), t = __builtin_amdgcn_rcpf(av * 0.2316418882f + 1.0f);
    float qq = t * 0.5307027145f + (-0.7265760135f); qq = qq * t + 0.7107068705f; qq = qq * t + (-0.142248368f); qq = qq * t + 0.127414796f; qq = qq * t;
    const float e = __builtin_amdgcn_exp2f((v * v) * (-0.72134752044f));
    const float m = v * (qq * e);
    return v < 0.f ? m : v - m;
}
#define SB() __builtin_amdgcn_sched_barrier(0)
__device__ __forceinline__ void axpy_row4(f32x2 (&acc)[16], const u32x4 w, const float a) {
    const f32x2 aa = {a, a};
#pragma unroll
    for (int k = 0; k < 4; ++k) {
        {
            const float sc = __builtin_bit_cast(float, 0x3F80007Fu);
            acc[4 * k + 0] = __builtin_elementwise_fma(__builtin_amdgcn_cvt_scalef32_pk_f32_fp4(w[k], sc, 0), aa, acc[4 * k + 0]);
            acc[4 * k + 1] = __builtin_elementwise_fma(__builtin_amdgcn_cvt_scalef32_pk_f32_fp4(w[k], sc, 1), aa, acc[4 * k + 1]);
            acc[4 * k + 2] = __builtin_elementwise_fma(__builtin_amdgcn_cvt_scalef32_pk_f32_fp4(w[k], sc, 2), aa, acc[4 * k + 2]);
            acc[4 * k + 3] = __builtin_elementwise_fma(__builtin_amdgcn_cvt_scalef32_pk_f32_fp4(w[k], sc, 3), aa, acc[4 * k + 3]);
        }
    }
}
__device__ __forceinline__ void phase_gather(const Ctx& c, const float* __restrict__ x1, const unsigned char* __restrict__ X8, const int* __restrict__ eidx, const float* __restrict__ gate,
                                             const unsigned char* __restrict__ U4, const unsigned char* __restrict__ V4, const float* __restrict__ g, const float* __restrict__ bta,
                                             float* __restrict__ out, bf16_t* __restrict__ outb) {
    typedef int i32x8 __attribute__((ext_vector_type(8)));
    const int gw = c.bid * NWAVES + c.wid, NGW = c.G * NWAVES;
    LAS unsigned char* xl = (LAS unsigned char*)c.lds + c.wid * 2048;
    const int lane = c.lane, q = lane >> 4, l15 = lane & 15, r32 = lane & 31, hh = lane >> 5;
    const unsigned lo16 = (unsigned)lane * 16u, vo16 = (unsigned)r32 * 16u;
    constexpr int UROW = D / 2;
    int tok = gw;
    if (tok >= NTOK) return;
    int ev0 = eidx[(size_t)tok * 128 + lane], ev1 = eidx[(size_t)tok * 128 + 64 + lane];
    float gv0 = gate[(size_t)tok * 128 + lane], gv1 = gate[(size_t)tok * 128 + 64 + lane];
    int en0, en1; float gn0, gn1;
    { const int t1 = (tok + NGW < NTOK) ? tok + NGW : tok; en0 = eidx[(size_t)t1 * 128 + lane]; en1 = eidx[(size_t)t1 * 128 + 64 + lane];
      gn0 = gate[(size_t)t1 * 128 + lane]; gn1 = gate[(size_t)t1 * 128 + 64 + lane]; }
    *(LAS u32x4*)(xl + lane * 16) = *(const u32x4*)(X8 + (size_t)tok * D + lo16);
    u32x4 bU[8], bV0[4], bV1[4];
#define V_ISSUE(buf, evsrc, base) do { _Pragma("unroll") for (int k_ = 0; k_ < 4; ++k_) { \
        const int ea_ = __builtin_amdgcn_readlane(evsrc, (base) + 2 * k_), eb_ = __builtin_amdgcn_readlane(evsrc, (base) + 2 * k_ + 1); \
        buf[k_] = *(const u32x4*)(V4 + ((unsigned)(hh ? eb_ : ea_) * (unsigned)UROW + vo16)); } } while (0)
#define V_COMPUTE(buf, ibase) do { _Pragma("unroll") for (int k_ = 0; k_ < 4; ++k_) { \
        const int ia_ = (ibase) + 2 * k_, ib_ = ia_ + 1; \
        const int aa_ = __builtin_amdgcn_readlane(a4[ia_ & 3], 16 * (ia_ >> 2)), ab_ = __builtin_amdgcn_readlane(a4[ib_ & 3], 16 * (ib_ >> 2)); \
        axpy_row4(acc, buf[k_], __builtin_bit_cast(float, hh ? ab_ : aa_)); SB(); } } while (0)
    {
        const unsigned char* ub = U4 + ((unsigned)__shfl(ev0, l15) * (unsigned)UROW + (unsigned)q * 16u);
#pragma unroll
        for (int t = 0; t < 8; ++t) bU[t] = *(const u32x4*)(ub + 64 * t);
        SB();
        V_ISSUE(bV0, ev0, 0);
        SB();
    }
    int slot = 0;
#pragma unroll 1
    for (; tok < NTOK; tok += NGW, slot ^= 1) {
        const LAS unsigned char* xc = xl + slot * 1024 + q * 16;
        f32x2 acc[16];
#pragma unroll
        for (int k = 0; k < 16; ++k) acc[k] = (f32x2){0.f, 0.f};
        SB();
#pragma unroll
        for (int h = 0; h < 8; ++h) {
            const int evh = (h < 4) ? ev0 : ev1, lb = (h & 3) * 16;
            const bool last = (h == 7);
            const int evn = last ? en0 : ((h + 1 < 4) ? ev0 : ev1), lbn = last ? 0 : ((h + 1) & 3) * 16;
            const float gvh = (h < 4) ? gv0 : gv1;
            float gq[4];
#pragma unroll
            for (int r = 0; r < 4; ++r) gq[r] = __shfl(gvh, lb + 4 * q + r);
            SB();
            V_ISSUE(bV1, evh, lb + 8);
            SB();
            f32x4 h4 = {0.f, 0.f, 0.f, 0.f};
#pragma unroll
            for (int t = 0; t < 8; ++t) {
                const u32x4 x0 = *(const LAS u32x4*)(xc + 128 * t), x1v = *(const LAS u32x4*)(xc + 128 * t + 64);
                const i32x8 av = {(int)bU[t][0], (int)bU[t][1], (int)bU[t][2], (int)bU[t][3], 0, 0, 0, 0};
                const i32x8 bv = {(int)x0[0], (int)x0[1], (int)x0[2], (int)x0[3], (int)x1v[0], (int)x1v[1], (int)x1v[2], (int)x1v[3]};
                h4 = __builtin_amdgcn_mfma_scale_f32_16x16x128_f8f6f4(av, bv, h4, 4, 0, 0, 0, 0, 0);
                if ((t & 1) == 1) SB();
            }
            int a4[4];
#pragma unroll
            for (int r = 0; r < 4; ++r) a4[r] = __builtin_bit_cast(int, gelu_erf(h4[r] * (1.f / (XS * US))) * gq[r] * (1.f / VS));
            SB();
            {
                const unsigned char* ubn = U4 + ((unsigned)__shfl(evn, lbn + l15) * (unsigned)UROW + (unsigned)q * 16u);
#pragma unroll
                for (int t = 0; t < 8; ++t) bU[t] = *(const u32x4*)(ubn + 64 * t);
            }
            SB();
            V_COMPUTE(bV0, 0);
            V_ISSUE(bV0, evn, lbn);
            SB();
            V_COMPUTE(bV1, 8);
        }
        const int tokn = (tok + NGW < NTOK) ? tok + NGW : tok, tok2 = (tok + 2 * NGW < NTOK) ? tok + 2 * NGW : tok;
        const int nn0 = eidx[(size_t)tok2 * 128 + lane], nn1 = eidx[(size_t)tok2 * 128 + 64 + lane];
        const float ng0 = gate[(size_t)tok2 * 128 + lane], ng1 = gate[(size_t)tok2 * 128 + 64 + lane];
        const u32x4 xn = *(const u32x4*)(X8 + (size_t)tokn * D + lo16);
        float z[16];
#pragma unroll
        for (int k = 0; k < 8; ++k)
#pragma unroll
            for (int e = 0; e < 2; ++e) {
                const float send = hh ? acc[k][e] : acc[8 + k][e], own = hh ? acc[8 + k][e] : acc[k][e];
                z[2 * k + e] = own + __shfl_xor(send, 32);
            }
        const int f4 = 8 * r32 + 4 * hh;
        const f32x4* xr = (const f32x4*)(x1 + (size_t)tok * D) + f4;
        float sm = 0.f;
#pragma unroll
        for (int w = 0; w < 4; ++w) { const f32x4 xv = xr[w];
#pragma unroll
            for (int e = 0; e < 4; ++e) { z[4 * w + e] += ALPHA * xv[e]; sm += z[4 * w + e]; } }
        const float mean = wave_sum(sm) * (1.f / D); float s2 = 0.f;
#pragma unroll
        for (int k = 0; k < 16; ++k) { z[k] -= mean; s2 += z[k] * z[k]; }
        const float rstd = rsqrtf(wave_sum(s2) * (1.f / D) + LN_EPS);
#pragma unroll
        for (int w = 0; w < 4; ++w) {
            const f32x4 gg = ((const f32x4*)g)[f4 + w], be = ((const f32x4*)bta)[f4 + w];
            f32x4 o;
#pragma unroll
            for (int e = 0; e < 4; ++e) o[e] = z[4 * w + e] * rstd * gg[e] + be[e];
            ((f32x4*)(out + (size_t)tok * D))[f4 + w] = o;
            uint2 ob; ob.x = f2bf(o[0]) | ((unsigned)f2bf(o[1]) << 16); ob.y = f2bf(o[2]) | ((unsigned)f2bf(o[3]) << 16);
            ((uint2*)(outb + (size_t)tok * D))[f4 + w] = ob;
        }
        *(LAS u32x4*)(xl + (slot ^ 1) * 1024 + lane * 16) = xn;
        ev0 = en0; ev1 = en1; en0 = nn0; en1 = nn1; gv0 = gn0; gv1 = gn1; gn0 = ng0; gn1 = ng1;
        SB();
    }
#undef V_ISSUE
#undef V_COMPUTE
}

#define GAS __attribute__((address_space(1)))
#define XB_TMO      128
#define XB_XCNT(j)  (256  + 64 * (j))
#define XB_XSUB(j)  (1280 + 64 * (j))
#define XB_XGEN(j)  (2304 + 64 * (j))
#define XB_TOP      3328
#define XB_TOPGEN   3392
#define XCD_BAR_WORDS 3456
#define XB_SPIN_CAP (1u << 18)

__device__ __forceinline__ unsigned xb_ld(unsigned* p)              { return __hip_atomic_load(p, __ATOMIC_RELAXED, __HIP_MEMORY_SCOPE_AGENT); }
__device__ __forceinline__ unsigned xb_add(unsigned* p, unsigned v) { return __hip_atomic_fetch_add(p, v, __ATOMIC_RELAXED, __HIP_MEMORY_SCOPE_AGENT); }
__device__ __forceinline__ unsigned xb_xcc_id() { return (unsigned)__builtin_amdgcn_s_getreg((3 << 11) | 20) & 0xFu; }
#define XB_SPIN(cond, bar) do { unsigned _sp = 0; while (cond) { __builtin_amdgcn_s_sleep(1); \
    if ((++_sp & 255u) == 0u) { if (xb_ld(&(bar)[XB_TMO])) break; if (_sp > XB_SPIN_CAP) { atomicAdd(&(bar)[XB_TMO], 1u); break; } } } } while (0)

struct XcdBarrier {
    unsigned* bar; unsigned x;
    volatile LAS unsigned* st;
};

__device__ __forceinline__ XcdBarrier xcd_barrier_post(unsigned* bar, volatile LAS unsigned* st) {
    XcdBarrier b; b.bar = bar; b.x = xb_xcc_id(); b.st = st;
    if (threadIdx.x == 0) (void)xb_add(&bar[XB_XCNT(b.x)], 1u);
    return b;
}
__device__ __forceinline__ void xcd_barrier_complete(unsigned* bar, unsigned x, unsigned& nloc, unsigned& nx) {
    const unsigned G = gridDim.x * gridDim.y * gridDim.z;
    unsigned sum, cnt, mine, sp = 0u;
    for (;;) {
        sum = 0u; cnt = 0u; mine = 0u;
#pragma unroll
        for (unsigned j = 0; j < 16; ++j) { const unsigned c = xb_ld(&bar[XB_XCNT(j)]); sum += c; cnt += (c > 0u) ? 1u : 0u; mine = (j == x) ? c : mine; }
        if (sum == G) break;
        __builtin_amdgcn_s_sleep(1);
        if ((++sp & 255u) == 0u) { if (xb_ld(&bar[XB_TMO])) break; if (sp > XB_SPIN_CAP) { atomicAdd(&bar[XB_TMO], 1u); break; } }
    }
    nloc = mine > 0u ? mine : 1u; nx = cnt > 0u ? cnt : 1u;
}

__device__ __forceinline__ void xcd_barrier(const XcdBarrier& b) {
    asm volatile("s_waitcnt vmcnt(0)" ::: "memory");
    __syncthreads();
    if (threadIdx.x == 0) {
        unsigned* bar = b.bar;
        __builtin_amdgcn_s_waitcnt(0);
        unsigned nloc = b.st[0], nx = b.st[1];
        if (nloc == 0u) { xcd_barrier_complete(bar, b.x, nloc, nx); b.st[0] = nloc; b.st[1] = nx; }
        const unsigned old = xb_add(&bar[XB_XSUB(b.x)], 1u);
        const unsigned gen = old / nloc;
        if (old + 1u == (gen + 1u) * nloc) {
            __builtin_amdgcn_fence(__ATOMIC_RELEASE, "agent");
            asm volatile("s_waitcnt vmcnt(0)" ::: "memory");
            const unsigned og = xb_add(&bar[XB_TOP], 1u);
            const unsigned tg = og / nx;
            if (og + 1u == (tg + 1u) * nx) xb_add(&bar[XB_TOPGEN], 1u);
            else XB_SPIN(xb_ld(&bar[XB_TOPGEN]) == tg, bar);
            __builtin_amdgcn_fence(__ATOMIC_ACQUIRE, "agent");
            xb_add(&bar[XB_XGEN(b.x)], 1u);
            asm volatile("s_waitcnt vmcnt(0)" ::: "memory");
        } else {
            XB_SPIN(xb_ld(&bar[XB_XGEN(b.x)]) == gen, bar);
            __builtin_amdgcn_fence(__ATOMIC_ACQUIRE, "agent");
            asm volatile("s_waitcnt vmcnt(0)" ::: "memory");
        }
    }
    __syncthreads();
}

constexpr size_t MiB = 1u << 20;
constexpr size_t WS_WIN = 0;
constexpr size_t WS_WO = 20 * MiB;
constexpr size_t WS_WQ = 28 * MiB;
constexpr size_t WS_XB = 48 * MiB;
constexpr size_t WS_XA = 112 * MiB;
constexpr size_t WS_X1 = 240 * MiB;
constexpr size_t WS_H = 368 * MiB;
constexpr size_t WS_Y = 512 * MiB;
constexpr size_t WS_Z = 576 * MiB;
constexpr size_t WS_QP = 368 * MiB;
constexpr size_t WS_KB = 44 * MiB;
constexpr size_t WS_EI = 704 * MiB;
constexpr size_t WS_GT = 720 * MiB;
constexpr size_t WS_U8 = 736 * MiB;
constexpr size_t WS_V8 = 800 * MiB;
constexpr size_t WS_X8 = 864 * MiB;
constexpr size_t WS_CTL = 896 * MiB;
constexpr size_t CTL_BYTES = 16384;
constexpr size_t WS_END = 897 * MiB;

struct Params { const float* in[16]; float* out; unsigned char* ws; };

__global__ void __launch_bounds__(NTHREADS, 2) mega_fwd(Params P) {
    extern __shared__ __attribute__((aligned(16))) unsigned char lds[];
    cg::grid_group grid = cg::this_grid();
    const float* x = P.in[0]; const float* w_in = P.in[1]; const float* w_o = P.in[2]; const float* sink = P.in[3]; const float* rpb = P.in[4]; const float* t5 = P.in[5];
    const float* ga = P.in[6]; const float* gb = P.in[7]; const float* l1g = P.in[8]; const float* l1b = P.in[9]; const float* l2g = P.in[10]; const float* l2b = P.in[11];
    const float* wq = P.in[12]; const float* keys = P.in[13]; const float* pu = P.in[14]; const float* pv = P.in[15];
    unsigned char* ws = P.ws;
    bf16_t* WinT = (bf16_t*)(ws + WS_WIN); bf16_t* WoT = (bf16_t*)(ws + WS_WO); bf16_t* WqT = (bf16_t*)(ws + WS_WQ);
    bf16_t* Xb = (bf16_t*)(ws + WS_XB); float* XA = (float*)(ws + WS_XA); float* X1 = (float*)(ws + WS_X1);
    bf16_t* H = (bf16_t*)(ws + WS_H); bf16_t* Y = (bf16_t*)(ws + WS_Y); float* Z = (float*)(ws + WS_Z); bf16_t* Qb = (bf16_t*)(ws + WS_QP); bf16_t* Kb = (bf16_t*)(ws + WS_KB);
    int* EI = (int*)(ws + WS_EI); float* GT = (float*)(ws + WS_GT);
    unsigned char* U8 = ws + WS_U8; unsigned char* V8 = ws + WS_V8; unsigned char* X8 = ws + WS_X8;

    volatile LAS unsigned* MISC = (volatile LAS unsigned*)((LAS unsigned char*)lds + (LDS_BYTES - 256));
    if (threadIdx.x < 4) MISC[threadIdx.x] = 0u;
    __syncthreads();
    const XcdBarrier bar = xcd_barrier_post((unsigned*)(ws + WS_CTL), MISC);
#define GRID_BAR() xcd_barrier(bar)
    phase_convert(make_ctx(lds), w_in, w_o, wq, x, pu, pv, WinT, WoT, WqT, Xb, U8, V8, keys, Kb);
    grid.sync();
#pragma unroll 1
    for (int l = 0; l < DEPTH; ++l) {
        const float* xin = (l == 0) ? x : XA;
        float* xout = (l == DEPTH - 1) ? P.out : XA;
        phase_gemm<pg8::EpiBf16<0>, true>(lds, Xb, WinT + (size_t)l * PROJ * D, PROJ, pg8::EpiBf16<0>{H, PROJ, nullptr, 0, 0, 1.f});
        GRID_BAR();
        phase_attn(make_ctx(lds), H, sink + l * 8, t5, rpb + (size_t)l * 8 * 15 * 31, Z);
        GRID_BAR();
        phase_rmsnorm(make_ctx(lds), Z, ga + l * 512, gb + l * 512, Y);
        GRID_BAR();
        phase_gemm<EpiZf32, true>(lds, Y, WoT + (size_t)l * D * D, D, EpiZf32{xin, Z});
        GRID_BAR();
        phase_ln(make_ctx(lds), Z, l1g + l * D, l1b + l * D, X1, Xb, X8);
        GRID_BAR();
        phase_gemm<pg8::EpiBf16<0>, true>(lds, Xb, WqT + (size_t)l * PQ * D, PQ, pg8::EpiBf16<0>{Qb, PQ, nullptr, 0, 0, 1.f});
        GRID_BAR();
        phase_topk(make_ctx(lds), Qb, Kb + (size_t)l * 8 * 2 * NKEYS * 128, EI, GT);
        GRID_BAR();
        phase_gather(make_ctx(lds), X1, X8, EI, GT, U8 + (size_t)l * NEXP * (D / 2), V8 + (size_t)l * NEXP * (D / 2), l2g + l * D, l2b + l * D, xout, Xb);
        if (l < DEPTH - 1) GRID_BAR();
    }
}

extern "C" void kernel_launch(void* const* d_in, const int* in_sizes, int n_in, void* d_out, int out_size, void* d_ws, size_t ws_size, hipStream_t stream) {
    static int grid = 0;
    if (grid == 0) {
        if (n_in != 16 || ws_size < WS_END || out_size != NTOK * D) { fprintf(stderr, "kernel_launch: unexpected shapes\n"); grid = -1; return; }
        int dev = 0, cus = 0, per_cu = 0;
        hipGetDevice(&dev);
        hipDeviceGetAttribute(&cus, hipDeviceAttributeMultiprocessorCount, dev);
        hipFuncSetAttribute((const void*)mega_fwd, hipFuncAttributeMaxDynamicSharedMemorySize, LDS_BYTES);
        hipOccupancyMaxActiveBlocksPerMultiprocessor(&per_cu, (const void*)mega_fwd, NTHREADS, LDS_BYTES);
        if (per_cu < 1) { fprintf(stderr, "kernel_launch: occupancy query says %d blocks/CU\n", per_cu); grid = -1; return; }
        grid = cus;
    }
    if (grid < 0) return;
    if (hipMemsetAsync((char*)d_ws + WS_CTL, 0, CTL_BYTES, stream) != hipSuccess) { fprintf(stderr, "kernel_launch: memset of the barrier words failed\n"); return; }
    Params P{};
    for (int i = 0; i < 16; ++i) P.in[i] = (const float*)d_in[i];
    P.out = (float*)d_out; P.ws = (unsigned char*)d_ws;
    void* args[] = {&P};
    hipError_t e = hipLaunchCooperativeKernel((const void*)mega_fwd, dim3(grid), dim3(NTHREADS), args, LDS_BYTES, stream);
    if (e != hipSuccess) fprintf(stderr, "cooperative launch failed: %s (grid %d)\n", hipGetErrorString(e), grid);
}
```
